# Optimizing an MI355X kernel written in HIP

```python
import math, functools
import jax, jax.numpy as jnp
from jax import lax
import numpy as np

D_MODEL = 1024
BATCH = 8
SEQ = 8192
DEPTH = 1
DEC_BATCH = 128
DEC_SEQ = 8
PAST_LEN = 8192
PAGE_SIZE = 128

HEAD_DIM = 64
MIX_WIDTH = D_MODEL
A_W = MIX_WIDTH // 2
B_W = MIX_WIDTH - A_W
H_ATTN = A_W // HEAD_DIM
H_RWKV = B_W // HEAD_DIM
BRANCHES = ((128, 1), (512, 4), (2048, 16))
MAX_WINDOW = 2048
MAX_DIL = 16
Q_BLOCK = 128
NUM_BUCKETS = 32
MAX_DISTANCE = 2048
LORA_W = 64
LORA_A = 64
LORA_G = 160
N_SHIFT = 3 * B_W + LORA_W + LORA_A + LORA_G
N_IN = 3 * A_W + N_SHIFT
D_FF = 4 * D_MODEL
RMS_EPS = 1e-6
GN_EPS = 64e-5
NEG_INF = -1e30

kernel_name = 'hybrid_dilated_attn_rwkv7_step'

f32 = jnp.float32


def rms_norm(x, g):
    xf = x.astype(f32)
    y = xf * lax.rsqrt(jnp.mean(xf * xf, -1, keepdims=True) + RMS_EPS) * g.astype(f32)
    return y.astype(x.dtype)


def t5_bucket(dist):
    dist = np.maximum(dist, 0)
    max_exact = NUM_BUCKETS // 2
    large = max_exact + (np.log(np.maximum(dist, 1) / max_exact)
                         / math.log(MAX_DISTANCE / max_exact)
                         * (NUM_BUCKETS - max_exact)).astype(np.int32)
    large = np.minimum(large, NUM_BUCKETS - 1)
    return np.where(dist < max_exact, dist, large).astype(np.int32)


def dilated_attention(q, k_ctx, v_ctx, q_start, bias_table, blk):
    B, Tq, H, E = q.shape
    pad = ((0, 0), (MAX_WINDOW, 0), (0, 0), (0, 0))
    kp = jnp.pad(k_ctx, pad)
    vp = jnp.pad(v_ctx, pad)
    scale = HEAD_DIM ** -0.5
    statics = []
    for w, d in BRANCHES:
        M, N = blk // d, (w + blk) // d
        m = np.arange(M)[:, None]
        n = np.arange(N)[None, :]
        band = jnp.asarray((n >= m) & (n <= m + w // d))
        bias = jnp.transpose(bias_table[t5_bucket(w + (m - n) * d)], (2, 0, 1)).astype(f32)
        statics.append((w, d, M, N, band, bias))

    def one_block(c0):
        qb = lax.dynamic_slice_in_dim(q, c0 - q_start, blk, axis=1)
        maxs, dens, outs = [], [], []
        for w, d, M, N, band, bias in statics:
            kr = lax.dynamic_slice_in_dim(kp, c0 + MAX_WINDOW - w, w + blk, axis=1).reshape(B, N, d, H, E)
            vr = lax.dynamic_slice_in_dim(vp, c0 + MAX_WINDOW - w, w + blk, axis=1).reshape(B, N, d, H, E)
            qr = qb.reshape(B, M, d, H, E)
            s = jnp.einsum('bmrhe,bnrhe->bhrmn', qr, kr).astype(f32) * scale + bias[None, :, None]
            valid = (c0 - w + jnp.arange(N)[None, :] * d + jnp.arange(d)[:, None]) >= 0
            s = jnp.where(band[None] & valid[:, None, :], s, NEG_INF)
            mx = jnp.max(s, -1)
            e = jnp.exp(s - mx[..., None])
            dn = jnp.sum(e, -1)
            o = jnp.einsum('bhrmn,bnrhe->bhrme', e, vr.astype(f32))
            maxs.append(mx.transpose(0, 3, 2, 1).reshape(B, blk, H))
            dens.append(dn.transpose(0, 3, 2, 1).reshape(B, blk, H))
            outs.append(o.transpose(0, 3, 2, 1, 4).reshape(B, blk, H, E))
        mall = maxs[0]
        for mx in maxs[1:]:
            mall = jnp.maximum(mall, mx)
        num = 0.0
        den = 0.0
        for mx, dn, o in zip(maxs, dens, outs):
            sc = jnp.exp(mx - mall)
            num = num + sc[..., None] * o
            den = den + sc * dn
        return num / den[..., None]

    c0s = q_start + blk * jnp.arange(Tq // blk, dtype=jnp.int32)
    out = lax.map(one_block, c0s)
    return out.transpose(1, 0, 2, 3, 4).reshape(B, Tq, H, E)


def wkv_scan(S0, r, w, k, v, kk, a):
    def step(S, inp):
        r_t, w_t, k_t, v_t, kk_t, a_t = inp
        sk = jnp.einsum('bhij,bhj->bhi', S, kk_t)
        S = (S * w_t[:, :, None, :] - sk[..., None] * (kk_t * a_t)[:, :, None, :]
             + v_t[..., None] * k_t[:, :, None, :])
        return S, jnp.einsum('bhij,bhj->bhi', S, r_t)
    xs = tuple(jnp.moveaxis(t, 1, 0) for t in (r, w, k, v, kk, a))
    S, y = lax.scan(step, S0, xs)
    return jnp.moveaxis(y, 0, 1), S


def rwkv7_time_mix(p, shift0, wkv0, mu_shift, w0, w_lora2, a0, a_lora2, g_lora2, k_k, k_a, r_k, lnx_g, lnx_b):
    B, T, _ = p.shape
    pf = p.astype(f32)
    prev = jnp.concatenate([shift0.astype(f32)[:, None], pf[:, :-1]], axis=1)
    xs = pf + (prev - pf) * mu_shift.astype(f32)
    r, k, v, xw, xa, xg = jnp.split(
        xs, (B_W, 2 * B_W, 3 * B_W, 3 * B_W + LORA_W, 3 * B_W + LORA_W + LORA_A), axis=-1)
    w_log = -jax.nn.softplus(-(w0.astype(f32) + jnp.tanh(xw) @ w_lora2.astype(f32))) - 0.5
    decay = jnp.exp(-jnp.exp(w_log))
    a = jax.nn.sigmoid(a0.astype(f32) + xa @ a_lora2.astype(f32))
    g = jax.nn.sigmoid(xg) @ g_lora2.astype(f32)
    heads = lambda t: t.reshape(B, T, H_RWKV, HEAD_DIM)
    kk = heads(k * k_k.astype(f32))
    kk = kk / jnp.maximum(jnp.sqrt(jnp.sum(kk * kk, -1, keepdims=True)), 1e-12)
    k = k * (1.0 + (a - 1.0) * k_a.astype(f32))
    r, k, v, decay, a = heads(r), heads(k), heads(v), heads(decay), heads(a)
    y, S = wkv_scan(wkv0.astype(f32), r, decay, k, v, kk, a)
    mean = jnp.mean(y, -1, keepdims=True)
    var = jnp.mean(jnp.square(y - mean), -1, keepdims=True)
    y = ((y - mean) * lax.rsqrt(var + GN_EPS)).reshape(B, T, B_W) * lnx_g.astype(f32) + lnx_b.astype(f32)
    bonus = jnp.sum(r * k * r_k.astype(f32), -1, keepdims=True) * v
    y = (y + bonus.reshape(B, T, B_W)) * g
    return y, S, p[:, -1]


def head_rms(x, g):
    xf = x.astype(f32)
    return (xf * lax.rsqrt(jnp.mean(xf * xf, -1, keepdims=True) + RMS_EPS) * g.astype(f32)).astype(x.dtype)


def decoder_layer(x, k_past, v_past, wkv0, shift0, bias_table, ln1_g, w_in, q_norm_g, k_norm_g,
                  mu_shift, w0, w_lora2, a0, a_lora2, g_lora2, k_k, k_a, r_k, lnx_g, lnx_b,
                  w_out, ln2_g, w_mlp1, w_mlp2):
    B, T, _ = x.shape
    n = rms_norm(x, ln1_g)
    proj = n @ w_in
    q = head_rms(proj[..., :A_W].reshape(B, T, H_ATTN, HEAD_DIM), q_norm_g)
    k = head_rms(proj[..., A_W:2 * A_W].reshape(B, T, H_ATTN, HEAD_DIM), k_norm_g)
    v = proj[..., 2 * A_W:3 * A_W].reshape(B, T, H_ATTN, HEAD_DIM)
    blk = min(Q_BLOCK, -(-T // MAX_DIL) * MAX_DIL)
    t_pad = -(-T // blk) * blk
    tp = ((0, 0), (0, t_pad - T), (0, 0), (0, 0))
    k_ctx = jnp.concatenate([k_past.astype(k.dtype), jnp.pad(k, tp)], axis=1)
    v_ctx = jnp.concatenate([v_past.astype(v.dtype), jnp.pad(v, tp)], axis=1)
    att = dilated_attention(jnp.pad(q, tp), k_ctx, v_ctx, k_past.shape[1], bias_table, blk)[:, :T]
    rw, wkv_T, shift_T = rwkv7_time_mix(proj[..., 3 * A_W:], shift0, wkv0, mu_shift, w0, w_lora2,
                                        a0, a_lora2, g_lora2, k_k, k_a, r_k, lnx_g, lnx_b)
    mixed = jnp.concatenate([att.reshape(B, T, A_W).astype(x.dtype), rw.astype(x.dtype)], axis=-1)
    h = x + mixed @ w_out
    m = rms_norm(h, ln2_g)
    y = h + jnp.square(jax.nn.relu(m @ w_mlp1)) @ w_mlp2
    return y, k, v, wkv_T, shift_T


def setup_inputs(seed: int = 0) -> dict:
    key = jax.random.key(seed)
    ks = jax.random.split(key, 32)
    L = DEPTH
    lw = min(MAX_WINDOW, PAST_LEN)
    nrm = lambda kk, shape, s: jax.random.normal(kk, shape, f32) * s
    return {
        'x_prompt': nrm(ks[0], (BATCH, SEQ, D_MODEL), 1.0),
        'x_sample': nrm(ks[1], (DEC_BATCH, DEC_SEQ, D_MODEL), 1.0),
        'cache_k_win': nrm(ks[2], (L, DEC_BATCH, lw, H_ATTN, HEAD_DIM), 1.0),
        'cache_v_win': nrm(ks[3], (L, DEC_BATCH, lw, H_ATTN, HEAD_DIM), 1.0),
        'state_wkv': nrm(ks[4], (L, DEC_BATCH, H_RWKV, HEAD_DIM, HEAD_DIM), 0.3),
        'state_shift': nrm(ks[5], (L, DEC_BATCH, N_SHIFT), 1.0),
        'bias_table': nrm(ks[6], (NUM_BUCKETS, H_ATTN), 0.5),
        'ln1_g': 1.0 + nrm(ks[7], (L, D_MODEL), 0.02),
        'w_in': nrm(ks[8], (L, D_MODEL, N_IN), D_MODEL ** -0.5),
        'q_norm_g': 1.0 + nrm(ks[9], (L, HEAD_DIM), 0.02),
        'k_norm_g': 1.0 + nrm(ks[10], (L, HEAD_DIM), 0.02),
        'mu_shift': jax.random.uniform(ks[11], (L, N_SHIFT), f32),
        'w0': jax.random.uniform(ks[12], (L, B_W), f32, -6.0, 1.0),
        'w_lora2': nrm(ks[13], (L, LORA_W, B_W), 0.1),
        'a0': nrm(ks[14], (L, B_W), 0.5),
        'a_lora2': nrm(ks[15], (L, LORA_A, B_W), 0.1),
        'g_lora2': nrm(ks[16], (L, LORA_G, B_W), LORA_G ** -0.5),
        'k_k': 0.85 + nrm(ks[17], (L, B_W), 0.05),
        'k_a': 1.0 + nrm(ks[18], (L, B_W), 0.05),
        'r_k': nrm(ks[19], (L, H_RWKV, HEAD_DIM), 0.1),
        'lnx_g': 1.0 + nrm(ks[20], (L, B_W), 0.02),
        'lnx_b': nrm(ks[21], (L, B_W), 0.02),
        'w_out': nrm(ks[22], (L, D_MODEL, D_MODEL), D_MODEL ** -0.5),
        'ln2_g': 1.0 + nrm(ks[23], (L, D_MODEL), 0.02),
        'w_mlp1': nrm(ks[24], (L, D_MODEL, D_FF), D_MODEL ** -0.5),
        'w_mlp2': nrm(ks[25], (L, D_FF, D_MODEL), D_FF ** -0.5),
    }


def reference(x_prompt, x_sample, cache_k_win, cache_v_win, state_wkv, state_shift, bias_table,
              ln1_g, w_in, q_norm_g, k_norm_g, mu_shift, w0, w_lora2, a0, a_lora2, g_lora2,
              k_k, k_a, r_k, lnx_g, lnx_b, w_out, ln2_g, w_mlp1, w_mlp2):
    yp, ys = x_prompt, x_sample
    Bp, Tp, _ = x_prompt.shape
    keep = min(MAX_WINDOW, Tp)
    kp_l, vp_l, sp_l, hp_l = [], [], [], []
    ks_l, vs_l, ss_l, hs_l = [], [], [], []
    for l in range(DEPTH):
        lw = (ln1_g[l], w_in[l], q_norm_g[l], k_norm_g[l], mu_shift[l], w0[l], w_lora2[l], a0[l],
              a_lora2[l], g_lora2[l], k_k[l], k_a[l], r_k[l], lnx_g[l], lnx_b[l], w_out[l], ln2_g[l],
              w_mlp1[l], w_mlp2[l])
        empty = jnp.zeros((Bp, 0, H_ATTN, HEAD_DIM), yp.dtype)
        yp, k_p, v_p, s_p, h_p = decoder_layer(
            yp, empty, empty, jnp.zeros((Bp, H_RWKV, HEAD_DIM, HEAD_DIM), f32),
            jnp.zeros((Bp, N_SHIFT), yp.dtype), bias_table, *lw)
        kp_l.append(k_p[:, Tp - keep:])
        vp_l.append(v_p[:, Tp - keep:])
        sp_l.append(s_p)
        hp_l.append(h_p)
        ys, k_s, v_s, s_s, h_s = decoder_layer(
            ys, cache_k_win[l], cache_v_win[l], state_wkv[l], state_shift[l], bias_table, *lw)
        ks_l.append(k_s)
        vs_l.append(v_s)
        ss_l.append(s_s)
        hs_l.append(h_s)
    return (yp, ys, jnp.stack(kp_l), jnp.stack(vp_l), jnp.stack(sp_l), jnp.stack(hp_l),
            jnp.stack(ks_l), jnp.stack(vs_l), jnp.stack(ss_l), jnp.stack(hs_l))
```

```cpp
#include <hip/hip_runtime.h>
#include <cstdio>
#include <cstdint>
#include <cmath>
namespace pg8 {
#define PG8_LAS __attribute__((address_space(3)))
typedef unsigned short bf16_t;
typedef short bf16x8 __attribute__((ext_vector_type(8)));
typedef float f32x4 __attribute__((ext_vector_type(4)));
typedef unsigned u32x4 __attribute__((ext_vector_type(4)));
constexpr int BM = 256, BK = 64, HALF = 128, HTB = HALF * BK * 2  , STAGE_BYTES = 8 * HTB, NXCD = 8, WGM = 8;

__host__ __device__ __forceinline__ int lds_byte(int r, int c) { const int st = (r >> 4) * 2 + (c >> 5), rr = r & 15, cc = c & 31, ob = rr * 64 + cc * 2; return st * 1024 + (ob ^ (((ob >> 9) & 1) << 5)); }
__host__ __device__ __forceinline__ void stage_rc(int b, int& R, int& C) { const int st = b / 1024, sb = b % 1024, swz = sb ^ (((sb >> 9) & 1) << 5); R = (st >> 1) * 16 + swz / 64; C = (st & 1) * 32 + (swz % 64) / 2; }
__host__ __device__ __forceinline__ int perm32(int rho) { const int n = rho >> 4, i = rho & 15; return 8 * (i >> 2) + 4 * n + (i & 3); }

struct Unit { int pm, pn; };
struct Gemm { const bf16_t* A; const bf16_t* Bt; int M, N, K; };

struct StaticOrder {
    int nM, nN, nwg, G, c;
    __host__ __device__ void init(int M, int N, int G_, int c_) { nM = M / BM; nN = N / BM; nwg = nM * nN; G = G_; c = c_; }
    __host__ __device__ bool next(int i, Unit& u) const {
        const long L = (long)i * G + c; if (L >= nwg) return false;
        int wgid = (int)L; { const int q = nwg / NXCD, r = nwg % NXCD, xcd = wgid % NXCD, off = wgid / NXCD; wgid = (xcd < r ? xcd * (q + 1) : r * (q + 1) + (xcd - r) * q) + off; }
        const int nig = WGM * nN, gid = wgid / nig, fm = gid * WGM, gsz = (nM - fm) < WGM ? (nM - fm) : WGM;
        u.pm = fm + ((wgid % nig) % gsz); u.pn = (wgid % nig) / gsz; return true;
    }
    __device__ __forceinline__ void a_ready(const Unit&) const {}
    __device__ __forceinline__ void done(const Unit&) const {}
};

__device__ __forceinline__ unsigned cvt_pk_bf16(float lo, float hi) { unsigned r; asm volatile("v_cvt_pk_bf16_f32 %0, %1, %2" : "=v"(r) : "v"(lo), "v"(hi)); return r; }
typedef float f32x2 __attribute__((ext_vector_type(2)));
struct EpiF32 {
    static constexpr bool PERM = false, AFTER_DRAIN = false;
    float* C; int ldc;
    __device__ __forceinline__ void operator()(const f32x4 (&acc)[2][2][4][2], const Unit& u, int wr, int wc, int fr, int fq) const {
        const int row0 = u.pm * BM + wr * 64 + fr, col0 = u.pn * BM + wc * 32 + 4 * fq;
#pragma unroll
        for (int ai = 0; ai < 2; ++ai)
#pragma unroll
            for (int m = 0; m < 4; ++m) { float* rowp = C + (size_t)(row0 + ai * HALF + m * 16) * ldc + col0;
#pragma unroll
                for (int bj = 0; bj < 2; ++bj)
#pragma unroll
                    for (int n = 0; n < 2; ++n) *(f32x4*)(rowp + bj * HALF + n * 16) = acc[ai][bj][m][n]; }
    }
};
struct EpiHRes {
    static constexpr bool PERM = false, AFTER_DRAIN = false;
    const float* xp; const float* xs; float* out; bf16_t* hb; float* ssq; int mp;
    __device__ __forceinline__ void operator()(const f32x4 (&acc)[2][2][4][2], const Unit& u, int wr, int wc, int fr, int fq) const {
        const int row0 = u.pm * BM + wr * 64 + fr, col0 = u.pn * BM + wc * 32 + 4 * fq;
#pragma unroll
        for (int ai = 0; ai < 2; ++ai)
#pragma unroll
            for (int m = 0; m < 4; ++m) {
                const int row = row0 + ai * HALF + m * 16;
                const float* xrow = (row < mp ? xp + (size_t)row * 1024 : xs + (size_t)(row - mp) * 1024) + col0;
                float* orow = out + (size_t)row * 1024 + col0; bf16_t* hrow = hb + (size_t)row * 1024 + col0;
                float s = 0.f;
#pragma unroll
                for (int bj = 0; bj < 2; ++bj)
#pragma unroll
                    for (int n = 0; n < 2; ++n) {
                        const f32x4 h = acc[ai][bj][m][n] + *(const f32x4*)(xrow + bj * HALF + n * 16);
                        *(f32x4*)(orow + bj * HALF + n * 16) = h;
                        unsigned long long w = (unsigned long long)cvt_pk_bf16(h[0], h[1]) | ((unsigned long long)cvt_pk_bf16(h[2], h[3]) << 32);
                        *(unsigned long long*)(hrow + bj * HALF + n * 16) = w;
                        s += (h[0] * h[0] + h[1] * h[1]) + (h[2] * h[2] + h[3] * h[3]);
                    }
                s += __shfl_xor(s, 16); s += __shfl_xor(s, 32);
                if (fq == 0) atomicAdd(ssq + row, s);
            }
    }
};
struct EpiRelu2 {
    static constexpr bool PERM = true, AFTER_DRAIN = false;
    bf16_t* O; int ldc; const float* ssq;
    __device__ __forceinline__ void operator()(const f32x4 (&acc)[2][2][4][2], const Unit& u, int wr, int wc, int fr, int fq) const {
        const int row0 = u.pm * BM + wr * 64 + fr, col0 = u.pn * BM + wc * 32 + 8 * fq;
#pragma unroll
        for (int ai = 0; ai < 2; ++ai)
#pragma unroll
            for (int m = 0; m < 4; ++m) {
                const int row = row0 + ai * HALF + m * 16;
                const float rs = __builtin_amdgcn_rsqf(ssq[row] * (1.0f / 1024.0f) + 1e-6f);
                bf16_t* rowp = O + (size_t)row * ldc + col0;
#pragma unroll
                for (int bj = 0; bj < 2; ++bj) {
                    f32x4 v0 = acc[ai][bj][m][0] * rs, v1 = acc[ai][bj][m][1] * rs;
#pragma unroll
                    for (int j = 0; j < 4; ++j) { const float a = fmaxf(v0[j], 0.f), b = fmaxf(v1[j], 0.f); v0[j] = a * a; v1[j] = b * b; }
                    u32x4 w; w.x = cvt_pk_bf16(v0[0], v0[1]); w.y = cvt_pk_bf16(v0[2], v0[3]); w.z = cvt_pk_bf16(v1[0], v1[1]); w.w = cvt_pk_bf16(v1[2], v1[3]);
                    *(u32x4*)(rowp + bj * HALF) = w;
                }
            }
    }
};
struct EpiAddOut {
    static constexpr bool PERM = false, AFTER_DRAIN = false;
    float* C; int ldc;
    __device__ __forceinline__ void operator()(const f32x4 (&acc)[2][2][4][2], const Unit& u, int wr, int wc, int fr, int fq) const {
        const int row0 = u.pm * BM + wr * 64 + fr, col0 = u.pn * BM + wc * 32 + 4 * fq;
#pragma unroll
        for (int ai = 0; ai < 2; ++ai)
#pragma unroll
            for (int m = 0; m < 4; ++m) { float* rowp = C + (size_t)(row0 + ai * HALF + m * 16) * ldc + col0;
#pragma unroll
                for (int bj = 0; bj < 2; ++bj)
#pragma unroll
                    for (int n = 0; n < 2; ++n) { f32x4* p = (f32x4*)(rowp + bj * HALF + n * 16); *p = *p + acc[ai][bj][m][n]; } }
    }
};

template <class Epi, class Sched, bool ALIGN_EPI = false, bool SP2 = false>
__device__ __forceinline__ void gemm_phase(PG8_LAS unsigned char* lds, const Gemm g, const Sched& S, const Epi& E) {
    const int tid = threadIdx.x, wid = __builtin_amdgcn_readfirstlane(tid >> 6), lane = tid & 63, wr = wid >> 2, wc = wid & 3, fr = lane & 15, fq = lane >> 4;
    const int K = g.K, nt = K / BK;
    unsigned voffA[2], voffB[2];
#pragma unroll
    for (int i = 0; i < 2; ++i) { int R, C; stage_rc(tid * 16 + i * 8192, R, C); const int Rb = Epi::PERM ? ((R & ~31) + perm32(R & 31)) : R;
        voffA[i] = (unsigned)(R * K + C) * 2u; voffB[i] = (unsigned)(Rb * K + C) * 2u; }
    const size_t kstep = (size_t)(BK * 2);
    const size_t hstep = (size_t)HALF * K * 2;
    const size_t tstep = 2 * hstep;
    const unsigned ldsw = (unsigned)wid * 1024u;
    const int aoff = lds_byte(wr * 64 + fr, fq * 8), boff = lds_byte(wc * 32 + fr, fq * 8);
#define PG8_SA(b, h) (((b) * 2 + (h)) * HTB)
#define PG8_SB(b, h) ((4 + (b) * 2 + (h)) * HTB)
#define PG8_STAGE(bufoff, gbase, voff) do { _Pragma("unroll") for (int _i = 0; _i < 2; ++_i) \
        __builtin_amdgcn_global_load_lds((const unsigned*)((const char*)(gbase) + (voff)[_i]), (PG8_LAS unsigned*)(lds + (bufoff) + ldsw + _i * 8192), 16, 0, 0); } while (0)
#define PG8_LDA(dst, b, h) do { _Pragma("unroll") for (int m = 0; m < 4; ++m) _Pragma("unroll") for (int k = 0; k < 2; ++k) dst[m][k] = *(const PG8_LAS bf16x8*)(lds + PG8_SA(b, h) + aoff + m * 2048 + k * 1024); } while (0)
#define PG8_LDB(dst, b, h) do { _Pragma("unroll") for (int n = 0; n < 2; ++n) _Pragma("unroll") for (int k = 0; k < 2; ++k) dst[n][k] = *(const PG8_LAS bf16x8*)(lds + PG8_SB(b, h) + boff + n * 2048 + k * 1024); } while (0)
#define PG8_MMA(ai, bj, At, Bt) do { __builtin_amdgcn_s_setprio(1); _Pragma("unroll") for (int m = 0; m < 4; ++m) _Pragma("unroll") for (int n = 0; n < 2; ++n) _Pragma("unroll") for (int k = 0; k < 2; ++k) \
        acc[ai][bj][m][n] = __builtin_amdgcn_mfma_f32_16x16x32_bf16(Bt[n][k], At[m][k], acc[ai][bj][m][n], 0, 0, 0); __builtin_amdgcn_s_setprio(0); } while (0)
#define PG8_WAIT_V(n) asm volatile("s_waitcnt vmcnt(" #n ")" ::: "memory")
#define PG8_WAIT_L(n) asm volatile("s_waitcnt lgkmcnt(" #n ")" ::: "memory")
#define PG8_BAR __builtin_amdgcn_s_barrier()
#define PG8_SCHED __builtin_amdgcn_sched_barrier(0)
    Unit cur, nxt; int ui = 0;
    if (!S.next(0, cur)) return;
    f32x4 acc[2][2][4][2];
#pragma unroll
    for (int a = 0; a < 2; ++a)
#pragma unroll
        for (int b = 0; b < 2; ++b)
#pragma unroll
            for (int m = 0; m < 4; ++m)
#pragma unroll
                for (int n = 0; n < 2; ++n) acc[a][b][m][n] = (f32x4){0.f, 0.f, 0.f, 0.f};
    bf16x8 At[4][2], B0[2][2], B1[2][2];
    const char* cA = (const char*)g.A + (size_t)cur.pm * tstep; const char* cB = (const char*)g.Bt + (size_t)cur.pn * tstep;
    S.a_ready(cur);
    if constexpr (SP2) {
        PG8_STAGE(PG8_SB(0, 0), cB, voffB); PG8_STAGE(PG8_SB(0, 1), cB + hstep, voffB); PG8_STAGE(PG8_SA(0, 0), cA, voffA); PG8_STAGE(PG8_SA(0, 1), cA + hstep, voffA);
        if (wr == 1) PG8_BAR;
        PG8_WAIT_V(2); PG8_BAR;
        PG8_STAGE(PG8_SB(1, 0), cB + kstep, voffB); PG8_STAGE(PG8_SA(1, 0), cA + kstep, voffA); PG8_STAGE(PG8_SB(1, 1), cB + hstep + kstep, voffB);
        PG8_WAIT_V(6); PG8_BAR;
    } else {
        PG8_STAGE(PG8_SB(0, 0), cB, voffB); PG8_STAGE(PG8_SA(0, 0), cA, voffA); PG8_STAGE(PG8_SB(0, 1), cB + hstep, voffB); PG8_STAGE(PG8_SA(0, 1), cA + hstep, voffA);
        if (wr == 1) PG8_BAR;
        PG8_WAIT_V(4); PG8_BAR;
        PG8_STAGE(PG8_SB(1, 0), cB + kstep, voffB); PG8_STAGE(PG8_SA(1, 0), cA + kstep, voffA); PG8_STAGE(PG8_SB(1, 1), cB + hstep + kstep, voffB);
        PG8_WAIT_V(6); PG8_BAR;
    }
    for (;;) {
        const bool has_next = S.next(ui + 1, nxt);
        const char* nA = has_next ? (const char*)g.A + (size_t)nxt.pm * tstep : cA; const char* nB = has_next ? (const char*)g.Bt + (size_t)nxt.pn * tstep : cB;
        for (int t = 0; t < nt; t += 2) {
            const bool last = (t == nt - 2);
            const char* a1 = cA + (size_t)(t + 1) * kstep;
            const char* a2 = last ? nA : cA + (size_t)(t + 2) * kstep; const char* b2 = last ? nB : cB + (size_t)(t + 2) * kstep;
            const char* a3 = a2 + kstep; const char* b3 = b2 + kstep;
            if (last && has_next) S.a_ready(nxt);
            if constexpr (SP2) {
            PG8_LDB(B0, 0, 0); PG8_LDB(B1, 0, 1); PG8_SCHED; PG8_LDA(At, 0, 0); PG8_STAGE(PG8_SA(1, 1), a1 + hstep, voffA);
            PG8_WAIT_V(8); PG8_WAIT_L(0); PG8_BAR; PG8_MMA(0, 0, At, B0); PG8_MMA(0, 1, At, B1); PG8_BAR; PG8_SCHED;
            PG8_LDA(At, 0, 1); PG8_STAGE(PG8_SB(0, 0), b2, voffB); PG8_STAGE(PG8_SB(0, 1), b2 + hstep, voffB); PG8_STAGE(PG8_SA(0, 0), a2, voffA);
            PG8_WAIT_V(8); PG8_WAIT_L(0); PG8_BAR; PG8_MMA(1, 0, At, B0); PG8_MMA(1, 1, At, B1); PG8_BAR; PG8_SCHED;
            PG8_LDB(B0, 1, 0); PG8_LDB(B1, 1, 1); PG8_SCHED; PG8_LDA(At, 1, 0); PG8_STAGE(PG8_SA(0, 1), a2 + hstep, voffA);
            PG8_WAIT_V(8); PG8_WAIT_L(0); PG8_BAR; PG8_MMA(0, 0, At, B0); PG8_MMA(0, 1, At, B1); PG8_BAR; PG8_SCHED;
            PG8_LDA(At, 1, 1); PG8_STAGE(PG8_SB(1, 0), b3, voffB); PG8_STAGE(PG8_SB(1, 1), b3 + hstep, voffB); PG8_STAGE(PG8_SA(1, 0), a3, voffA);
            PG8_WAIT_V(8); PG8_WAIT_L(0); PG8_BAR; PG8_MMA(1, 0, At, B0); PG8_MMA(1, 1, At, B1); PG8_BAR; PG8_SCHED;
            } else {
            PG8_LDB(B0, 0, 0); PG8_SCHED; PG8_LDA(At, 0, 0); PG8_STAGE(PG8_SA(1, 1), a1 + hstep, voffA);
            PG8_WAIT_L(8); PG8_BAR; PG8_WAIT_L(0); PG8_MMA(0, 0, At, B0); PG8_BAR; PG8_SCHED;
            PG8_LDB(B1, 0, 1); PG8_STAGE(PG8_SB(0, 0), b2, voffB);
            PG8_BAR; PG8_WAIT_L(0); PG8_MMA(0, 1, At, B1); PG8_BAR;
            PG8_LDA(At, 0, 1); PG8_STAGE(PG8_SA(0, 0), a2, voffA);
            PG8_BAR; PG8_WAIT_L(0); PG8_MMA(1, 0, At, B0); PG8_BAR; PG8_SCHED;
            PG8_STAGE(PG8_SB(0, 1), b2 + hstep, voffB);
            PG8_WAIT_V(6); PG8_BAR; PG8_MMA(1, 1, At, B1); PG8_BAR;
            PG8_LDB(B0, 1, 0); PG8_SCHED; PG8_LDA(At, 1, 0); PG8_STAGE(PG8_SA(0, 1), a2 + hstep, voffA);
            PG8_WAIT_L(8); PG8_BAR; PG8_WAIT_L(0); PG8_MMA(0, 0, At, B0); PG8_BAR; PG8_SCHED;
            PG8_LDB(B1, 1, 1); PG8_STAGE(PG8_SB(1, 0), b3, voffB);
            PG8_BAR; PG8_WAIT_L(0); PG8_MMA(0, 1, At, B1); PG8_BAR;
            PG8_LDA(At, 1, 1); PG8_STAGE(PG8_SA(1, 0), a3, voffA);
            PG8_BAR; PG8_WAIT_L(0); PG8_MMA(1, 0, At, B0); PG8_BAR; PG8_SCHED;
            PG8_STAGE(PG8_SB(1, 1), b3 + hstep, voffB);
            PG8_WAIT_V(6); PG8_BAR; PG8_MMA(1, 1, At, B1); PG8_BAR;
            }
        }
        if constexpr (ALIGN_EPI) { if (wr == 0) PG8_BAR; }
        if constexpr (!Epi::AFTER_DRAIN) { E(acc, cur, wr, wc, fr, fq); S.done(cur); }
        if (!has_next) break;
#pragma unroll
        for (int a = 0; a < 2; ++a)
#pragma unroll
            for (int b = 0; b < 2; ++b)
#pragma unroll
                for (int m = 0; m < 4; ++m)
#pragma unroll
                    for (int n = 0; n < 2; ++n) acc[a][b][m][n] = (f32x4){0.f, 0.f, 0.f, 0.f};
        cur = nxt; cA = nA; cB = nB; ++ui;
        if constexpr (ALIGN_EPI) { if (wr == 1) PG8_BAR; }
    }
    PG8_WAIT_V(0);
    if constexpr (!ALIGN_EPI) { if (wr == 0) PG8_BAR; }
    PG8_BAR;
    if constexpr (Epi::AFTER_DRAIN) { E.fused(acc, cur, wr, wc, fr, fq, lds, wid, lane); S.done(cur); }
#undef PG8_SA
#undef PG8_SB
#undef PG8_STAGE
#undef PG8_LDA
#undef PG8_LDB
#undef PG8_MMA
#undef PG8_WAIT_V
#undef PG8_WAIT_L
#undef PG8_BAR
#undef PG8_SCHED
}
}
#define GAS __attribute__((address_space(1)))
#define LAS __attribute__((address_space(3)))
typedef unsigned short bf16;
typedef unsigned v4u __attribute__((ext_vector_type(4)));
typedef float f32x4 __attribute__((ext_vector_type(4)));
typedef short bf16x8 __attribute__((ext_vector_type(8)));
typedef GAS unsigned gu32;
typedef GAS unsigned long long gu64;
#define RLX_AGENT __ATOMIC_RELAXED, __HIP_MEMORY_SCOPE_AGENT
#define LDS_WAIT() asm volatile("s_waitcnt lgkmcnt(0)" ::: "memory")
#define VM_WAIT() asm volatile("s_waitcnt vmcnt(0)" ::: "memory")
__device__ __forceinline__ unsigned long long rt() { return __builtin_amdgcn_s_memrealtime(); }
__device__ __forceinline__ unsigned f2bf(float f) { unsigned u = __builtin_bit_cast(unsigned, f); return (u + 0x7fffu + ((u >> 16) & 1u)) >> 16; }
__device__ __forceinline__ unsigned pk2(float lo, float hi) { return f2bf(lo) | (f2bf(hi) << 16); }

#define XB_TMO      128
#define XB_XCNT(j)  (256  + 64 * (j))
#define XB_XSUB(j)  (1280 + 64 * (j))
#define XB_XGEN(j)  (2304 + 64 * (j))
#define XB_TOP      3328
#define XB_TOPGEN   3392
#define XCD_BAR_WORDS 3456
#define XB_SPIN_CAP (1u << 18)

__device__ __forceinline__ unsigned xb_ld(unsigned* p)              { return __hip_atomic_load(p, __ATOMIC_RELAXED, __HIP_MEMORY_SCOPE_AGENT); }
__device__ __forceinline__ unsigned xb_add(unsigned* p, unsigned v) { return __hip_atomic_fetch_add(p, v, __ATOMIC_RELAXED, __HIP_MEMORY_SCOPE_AGENT); }
__device__ __forceinline__ unsigned xb_xcc_id() { return (unsigned)__builtin_amdgcn_s_getreg((3 << 11) | 20) & 0xFu; }
#define XB_SPIN(cond, bar) do { unsigned _sp = 0; while (cond) { __builtin_amdgcn_s_sleep(1); \
    if ((++_sp & 255u) == 0u) { if (xb_ld(&(bar)[XB_TMO])) break; if (_sp > XB_SPIN_CAP) { atomicAdd(&(bar)[XB_TMO], 1u); break; } } } } while (0)

struct XcdBarrier {
    unsigned* bar; unsigned x;
    volatile LAS unsigned* st;
};

__device__ __forceinline__ XcdBarrier xcd_barrier_post(unsigned* bar, volatile LAS unsigned* st) {
    XcdBarrier b; b.bar = bar; b.x = xb_xcc_id(); b.st = st;
    if (threadIdx.x == 0) (void)xb_add(&bar[XB_XCNT(b.x)], 1u);
    return b;
}
__device__ __forceinline__ void xcd_barrier_complete(unsigned* bar, unsigned x, unsigned& nloc, unsigned& nx) {
    const unsigned G = gridDim.x * gridDim.y * gridDim.z;
    unsigned sum, cnt, mine, sp = 0u;
    for (;;) {
        sum = 0u; cnt = 0u; mine = 0u;
#pragma unroll
        for (unsigned j = 0; j < 16; ++j) { const unsigned c = xb_ld(&bar[XB_XCNT(j)]); sum += c; cnt += (c > 0u) ? 1u : 0u; mine = (j == x) ? c : mine; }
        if (sum == G) break;
        __builtin_amdgcn_s_sleep(1);
        if ((++sp & 255u) == 0u) { if (xb_ld(&bar[XB_TMO])) break; if (sp > XB_SPIN_CAP) { atomicAdd(&bar[XB_TMO], 1u); break; } }
    }
    nloc = mine > 0u ? mine : 1u; nx = cnt > 0u ? cnt : 1u;
}

__device__ __forceinline__ void xcd_barrier(const XcdBarrier& b) {
    asm volatile("s_waitcnt vmcnt(0)" ::: "memory");
    __syncthreads();
    if (threadIdx.x == 0) {
        unsigned* bar = b.bar;
        __builtin_amdgcn_s_waitcnt(0);
        unsigned nloc = b.st[0], nx = b.st[1];
        if (nloc == 0u) { xcd_barrier_complete(bar, b.x, nloc, nx); b.st[0] = nloc; b.st[1] = nx; }
        const unsigned old = xb_add(&bar[XB_XSUB(b.x)], 1u);
        const unsigned gen = old / nloc;
        if (old + 1u == (gen + 1u) * nloc) {
            __builtin_amdgcn_fence(__ATOMIC_RELEASE, "agent");
            asm volatile("s_waitcnt vmcnt(0)" ::: "memory");
            const unsigned og = xb_add(&bar[XB_TOP], 1u);
            const unsigned tg = og / nx;
            if (og + 1u == (tg + 1u) * nx) xb_add(&bar[XB_TOPGEN], 1u);
            else XB_SPIN(xb_ld(&bar[XB_TOPGEN]) == tg, bar);
            __builtin_amdgcn_fence(__ATOMIC_ACQUIRE, "agent");
            xb_add(&bar[XB_XGEN(b.x)], 1u);
            asm volatile("s_waitcnt vmcnt(0)" ::: "memory");
        } else {
            XB_SPIN(xb_ld(&bar[XB_XGEN(b.x)]) == gen, bar);
            __builtin_amdgcn_fence(__ATOMIC_ACQUIRE, "agent");
            asm volatile("s_waitcnt vmcnt(0)" ::: "memory");
        }
    }
    __syncthreads();
}
constexpr int NWAVES = 8, NTHR = 512;
constexpr int D = 1024, BATCH = 8, SEQ = 8192, MP = BATCH * SEQ, SBATCH = 128, STOK = 8, MS = SBATCH * STOK, M = MP + MS;
constexpr int AW = 512, HD = 64, NH = 8, NSHIFT = 1824, NIN = 3360, NINP = 3584, FF = 4096, LWIN = 2048;
constexpr int C_Q = 0, C_K = 512, C_V = 1024, C_P = 1536;
constexpr float RMS_EPS = 1e-6f, GN_EPS = 64e-5f;
constexpr size_t O_YP = 0, O_YS = 67108864, O_KWP = 68157440, O_VWP = 76546048, O_WKVP = 84934656, O_SHP = 85196800, O_KNS = 85211392, O_VNS = 85735680, O_WKVS = 86259968, O_SHS = 90454272, O_END = 90687744;
constexpr size_t MiB = 1u << 20;
constexpr size_t WS_CTL = 0, CTL_ZERO_BYTES = 1 * MiB;
constexpr size_t WS_SSQ = 256 * 1024;
constexpr size_t WS_WIN = 2 * MiB, WS_WO = 10 * MiB, WS_W1 = 12 * MiB, WS_W2 = 20 * MiB;
constexpr size_t WS_XN = 32 * MiB;
constexpr size_t WS_PROJ = 162 * MiB;
constexpr size_t WS_RW = 1072 * MiB;
constexpr size_t RW_STRIDE = 130 * MiB;
constexpr size_t WS_END = WS_RW + 7 * RW_STRIDE;
static_assert(WS_SSQ + (size_t)M * 4 <= CTL_ZERO_BYTES && WS_XN + (size_t)M * 1024 * 2 <= WS_PROJ && WS_PROJ + (size_t)M * NINP * 4 <= WS_RW && (size_t)M * 512 * 4 <= RW_STRIDE && WS_END <= 2048 * MiB, "ws map");
constexpr int CW_TMO = 0, CW_BAR = 4096;
constexpr int RING_OFF = 0, RING_BYTES = 131072, LDSCTL_OFF = RING_BYTES, MISC_OFF = LDSCTL_OFF + 320, LDS_BYTES = 147456;

struct Args { const float* in[26]; float* out; unsigned char* ws; int ph_lo, ph_hi, pad0, pad1; };

struct Frame {
    LAS unsigned char* lds; volatile LAS unsigned* MISC; gu32* ctl;
    int tid, lane, wave, vcu, G;
};
__device__ __forceinline__ float wave_sum(float v) {
#pragma unroll
    for (int o = 1; o < 64; o <<= 1) v += __shfl_xor(v, o);
    return v;
}
__device__ __forceinline__ float wave_max(float v) {
#pragma unroll
    for (int o = 1; o < 64; o <<= 1) v = fmaxf(v, __shfl_xor(v, o));
    return v;
}
__device__ __forceinline__ void p0_transpose_item(const float* W, int K, int N, bf16* WT, const float* ks, LAS float* scr, int item, int lane) {
    const int nblk = N / 32, kb = item / nblk, nb = item % nblk, k0 = 64 * kb, n0 = 32 * nb;
#pragma unroll 8
    for (int i = 0; i < 32; ++i) { const int kk = 2 * i + (lane >> 5); float w = W[(size_t)(k0 + kk) * N + n0 + (lane & 31)]; if (ks) w *= ks[k0 + kk]; scr[kk * 33 + (lane & 31)] = w; }
    LDS_WAIT(); asm volatile("" ::: "memory");
    const int c = lane & 7;
#pragma unroll
    for (int j = 0; j < 4; ++j) { const int n = (lane >> 3) + 8 * j; const LAS float* s = scr + (8 * c) * 33 + n;
        v4u o; o.x = pk2(s[0 * 33], s[1 * 33]); o.y = pk2(s[2 * 33], s[3 * 33]); o.z = pk2(s[4 * 33], s[5 * 33]); o.w = pk2(s[6 * 33], s[7 * 33]);
        *(GAS v4u*)(WT + (size_t)(n0 + n) * K + k0 + 8 * c) = o; }
    LDS_WAIT(); asm volatile("" ::: "memory");
}

__device__ __forceinline__ void p0_prologue(Frame& F, const Args& A) {
    unsigned char* ws = A.ws;
    bf16* WIN = (bf16*)(ws + WS_WIN); bf16* WO = (bf16*)(ws + WS_WO); bf16* W1 = (bf16*)(ws + WS_W1); bf16* W2 = (bf16*)(ws + WS_W2); bf16* XN = (bf16*)(ws + WS_XN);
    LAS float* scr = (LAS float*)(F.lds + RING_OFF + F.wave * 16384);
    const int gw = F.vcu * NWAVES + F.wave, NGW = F.G * NWAVES;
    constexpr int I_IN = (D / 64) * (NIN / 32), I_O = (D / 64) * (D / 32), I_1 = (D / 64) * (FF / 32), I_2 = (FF / 64) * (D / 32);
    constexpr int NITEMS = I_IN + I_O + I_1 + I_2;
    for (int it = gw; it < NITEMS; it += NGW) {
        int r = it;
        if (r < I_IN) { p0_transpose_item(A.in[8], D, NIN, WIN, nullptr, scr, r, F.lane); continue; } r -= I_IN;
        if (r < I_O) { p0_transpose_item(A.in[22], D, D, WO, nullptr, scr, r, F.lane); continue; } r -= I_O;
        if (r < I_1) { p0_transpose_item(A.in[24], D, FF, W1, A.in[23], scr, r, F.lane); continue; } r -= I_1;
        p0_transpose_item(A.in[25], FF, D, W2, nullptr, scr, r, F.lane);
    }
    { GAS v4u* z = (GAS v4u*)(WIN + (size_t)NIN * D); const int n16 = (NINP - NIN) * D * 2 / 16;
      for (int i = (F.vcu * NTHR + F.tid); i < n16; i += F.G * NTHR) z[i] = (v4u){0u, 0u, 0u, 0u}; }
    const float* g1 = A.in[7];
    for (int m = gw; m < M; m += NGW) {
        const float* xrow = (m < MP) ? A.in[0] + (size_t)m * D : A.in[1] + (size_t)(m - MP) * D;
        const GAS f32x4* xr = (const GAS f32x4*)xrow + F.lane; const GAS f32x4* gr = (const GAS f32x4*)g1 + F.lane;
        f32x4 v[4]; float s = 0.f;
#pragma unroll
        for (int j = 0; j < 4; ++j) { v[j] = xr[64 * j]; s += (v[j].x * v[j].x + v[j].y * v[j].y) + (v[j].z * v[j].z + v[j].w * v[j].w); }
        const float rstd = 1.0f / sqrtf(wave_sum(s) * (1.f / D) + RMS_EPS);
        GAS unsigned long long* o8 = (GAS unsigned long long*)(XN + (size_t)m * D) + F.lane;
#pragma unroll
        for (int j = 0; j < 4; ++j) { const f32x4 g = gr[64 * j]; o8[64 * j] = (unsigned long long)pk2(v[j].x * rstd * g.x, v[j].y * rstd * g.y) | ((unsigned long long)pk2(v[j].z * rstd * g.z, v[j].w * rstd * g.w) << 32); }
    }
}

__device__ __forceinline__ void p2_post(Frame& F, const Args& A) {
    float* PROJ = (float*)(A.ws + WS_PROJ); float* out = A.out;
    const float* gq = A.in[9]; const float* gk = A.in[10];
    for (int it = F.vcu * NTHR + F.tid; it < M * NH * 2; it += F.G * NTHR) {
        const int isk = it & 1, h = (it >> 1) & 7, row = it >> 4;
        float* qp = PROJ + (size_t)row * NINP + h * 64 + (isk ? C_K : C_Q); const float* vp = PROJ + (size_t)row * NINP + h * 64 + C_V;
        const float* gg = isk ? gk : gq;
        f32x4 q[16]; float sq = 0.f;
#pragma unroll
        for (int j = 0; j < 16; ++j) { q[j] = ((const f32x4*)qp)[j]; sq += (q[j].x * q[j].x + q[j].y * q[j].y) + (q[j].z * q[j].z + q[j].w * q[j].w); }
        const float rq = 1.0f / sqrtf(sq * (1.f / 64.f) + RMS_EPS);
        float* ko = nullptr; float* vo = nullptr;
        if (isk) {
            if (row < MP) { const int b = row >> 13, t = row & 8191; if (t >= SEQ - LWIN) { const size_t o = ((size_t)(b * LWIN + (t - (SEQ - LWIN))) * NH + h) * 64; ko = out + O_KWP + o; vo = out + O_VWP + o; } }
            else { const size_t o = ((size_t)(row - MP) * NH + h) * 64; ko = out + O_KNS + o; vo = out + O_VNS + o; }
        }
#pragma unroll
        for (int j = 0; j < 16; ++j) { const f32x4 g1 = ((const f32x4*)gg)[j];
            q[j] = q[j] * rq * g1; ((f32x4*)qp)[j] = q[j];
            if (ko) { ((f32x4*)ko)[j] = q[j]; ((f32x4*)vo)[j] = ((const f32x4*)vp)[j]; } }
    }
    for (int it = F.vcu * NTHR + F.tid; it < (BATCH + SBATCH) * NSHIFT; it += F.G * NTHR) {
        const int s = it / NSHIFT, c = it % NSHIFT;
        if (s < BATCH) out[O_SHP + (size_t)s * NSHIFT + c] = PROJ[(size_t)(s * SEQ + SEQ - 1) * NINP + C_P + c];
        else out[O_SHS + (size_t)(s - BATCH) * NSHIFT + c] = PROJ[(size_t)(MP + (s - BATCH) * STOK + STOK - 1) * NINP + C_P + c];
    }
    LAS float* lin = (LAS float*)(F.lds + RING_OFF);
    float* RW = (float*)(A.ws + WS_RW); const size_t RS = RW_STRIDE / 4;
    const float* mu = A.in[11]; const float* w0 = A.in[12]; const float* wl2 = A.in[13]; const float* a0 = A.in[14]; const float* al2 = A.in[15]; const float* gl2 = A.in[16];
    const float* k_k = A.in[17]; const float* k_a = A.in[18]; const float* sshift = A.in[5];
    const int c = F.tid;
    for (int row = F.vcu; row < M; row += F.G) {
        const float* p = PROJ + (size_t)row * NINP + C_P; const float* pv = nullptr;
        if (row < MP) { if ((row & 8191) != 0) pv = p - NINP; }
        else { const int i = (row - MP) & 7, sb = (row - MP) >> 3; pv = (i == 0) ? sshift + (size_t)sb * NSHIFT : p - NINP; }
#define XS(cc) (p[cc] + ((pv ? pv[cc] : 0.f) - p[cc]) * mu[cc])
        if (c < 288) { const int cc = 1536 + c; const float x = XS(cc); float a;
            if (c < 64) a = tanhf(x); else if (c < 128) a = x; else a = 1.0f / (1.0f + expf(-x));
            lin[c] = a; }
        __syncthreads();
        const float r = XS(c), k = XS(512 + c), v = XS(1024 + c);
#undef XS
        float wl = w0[c], al = a0[c], g = 0.f;
#pragma unroll 4
        for (int m = 0; m < 64; ++m) { wl += lin[m] * wl2[m * 512 + c]; al += lin[64 + m] * al2[m * 512 + c]; }
#pragma unroll 4
        for (int m = 0; m < 160; ++m) g += lin[128 + m] * gl2[m * 512 + c];
        const float z = -wl; const float sp = (z > 20.f) ? z : log1pf(expf(z));
        const float wlog = -sp - 0.5f; const float dec = expf(-expf(wlog));
        const float a = 1.0f / (1.0f + expf(-al));
        const float kkv = k * k_k[c]; const float ss = wave_sum(kkv * kkv); const float kk = kkv / fmaxf(sqrtf(ss), 1e-12f);
        const float kp = k * (1.0f + (a - 1.0f) * k_a[c]);
        const size_t o = (size_t)row * 512 + c;
        RW[0 * RS + o] = r; RW[1 * RS + o] = dec; RW[2 * RS + o] = kp; RW[3 * RS + o] = v; RW[4 * RS + o] = kk; RW[5 * RS + o] = a; RW[6 * RS + o] = g;
        __syncthreads();
    }
}

__device__ __forceinline__ void p3_attn(Frame& F, const Args& A) {
    const float* PROJ = (const float*)(A.ws + WS_PROJ); bf16* MIX = (bf16*)(A.ws + WS_XN);
    const float* ck = A.in[2]; const float* cv = A.in[3]; const float* btab = A.in[6];
    LAS float* lut = (LAS float*)(F.lds + RING_OFF);
    LAS float* qs = (LAS float*)(F.lds + RING_OFF + 16384 + F.wave * 256);
    for (int i = F.tid; i < NH * 3 * 129; i += NTHR) { const int h = i / 387, r = i % 387, br = r / 129, j = r % 129; const int dist = j << (2 * br);
        int bk; if (dist < 16) bk = dist; else { bk = 16 + (int)(log((double)dist / 16.0) / log(128.0) * 16.0); if (bk > 31) bk = 31; }
        lut[i] = btab[bk * NH + h]; }
    __syncthreads();
    const int gw = F.vcu * NWAVES + F.wave, NGW = F.G * NWAVES; const int lane = F.lane;
    for (int it = gw; it < M * NH; it += NGW) {
        const int row = it >> 3, h = it & 7;
        const bool prompt = row < MP; const int b = prompt ? (row >> 13) : ((row - MP) >> 3); const int t = prompt ? (row & 8191) : ((row - MP) & 7);
        qs[lane] = PROJ[(size_t)row * NINP + h * 64 + lane];
        LDS_WAIT(); asm volatile("" ::: "memory");
        float mrun = -INFINITY, lrun = 0.f, o = 0.f;
        for (int rd = 0; rd < 7; ++rd) {
            int br, j;
            if (rd < 6) { br = rd >> 1; j = (rd & 1) * 64 + lane; } else { br = lane < 3 ? lane : 0; j = 128; }
            bool valid = (rd < 6) || (lane < 3);
            const int dist = j << (2 * br);
            const float* kptr = PROJ;
            if (prompt) { const int pos = t - dist; if (pos < 0) valid = false; else kptr = PROJ + (size_t)(b * SEQ + pos) * NINP + C_K + h * 64; }
            else { const int cpos = LWIN + t - dist; kptr = (cpos >= LWIN) ? PROJ + (size_t)(MP + b * STOK + (cpos - LWIN)) * NINP + C_K + h * 64 : ck + ((size_t)(b * LWIN + cpos) * NH + h) * 64; }
            float s = 0.f;
#pragma unroll
            for (int e4 = 0; e4 < 16; ++e4) { const f32x4 kv = ((const f32x4*)kptr)[e4]; const f32x4 qv = *(const LAS f32x4*)(qs + 4 * e4); s += (kv.x * qv.x + kv.y * qv.y) + (kv.z * qv.z + kv.w * qv.w); }
            s = valid ? (s * 0.125f + lut[h * 387 + br * 129 + j]) : -INFINITY;
            const float mr = wave_max(s); const float mnew = fmaxf(mrun, mr);
            const float sc = expf(mrun - mnew); const float pe = valid ? expf(s - mnew) : 0.f;
            lrun = lrun * sc + wave_sum(pe); o *= sc; mrun = mnew;
            const int nk = (rd < 6) ? 64 : 3;
            for (int l = 0; l < nk; ++l) {
                const float pl = __shfl(pe, l);
                if (pl != 0.f) {
                    int br2, j2; if (rd < 6) { br2 = rd >> 1; j2 = (rd & 1) * 64 + l; } else { br2 = l; j2 = 128; }
                    const int d2 = j2 << (2 * br2); const float* vptr;
                    if (prompt) vptr = PROJ + (size_t)(b * SEQ + (t - d2)) * NINP + C_V + h * 64;
                    else { const int cpos = LWIN + t - d2; vptr = (cpos >= LWIN) ? PROJ + (size_t)(MP + b * STOK + (cpos - LWIN)) * NINP + C_V + h * 64 : cv + ((size_t)(b * LWIN + cpos) * NH + h) * 64; }
                    o += pl * vptr[lane];
                }
            }
        }
        MIX[(size_t)row * D + h * 64 + lane] = (bf16)f2bf(o / lrun);
        asm volatile("" ::: "memory");
    }
}

__device__ __forceinline__ void p4_scan(Frame& F, const Args& A) {
    const float* RW = (const float*)(A.ws + WS_RW); const size_t RS = RW_STRIDE / 4; bf16* MIX = (bf16*)(A.ws + WS_XN);
    const float* r_k = A.in[19]; const float* lnx_g = A.in[20]; const float* lnx_b = A.in[21]; const float* wkv0 = A.in[4];
    LAS float* sh = (LAS float*)(F.lds + RING_OFF + F.wave * 2048);
    const int lane = F.lane;
    const int gw = F.wave * F.G + F.vcu, NGW = F.G * NWAVES;
    for (int it = gw; it < BATCH * NH + SBATCH * NH; it += NGW) {
        const bool prompt = it < BATCH * NH; const int sq = prompt ? (it >> 3) : ((it - BATCH * NH) >> 3), h = it & 7;
        const int T = prompt ? SEQ : STOK; const size_t row0 = prompt ? (size_t)sq * SEQ : (size_t)MP + (size_t)sq * STOK;
        float S[64];
        if (prompt) {
#pragma unroll
            for (int j = 0; j < 64; ++j) S[j] = 0.f;
        } else { const f32x4* s0 = (const f32x4*)(wkv0 + ((size_t)(sq * NH + h) * 64 + lane) * 64);
#pragma unroll
            for (int j = 0; j < 16; ++j) { const f32x4 v = s0[j]; S[4 * j] = v.x; S[4 * j + 1] = v.y; S[4 * j + 2] = v.z; S[4 * j + 3] = v.w; } }
        const int c = h * 64 + lane; const float rkc = r_k[c], lg = lnx_g[c], lb = lnx_b[c];
        for (int t = 0; t < T; ++t) {
            const size_t o = (row0 + t) * 512 + c;
            const float r = RW[o], dec = RW[RS + o], kp = RW[2 * RS + o], v = RW[3 * RS + o], kk = RW[4 * RS + o], a = RW[5 * RS + o], g = RW[6 * RS + o];
            sh[lane] = r; sh[64 + lane] = dec; sh[128 + lane] = kp; sh[192 + lane] = kk; sh[256 + lane] = kk * a;
            LDS_WAIT(); asm volatile("" ::: "memory");
            float sk = 0.f;
#pragma unroll
            for (int j = 0; j < 64; ++j) sk += S[j] * sh[192 + j];
            float y = 0.f;
#pragma unroll
            for (int j = 0; j < 64; ++j) { S[j] = S[j] * sh[64 + j] - sk * sh[256 + j] + v * sh[128 + j]; y += S[j] * sh[j]; }
            const float bon = wave_sum(r * kp * rkc);
            const float mean = wave_sum(y) * (1.f / 64.f); const float dv = y - mean; const float var = wave_sum(dv * dv) * (1.f / 64.f);
            const float yo = dv * (1.0f / sqrtf(var + GN_EPS)) * lg + lb;
            MIX[(row0 + t) * D + 512 + c] = (bf16)f2bf((yo + bon * v) * g);
            LDS_WAIT(); asm volatile("" ::: "memory");
        }
        float* so = A.out + (prompt ? O_WKVP : O_WKVS) + ((size_t)(sq * NH + h) * 64 + lane) * 64;
#pragma unroll
        for (int j = 0; j < 16; ++j) ((f32x4*)so)[j] = (f32x4){S[4 * j], S[4 * j + 1], S[4 * j + 2], S[4 * j + 3]};
    }
}

__global__ void __launch_bounds__(NTHR, 2) fwd(Args args) {
    extern __shared__ __attribute__((aligned(16))) unsigned char lds[];
    Frame F;
    F.lds = (LAS unsigned char*)lds; F.MISC = (volatile LAS unsigned*)(F.lds + MISC_OFF);
    F.tid = threadIdx.x; F.lane = F.tid & 63; F.wave = __builtin_amdgcn_readfirstlane(F.tid >> 6);
    F.G = gridDim.x; { const int bx = blockIdx.x; F.vcu = (F.G % 8 == 0) ? (bx % 8) * (F.G / 8) + bx / 8 : bx; }
    unsigned char* ws = args.ws; F.ctl = (gu32*)(ws + WS_CTL);
    for (int u = F.tid; u < (LDS_BYTES - LDSCTL_OFF) / 4; u += NTHR) ((LAS unsigned*)(F.lds + LDSCTL_OFF))[u] = 0u;
    __syncthreads();
    const int lo = args.ph_lo, hi = args.ph_hi; const bool multi = (hi - lo) > 1;
    XcdBarrier bar; bar.bar = (unsigned*)(F.ctl + CW_BAR); bar.x = 0; bar.st = nullptr;
    if (multi) bar = xcd_barrier_post((unsigned*)(F.ctl + CW_BAR), F.MISC + 8);
#define IN(k) (lo <= (k) && (k) < hi)
#define SEAM(k) do { if (IN(k) && IN((k) + 1)) xcd_barrier(bar); } while (0)
    bf16* WIN = (bf16*)(ws + WS_WIN); bf16* WO = (bf16*)(ws + WS_WO); bf16* W1 = (bf16*)(ws + WS_W1); bf16* W2 = (bf16*)(ws + WS_W2);
    bf16* XN = (bf16*)(ws + WS_XN); float* PROJ = (float*)(ws + WS_PROJ); bf16* HB = (bf16*)(ws + WS_PROJ); bf16* HBF = (bf16*)(ws + WS_RW); float* SSQ = (float*)(ws + WS_SSQ);
#ifndef SKIP_0
    if (IN(0)) { p0_prologue(F, args); SEAM(0); }
#endif
#ifndef SKIP_1
    if (IN(1)) { pg8::Gemm g{XN, WIN, M, NINP, D}; pg8::StaticOrder S; S.init(M, NINP, F.G, (int)blockIdx.x);
        pg8::EpiF32 E{PROJ, NINP};
        pg8::gemm_phase<pg8::EpiF32, pg8::StaticOrder, true, true>(F.lds + RING_OFF, g, S, E); SEAM(1); }
#endif
#ifndef SKIP_2
    if (IN(2)) { p2_post(F, args); SEAM(2); }
#endif
#ifndef SKIP_3
    if (IN(3)) { p3_attn(F, args); SEAM(3); }
#endif
#ifndef SKIP_4
    if (IN(4)) { p4_scan(F, args); SEAM(4); }
#endif
#ifndef SKIP_5
    if (IN(5)) { pg8::Gemm g{XN, WO, M, D, D}; pg8::StaticOrder S; S.init(M, D, F.G, (int)blockIdx.x);
        pg8::EpiHRes E{args.in[0], args.in[1], args.out + O_YP, HBF, SSQ, MP};
        pg8::gemm_phase<pg8::EpiHRes, pg8::StaticOrder, true, true>(F.lds + RING_OFF, g, S, E); SEAM(5); }
#endif
#ifndef SKIP_6
    if (IN(6)) { pg8::Gemm g{HBF, W1, M, FF, D}; pg8::StaticOrder S; S.init(M, FF, F.G, (int)blockIdx.x);
        pg8::EpiRelu2 E{HB, FF, SSQ};
        pg8::gemm_phase<pg8::EpiRelu2, pg8::StaticOrder, true, true>(F.lds + RING_OFF, g, S, E); SEAM(6); }
#endif
#ifndef SKIP_7
    if (IN(7)) { pg8::Gemm g{HB, W2, M, D, FF}; pg8::StaticOrder S; S.init(M, D, F.G, (int)blockIdx.x);
        pg8::EpiAddOut E{args.out + O_YP, D};
        pg8::gemm_phase<pg8::EpiAddOut, pg8::StaticOrder, true, true>(F.lds + RING_OFF, g, S, E); }
#endif
#undef IN
#undef SEAM
}

#ifndef N_PHASES_PER_LAUNCH
#define N_PHASES_PER_LAUNCH 1
#endif
extern "C" void kernel_launch(void* const* d_in, const int* in_sizes, int n_in, void* d_out, int out_size, void* d_ws, size_t ws_size, hipStream_t stream) {
    static int grid = 0;
    if (grid == 0) {
        if (n_in != 26 || out_size != (int)O_END || ws_size < WS_END) { fprintf(stderr, "kernel_launch: unexpected shapes n_in %d out %d ws %zu\n", n_in, out_size, ws_size); grid = -1; return; }
        int dev = 0, cus = 0, per_cu = 0;
        if (hipGetDevice(&dev) != hipSuccess || hipDeviceGetAttribute(&cus, hipDeviceAttributeMultiprocessorCount, dev) != hipSuccess) { grid = -1; return; }
        if (hipFuncSetAttribute((const void*)fwd, hipFuncAttributeMaxDynamicSharedMemorySize, LDS_BYTES) != hipSuccess) { fprintf(stderr, "kernel_launch: hipFuncSetAttribute failed\n"); grid = -1; return; }
        if (hipOccupancyMaxActiveBlocksPerMultiprocessor(&per_cu, (const void*)fwd, NTHR, LDS_BYTES) != hipSuccess || per_cu < 1) { fprintf(stderr, "kernel_launch: occupancy query says %d\n", per_cu); }
        (void)hipGetLastError();
        grid = cus;
    }
    if (grid < 0) return;
    if (hipMemsetAsync((char*)d_ws + WS_CTL, 0, CTL_ZERO_BYTES, stream) != hipSuccess) return;
    Args a{};
    for (int i = 0; i < 26; ++i) a.in[i] = (const float*)d_in[i];
    a.out = (float*)d_out; a.ws = (unsigned char*)d_ws;
    constexpr int NPH = 8;
    for (int p = 0; p < NPH; p += N_PHASES_PER_LAUNCH) {
        a.ph_lo = p; a.ph_hi = (p + N_PHASES_PER_LAUNCH < NPH) ? p + N_PHASES_PER_LAUNCH : NPH;
        hipLaunchKernelGGL(fwd, dim3(grid), dim3(NTHR), LDS_BYTES, stream, a);
    }
}
```

```cpp
#include <hip/hip_runtime.h>
#include <cstdio>
#include <cstdint>
#include <cmath>
namespace pg8 {
#define PG8_LAS __attribute__((address_space(3)))
typedef unsigned short bf16_t;
typedef short bf16x8 __attribute__((ext_vector_type(8)));
typedef float f32x4 __attribute__((ext_vector_type(4)));
typedef unsigned u32x4 __attribute__((ext_vector_type(4)));
constexpr int BM = 256, BK = 64, HALF = 128, HTB = HALF * BK * 2  , STAGE_BYTES = 8 * HTB, NXCD = 8, WGM = 8;

__host__ __device__ __forceinline__ int lds_byte(int r, int c) { const int st = (r >> 4) * 2 + (c >> 5), rr = r & 15, cc = c & 31, ob = rr * 64 + cc * 2; return st * 1024 + (ob ^ (((ob >> 9) & 1) << 5)); }
__host__ __device__ __forceinline__ void stage_rc(int b, int& R, int& C) { const int st = b / 1024, sb = b % 1024, swz = sb ^ (((sb >> 9) & 1) << 5); R = (st >> 1) * 16 + swz / 64; C = (st & 1) * 32 + (swz % 64) / 2; }
__host__ __device__ __forceinline__ int perm32(int rho) { const int n = rho >> 4, i = rho & 15; return 8 * (i >> 2) + 4 * n + (i & 3); }

struct Unit { int pm, pn, ko; };
struct Gemm { const bf16_t* A; const bf16_t* Bt; int M, N, K; int ld; };

struct StaticOrder {
    int nM, nN, nwg, G, c;
    __host__ __device__ void init(int M, int N, int G_, int c_) { nM = M / BM; nN = N / BM; nwg = nM * nN; G = G_; c = c_; }
    __host__ __device__ bool next(int i, Unit& u) const {
        const long L = (long)i * G + c; if (L >= nwg) return false;
        int wgid = (int)L; { const int q = nwg / NXCD, r = nwg % NXCD, xcd = wgid % NXCD, off = wgid / NXCD; wgid = (xcd < r ? xcd * (q + 1) : r * (q + 1) + (xcd - r) * q) + off; }
        const int nig = WGM * nN, gid = wgid / nig, fm = gid * WGM, gsz = (nM - fm) < WGM ? (nM - fm) : WGM;
        u.pm = fm + ((wgid % nig) % gsz); u.pn = (wgid % nig) / gsz; u.ko = 0; return true;
    }
    __device__ __forceinline__ void a_ready(const Unit&) const {}
    __device__ __forceinline__ void done(const Unit&) const {}
};

__device__ __forceinline__ unsigned cvt_pk_bf16(float lo, float hi) { unsigned r; asm volatile("v_cvt_pk_bf16_f32 %0, %1, %2" : "=v"(r) : "v"(lo), "v"(hi)); return r; }
typedef float f32x2 __attribute__((ext_vector_type(2)));
struct NoPre {};
struct EpiF32 {
    static constexpr bool PERM = false, AFTER_DRAIN = false;
    float* C; int ldc;
    typedef NoPre Pre; __device__ __forceinline__ void pre(Pre&, const Unit&, int, int, int, int) const {}
    __device__ __forceinline__ void operator()(const f32x4 (&acc)[2][2][4][2], const Unit& u, int wr, int wc, int fr, int fq, const Pre&) const {
        const int row0 = u.pm * BM + wr * 64 + fr, col0 = u.pn * BM + wc * 32 + 4 * fq;
#pragma unroll
        for (int ai = 0; ai < 2; ++ai)
#pragma unroll
            for (int m = 0; m < 4; ++m) { float* rowp = C + (size_t)(row0 + ai * HALF + m * 16) * ldc + col0;
#pragma unroll
                for (int bj = 0; bj < 2; ++bj)
#pragma unroll
                    for (int n = 0; n < 2; ++n) *(f32x4*)(rowp + bj * HALF + n * 16) = acc[ai][bj][m][n]; }
    }
};
struct EpiHRes {
    static constexpr bool PERM = false, AFTER_DRAIN = false;
    const bf16_t* xb; float* out; bf16_t* hb; float* ssq; int mp;
    typedef NoPre Pre; __device__ __forceinline__ void pre(Pre&, const Unit&, int, int, int, int) const {}
    __device__ __forceinline__ void operator()(const f32x4 (&acc)[2][2][4][2], const Unit& u, int wr, int wc, int fr, int fq, const Pre&) const {
        const int row0 = u.pm * BM + wr * 64 + fr, col0 = u.pn * BM + wc * 32 + 4 * fq;
#pragma unroll
        for (int ai = 0; ai < 2; ++ai)
#pragma unroll
            for (int m = 0; m < 4; ++m) {
                const int row = row0 + ai * HALF + m * 16;
                const bf16_t* xrow = xb + (size_t)row * 1024 + col0;
                float* orow = out + (size_t)row * 1024 + col0; bf16_t* hrow = hb + (size_t)row * 1024 + col0;
                float s = 0.f;
#pragma unroll
                for (int bj = 0; bj < 2; ++bj)
#pragma unroll
                    for (int n = 0; n < 2; ++n) {
                        const unsigned long long xw = *(const unsigned long long*)(xrow + bj * HALF + n * 16); const unsigned xlo = (unsigned)xw, xhi = (unsigned)(xw >> 32);
                        f32x4 xv; xv[0] = __builtin_bit_cast(float, xlo << 16); xv[1] = __builtin_bit_cast(float, xlo & 0xffff0000u); xv[2] = __builtin_bit_cast(float, xhi << 16); xv[3] = __builtin_bit_cast(float, xhi & 0xffff0000u);
                        const f32x4 h = acc[ai][bj][m][n] + xv;
                        if (row >= mp) *(f32x4*)(orow + bj * HALF + n * 16) = h;
                        unsigned long long w = (unsigned long long)cvt_pk_bf16(h[0], h[1]) | ((unsigned long long)cvt_pk_bf16(h[2], h[3]) << 32);
                        *(unsigned long long*)(hrow + bj * HALF + n * 16) = w;
                        s += (h[0] * h[0] + h[1] * h[1]) + (h[2] * h[2] + h[3] * h[3]);
                    }
                s += __shfl_xor(s, 16); s += __shfl_xor(s, 32);
                if (fq == 0) atomicAdd(ssq + row, s);
            }
    }
};
struct EpiRelu2 {
    static constexpr bool PERM = true, AFTER_DRAIN = false;
    bf16_t* O; int ldc; const float* ssq;
    struct Pre { float s[8]; };
    __device__ __forceinline__ void pre(Pre& P_, const Unit& u, int wr, int wc, int fr, int fq) const {
        const int row0 = u.pm * BM + wr * 64 + fr;
#pragma unroll
        for (int ai = 0; ai < 2; ++ai)
#pragma unroll
            for (int m = 0; m < 4; ++m) P_.s[ai * 4 + m] = ssq[row0 + ai * HALF + m * 16];
    }
    __device__ __forceinline__ void operator()(const f32x4 (&acc)[2][2][4][2], const Unit& u, int wr, int wc, int fr, int fq, const Pre& P_) const {
        const int row0 = u.pm * BM + wr * 64 + fr, col0 = u.pn * BM + wc * 32 + 8 * fq;
#pragma unroll
        for (int ai = 0; ai < 2; ++ai)
#pragma unroll
            for (int m = 0; m < 4; ++m) {
                const int row = row0 + ai * HALF + m * 16;
                const float rs = __builtin_amdgcn_rsqf(P_.s[ai * 4 + m] * (1.0f / 1024.0f) + 1e-6f);
                bf16_t* rowp = O + (size_t)row * ldc + col0;
#pragma unroll
                for (int bj = 0; bj < 2; ++bj) {
                    f32x4 v0 = acc[ai][bj][m][0] * rs, v1 = acc[ai][bj][m][1] * rs;
#pragma unroll
                    for (int j = 0; j < 4; ++j) { const float a = fmaxf(v0[j], 0.f), b = fmaxf(v1[j], 0.f); v0[j] = a * a; v1[j] = b * b; }
                    u32x4 w; w.x = cvt_pk_bf16(v0[0], v0[1]); w.y = cvt_pk_bf16(v0[2], v0[3]); w.z = cvt_pk_bf16(v1[0], v1[1]); w.w = cvt_pk_bf16(v1[2], v1[3]);
                    *(u32x4*)(rowp + bj * HALF) = w;
                }
            }
    }
};
struct EpiAddOut {
    static constexpr bool PERM = false, AFTER_DRAIN = false;
    float* C; int ldc;
    typedef NoPre Pre; __device__ __forceinline__ void pre(Pre&, const Unit&, int, int, int, int) const {}
    __device__ __forceinline__ void operator()(const f32x4 (&acc)[2][2][4][2], const Unit& u, int wr, int wc, int fr, int fq, const Pre&) const {
        const int row0 = u.pm * BM + wr * 64 + fr, col0 = u.pn * BM + wc * 32 + 4 * fq;
#pragma unroll
        for (int ai = 0; ai < 2; ++ai)
#pragma unroll
            for (int m = 0; m < 4; ++m) { float* rowp = C + (size_t)(row0 + ai * HALF + m * 16) * ldc + col0;
#pragma unroll
                for (int bj = 0; bj < 2; ++bj)
#pragma unroll
                    for (int n = 0; n < 2; ++n) { f32x4* p = (f32x4*)(rowp + bj * HALF + n * 16); *p = *p + acc[ai][bj][m][n]; } }
    }
};
struct EpiProj {
    static constexpr bool PERM = true, AFTER_DRAIN = false;
    bf16_t* QKV; size_t qkv_stride;
    bf16_t* PB;
    float* QS;
    float* out; const float* gq; const float* gk; const float* rstd;
    struct Pre { float s[8]; };
    __device__ __forceinline__ void pre(Pre& P_, const Unit& u, int wr, int wc, int fr, int fq) const {
        const int row0 = u.pm * BM + wr * 64 + fr;
#pragma unroll
        for (int ai = 0; ai < 2; ++ai)
#pragma unroll
            for (int m = 0; m < 4; ++m) P_.s[ai * 4 + m] = rstd[row0 + ai * HALF + m * 16];
    }
    __device__ __forceinline__ void operator()(const f32x4 (&acc)[2][2][4][2], const Unit& u, int wr, int wc, int fr, int fq, const Pre& P_) const {
        const int pn = u.pn, pm = u.pm;
        if (pn < 6) {
            const int region = pn >> 1, h = (pn & 1) * 4 + wc;
            f32x4 gv[2][2];
#pragma unroll
            for (int bj = 0; bj < 2; ++bj)
#pragma unroll
                for (int n = 0; n < 2; ++n) gv[bj][n] = (region == 2) ? (f32x4){1.f, 1.f, 1.f, 1.f} : *(const f32x4*)((region == 0 ? gq : gk) + 32 * bj + 8 * fq + 4 * n);
#pragma unroll
            for (int ai = 0; ai < 2; ++ai)
#pragma unroll
                for (int m = 0; m < 4; ++m) {
                    const int row = pm * BM + ai * HALF + wr * 64 + m * 16 + fr;
                    f32x4 v[2][2]; const float rs1 = P_.s[ai * 4 + m];
#pragma unroll
                    for (int bj = 0; bj < 2; ++bj)
#pragma unroll
                        for (int n = 0; n < 2; ++n) v[bj][n] = acc[ai][bj][m][n] * rs1;
                    if (region < 2) {
                        float ss = 0.f;
#pragma unroll
                        for (int bj = 0; bj < 2; ++bj)
#pragma unroll
                            for (int n = 0; n < 2; ++n) ss += (v[bj][n][0] * v[bj][n][0] + v[bj][n][1] * v[bj][n][1]) + (v[bj][n][2] * v[bj][n][2] + v[bj][n][3] * v[bj][n][3]);
                        ss += __shfl_xor(ss, 16); ss += __shfl_xor(ss, 32);
                        const float rs = 1.0f / sqrtf(ss * (1.0f / 64.0f) + 1e-6f);
#pragma unroll
                        for (int bj = 0; bj < 2; ++bj)
#pragma unroll
                            for (int n = 0; n < 2; ++n) v[bj][n] = v[bj][n] * rs * gv[bj][n];
                    }
                    if (pm < 256) {
                        const int b = row >> 13, t = row & 8191;
                        bf16_t* dst = QKV + (size_t)region * qkv_stride + ((size_t)(b * 8 + h) * 8192 + t) * 64 + 8 * fq;
                        const float sc = (region == 0) ? 0.18033688011112042f : 1.0f;
#pragma unroll
                        for (int bj = 0; bj < 2; ++bj) { const f32x4 a = v[bj][0] * sc, c = v[bj][1] * sc;
                            u32x4 w; w.x = cvt_pk_bf16(a[0], a[1]); w.y = cvt_pk_bf16(a[2], a[3]); w.z = cvt_pk_bf16(c[0], c[1]); w.w = cvt_pk_bf16(c[2], c[3]);
                            *(u32x4*)(dst + 32 * bj) = w; }
                        if (region > 0 && t >= 6144) {
                            float* od = out + (region == 1 ? (size_t)68157440 : (size_t)76546048) + ((size_t)(b * 2048 + (t - 6144)) * 8 + h) * 64 + 8 * fq;
#pragma unroll
                            for (int bj = 0; bj < 2; ++bj) { *(f32x4*)(od + 32 * bj) = v[bj][0]; *(f32x4*)(od + 32 * bj + 4) = v[bj][1]; }
                        }
                    } else {
                        const int rs_ = row - 65536;
                        float* od = (region == 0) ? QS + (size_t)rs_ * 512 + h * 64 + 8 * fq : out + (region == 1 ? (size_t)85211392 : (size_t)85735680) + ((size_t)rs_ * 8 + h) * 64 + 8 * fq;
#pragma unroll
                        for (int bj = 0; bj < 2; ++bj) { *(f32x4*)(od + 32 * bj) = v[bj][0]; *(f32x4*)(od + 32 * bj + 4) = v[bj][1]; }
                    }
                }
        } else {
            const int col0 = (pn - 6) * 256 + wc * 32 + 8 * fq;
#pragma unroll
            for (int ai = 0; ai < 2; ++ai)
#pragma unroll
                for (int m = 0; m < 4; ++m) {
                    const int row = pm * BM + ai * HALF + wr * 64 + m * 16 + fr;
                    bf16_t* dst = PB + (size_t)row * 2048 + col0;
                    float* sd = nullptr;
                    if (pm < 256) { if ((row & 8191) == 8191) sd = out + (size_t)85196800 + (size_t)(row >> 13) * 1824; }
                    else { const int rs_ = row - 65536; if ((rs_ & 7) == 7) sd = out + (size_t)90454272 + (size_t)(rs_ >> 3) * 1824; }
                    const float rs1 = P_.s[ai * 4 + m];
#pragma unroll
                    for (int bj = 0; bj < 2; ++bj) { const f32x4 a = acc[ai][bj][m][0] * rs1, c = acc[ai][bj][m][1] * rs1;
                        u32x4 w; w.x = cvt_pk_bf16(a[0], a[1]); w.y = cvt_pk_bf16(a[2], a[3]); w.z = cvt_pk_bf16(c[0], c[1]); w.w = cvt_pk_bf16(c[2], c[3]);
                        const int cc = col0 + 128 * bj;
                        if (cc < 1824) *(u32x4*)(dst + 128 * bj) = w;
                        if (sd && cc < 1824) { *(f32x4*)(sd + cc) = a; *(f32x4*)(sd + cc + 4) = c; } }
                }
        }
    }
};

struct EpiAddH {
    static constexpr bool PERM = false, AFTER_DRAIN = false;
    float* C; const bf16_t* hb; int ldc;
    typedef NoPre Pre; __device__ __forceinline__ void pre(Pre&, const Unit&, int, int, int, int) const {}
    __device__ __forceinline__ void operator()(const f32x4 (&acc)[2][2][4][2], const Unit& u, int wr, int wc, int fr, int fq, const Pre&) const {
        const int row0 = u.pm * BM + wr * 64 + fr, col0 = u.pn * BM + wc * 32 + 4 * fq;
#pragma unroll
        for (int ai = 0; ai < 2; ++ai)
#pragma unroll
            for (int m = 0; m < 4; ++m) { const size_t ro = (size_t)(row0 + ai * HALF + m * 16) * ldc + col0;
#pragma unroll
                for (int bj = 0; bj < 2; ++bj)
#pragma unroll
                    for (int n = 0; n < 2; ++n) { const unsigned long long hw = *(const unsigned long long*)(hb + ro + bj * HALF + n * 16); const unsigned lo = (unsigned)hw, hi = (unsigned)(hw >> 32);
                        f32x4 h; h[0] = __builtin_bit_cast(float, lo << 16); h[1] = __builtin_bit_cast(float, lo & 0xffff0000u); h[2] = __builtin_bit_cast(float, hi << 16); h[3] = __builtin_bit_cast(float, hi & 0xffff0000u);
                        *(f32x4*)(C + ro + bj * HALF + n * 16) = h + acc[ai][bj][m][n]; } }
    }
};
template <int SPLIT, int KFULL> struct SplitKOrder {
    int G, c;
    __host__ __device__ bool next(int i, Unit& u) const { const int L = i * G + c; if (L >= 16 * SPLIT) return false; const int ks = L % SPLIT, tile = L / SPLIT; u.pm = 256 + (tile >> 2); u.pn = tile & 3; u.ko = ks * (KFULL / SPLIT); return true; }
    __device__ __forceinline__ void a_ready(const Unit&) const {}
    __device__ __forceinline__ void done(const Unit&) const {}
};
struct EpiAtomicAdd {
    static constexpr bool PERM = false, AFTER_DRAIN = false;
    float* C; int ldc;
    typedef NoPre Pre; __device__ __forceinline__ void pre(Pre&, const Unit&, int, int, int, int) const {}
    __device__ __forceinline__ void operator()(const f32x4 (&acc)[2][2][4][2], const Unit& u, int wr, int wc, int fr, int fq, const Pre&) const {
        const int row0 = u.pm * BM + wr * 64 + fr, col0 = u.pn * BM + wc * 32 + 4 * fq;
#pragma unroll
        for (int ai = 0; ai < 2; ++ai)
#pragma unroll
            for (int m = 0; m < 4; ++m) { float* rowp = C + (size_t)(row0 + ai * HALF + m * 16) * ldc + col0;
#pragma unroll
                for (int bj = 0; bj < 2; ++bj)
#pragma unroll
                    for (int n = 0; n < 2; ++n) { float* p = rowp + bj * HALF + n * 16;
#pragma unroll
                        for (int j = 0; j < 4; ++j) unsafeAtomicAdd(p + j, acc[ai][bj][m][n][j]); } }
    }
};

template <class Epi, class Sched, bool ALIGN_EPI = false, bool SP2 = false>
__device__ __forceinline__ void gemm_phase(PG8_LAS unsigned char* lds, const Gemm g, const Sched& S, const Epi& E) {
    const int tid = threadIdx.x, wid = __builtin_amdgcn_readfirstlane(tid >> 6), lane = tid & 63, wr = wid >> 2, wc = wid & 3, fr = lane & 15, fq = lane >> 4;
    const int K = g.K, nt = K / BK, LD = g.ld ? g.ld : g.K;
    unsigned voffA[2], voffB[2];
#pragma unroll
    for (int i = 0; i < 2; ++i) { int R, C; stage_rc(tid * 16 + i * 8192, R, C); const int Rb = Epi::PERM ? ((R & ~31) + perm32(R & 31)) : R;
        voffA[i] = (unsigned)(R * LD + C) * 2u; voffB[i] = (unsigned)(Rb * LD + C) * 2u; }
    const size_t kstep = (size_t)(BK * 2);
    const size_t hstep = (size_t)HALF * LD * 2;
    const size_t tstep = 2 * hstep;
    const unsigned ldsw = (unsigned)wid * 1024u;
    const int aoff = lds_byte(wr * 64 + fr, fq * 8), boff = lds_byte(wc * 32 + fr, fq * 8);
#define PG8_SA(b, h) (((b) * 2 + (h)) * HTB)
#define PG8_SB(b, h) ((4 + (b) * 2 + (h)) * HTB)
#define PG8_STAGE(bufoff, gbase, voff) do { _Pragma("unroll") for (int _i = 0; _i < 2; ++_i) \
        __builtin_amdgcn_global_load_lds((const unsigned*)((const char*)(gbase) + (voff)[_i]), (PG8_LAS unsigned*)(lds + (bufoff) + ldsw + _i * 8192), 16, 0, 0); } while (0)
#define PG8_LDA(dst, b, h) do { _Pragma("unroll") for (int m = 0; m < 4; ++m) _Pragma("unroll") for (int k = 0; k < 2; ++k) dst[m][k] = *(const PG8_LAS bf16x8*)(lds + PG8_SA(b, h) + aoff + m * 2048 + k * 1024); } while (0)
#define PG8_LDB(dst, b, h) do { _Pragma("unroll") for (int n = 0; n < 2; ++n) _Pragma("unroll") for (int k = 0; k < 2; ++k) dst[n][k] = *(const PG8_LAS bf16x8*)(lds + PG8_SB(b, h) + boff + n * 2048 + k * 1024); } while (0)
#define PG8_MMA(ai, bj, At, Bt) do { __builtin_amdgcn_s_setprio(1); _Pragma("unroll") for (int m = 0; m < 4; ++m) _Pragma("unroll") for (int n = 0; n < 2; ++n) _Pragma("unroll") for (int k = 0; k < 2; ++k) \
        acc[ai][bj][m][n] = __builtin_amdgcn_mfma_f32_16x16x32_bf16(Bt[n][k], At[m][k], acc[ai][bj][m][n], 0, 0, 0); __builtin_amdgcn_s_setprio(0); } while (0)
#define PG8_WAIT_V(n) asm volatile("s_waitcnt vmcnt(" #n ")" ::: "memory")
#define PG8_WAIT_L(n) asm volatile("s_waitcnt lgkmcnt(" #n ")" ::: "memory")
#define PG8_BAR __builtin_amdgcn_s_barrier()
#define PG8_SCHED __builtin_amdgcn_sched_barrier(0)
    Unit cur, nxt; int ui = 0;
    if (!S.next(0, cur)) return;
    f32x4 acc[2][2][4][2];
    typename Epi::Pre epre;
#pragma unroll
    for (int a = 0; a < 2; ++a)
#pragma unroll
        for (int b = 0; b < 2; ++b)
#pragma unroll
            for (int m = 0; m < 4; ++m)
#pragma unroll
                for (int n = 0; n < 2; ++n) acc[a][b][m][n] = (f32x4){0.f, 0.f, 0.f, 0.f};
    bf16x8 At[4][2], B0[2][2], B1[2][2];
    const char* cA = (const char*)g.A + (size_t)cur.pm * tstep + (size_t)cur.ko * 2; const char* cB = (const char*)g.Bt + (size_t)cur.pn * tstep + (size_t)cur.ko * 2;
    S.a_ready(cur);
    if constexpr (SP2) {
        PG8_STAGE(PG8_SB(0, 0), cB, voffB); PG8_STAGE(PG8_SB(0, 1), cB + hstep, voffB); PG8_STAGE(PG8_SA(0, 0), cA, voffA); PG8_STAGE(PG8_SA(0, 1), cA + hstep, voffA);
        if (wr == 1) PG8_BAR;
        PG8_WAIT_V(2); PG8_BAR;
        PG8_STAGE(PG8_SB(1, 0), cB + kstep, voffB); PG8_STAGE(PG8_SA(1, 0), cA + kstep, voffA); PG8_STAGE(PG8_SB(1, 1), cB + hstep + kstep, voffB);
        PG8_WAIT_V(6); PG8_BAR;
    } else {
        PG8_STAGE(PG8_SB(0, 0), cB, voffB); PG8_STAGE(PG8_SA(0, 0), cA, voffA); PG8_STAGE(PG8_SB(0, 1), cB + hstep, voffB); PG8_STAGE(PG8_SA(0, 1), cA + hstep, voffA);
        if (wr == 1) PG8_BAR;
        PG8_WAIT_V(4); PG8_BAR;
        PG8_STAGE(PG8_SB(1, 0), cB + kstep, voffB); PG8_STAGE(PG8_SA(1, 0), cA + kstep, voffA); PG8_STAGE(PG8_SB(1, 1), cB + hstep + kstep, voffB);
        PG8_WAIT_V(6); PG8_BAR;
    }
    for (;;) {
        const bool has_next = S.next(ui + 1, nxt);
        const char* nA = has_next ? (const char*)g.A + (size_t)nxt.pm * tstep + (size_t)nxt.ko * 2 : cA; const char* nB = has_next ? (const char*)g.Bt + (size_t)nxt.pn * tstep + (size_t)nxt.ko * 2 : cB;
        for (int t = 0; t < nt; t += 2) {
            const bool last = (t == nt - 2);
            const char* a1 = cA + (size_t)(t + 1) * kstep;
            const char* a2 = last ? nA : cA + (size_t)(t + 2) * kstep; const char* b2 = last ? nB : cB + (size_t)(t + 2) * kstep;
            const char* a3 = a2 + kstep; const char* b3 = b2 + kstep;
            if (last && has_next) S.a_ready(nxt);
            if (last) E.pre(epre, cur, wr, wc, fr, fq);
            if constexpr (SP2) {
            PG8_LDB(B0, 0, 0); PG8_LDB(B1, 0, 1); PG8_SCHED; PG8_LDA(At, 0, 0); PG8_STAGE(PG8_SA(1, 1), a1 + hstep, voffA);
            PG8_WAIT_V(8); PG8_WAIT_L(0); PG8_BAR; PG8_MMA(0, 0, At, B0); PG8_MMA(0, 1, At, B1); PG8_BAR; PG8_SCHED;
            PG8_LDA(At, 0, 1); PG8_STAGE(PG8_SB(0, 0), b2, voffB); PG8_STAGE(PG8_SB(0, 1), b2 + hstep, voffB); PG8_STAGE(PG8_SA(0, 0), a2, voffA);
            PG8_WAIT_V(8); PG8_WAIT_L(0); PG8_BAR; PG8_MMA(1, 0, At, B0); PG8_MMA(1, 1, At, B1); PG8_BAR; PG8_SCHED;
            PG8_LDB(B0, 1, 0); PG8_LDB(B1, 1, 1); PG8_SCHED; PG8_LDA(At, 1, 0); PG8_STAGE(PG8_SA(0, 1), a2 + hstep, voffA);
            PG8_WAIT_V(8); PG8_WAIT_L(0); PG8_BAR; PG8_MMA(0, 0, At, B0); PG8_MMA(0, 1, At, B1); PG8_BAR; PG8_SCHED;
            PG8_LDA(At, 1, 1); PG8_STAGE(PG8_SB(1, 0), b3, voffB); PG8_STAGE(PG8_SB(1, 1), b3 + hstep, voffB); PG8_STAGE(PG8_SA(1, 0), a3, voffA);
            PG8_WAIT_V(8); PG8_WAIT_L(0); PG8_BAR; PG8_MMA(1, 0, At, B0); PG8_MMA(1, 1, At, B1); PG8_BAR; PG8_SCHED;
            } else {
            PG8_LDB(B0, 0, 0); PG8_SCHED; PG8_LDA(At, 0, 0); PG8_STAGE(PG8_SA(1, 1), a1 + hstep, voffA);
            PG8_WAIT_L(8); PG8_BAR; PG8_WAIT_L(0); PG8_MMA(0, 0, At, B0); PG8_BAR; PG8_SCHED;
            PG8_LDB(B1, 0, 1); PG8_STAGE(PG8_SB(0, 0), b2, voffB);
            PG8_BAR; PG8_WAIT_L(0); PG8_MMA(0, 1, At, B1); PG8_BAR;
            PG8_LDA(At, 0, 1); PG8_STAGE(PG8_SA(0, 0), a2, voffA);
            PG8_BAR; PG8_WAIT_L(0); PG8_MMA(1, 0, At, B0); PG8_BAR; PG8_SCHED;
            PG8_STAGE(PG8_SB(0, 1), b2 + hstep, voffB);
            PG8_WAIT_V(6); PG8_BAR; PG8_MMA(1, 1, At, B1); PG8_BAR;
            PG8_LDB(B0, 1, 0); PG8_SCHED; PG8_LDA(At, 1, 0); PG8_STAGE(PG8_SA(0, 1), a2 + hstep, voffA);
            PG8_WAIT_L(8); PG8_BAR; PG8_WAIT_L(0); PG8_MMA(0, 0, At, B0); PG8_BAR; PG8_SCHED;
            PG8_LDB(B1, 1, 1); PG8_STAGE(PG8_SB(1, 0), b3, voffB);
            PG8_BAR; PG8_WAIT_L(0); PG8_MMA(0, 1, At, B1); PG8_BAR;
            PG8_LDA(At, 1, 1); PG8_STAGE(PG8_SA(1, 0), a3, voffA);
            PG8_BAR; PG8_WAIT_L(0); PG8_MMA(1, 0, At, B0); PG8_BAR; PG8_SCHED;
            PG8_STAGE(PG8_SB(1, 1), b3 + hstep, voffB);
            PG8_WAIT_V(6); PG8_BAR; PG8_MMA(1, 1, At, B1); PG8_BAR;
            }
        }
        if constexpr (ALIGN_EPI) { if (wr == 0) PG8_BAR; }
        if constexpr (!Epi::AFTER_DRAIN) { E(acc, cur, wr, wc, fr, fq, epre); S.done(cur); }
        if (!has_next) break;
#pragma unroll
        for (int a = 0; a < 2; ++a)
#pragma unroll
            for (int b = 0; b < 2; ++b)
#pragma unroll
                for (int m = 0; m < 4; ++m)
#pragma unroll
                    for (int n = 0; n < 2; ++n) acc[a][b][m][n] = (f32x4){0.f, 0.f, 0.f, 0.f};
        cur = nxt; cA = nA; cB = nB; ++ui;
        if constexpr (ALIGN_EPI) { if (wr == 1) PG8_BAR; }
    }
    PG8_WAIT_V(0);
    if constexpr (!ALIGN_EPI) { if (wr == 0) PG8_BAR; }
    PG8_BAR;
    if constexpr (Epi::AFTER_DRAIN) { E.fused(acc, cur, wr, wc, fr, fq, lds, wid, lane); S.done(cur); }
#undef PG8_SA
#undef PG8_SB
#undef PG8_STAGE
#undef PG8_LDA
#undef PG8_LDB
#undef PG8_MMA
#undef PG8_WAIT_V
#undef PG8_WAIT_L
#undef PG8_BAR
#undef PG8_SCHED
}
}
#define GAS __attribute__((address_space(1)))
#define LAS __attribute__((address_space(3)))
typedef unsigned short bf16;
typedef unsigned v4u __attribute__((ext_vector_type(4)));
typedef float f32x4 __attribute__((ext_vector_type(4)));
typedef short bf16x8 __attribute__((ext_vector_type(8)));
typedef GAS unsigned gu32;
typedef GAS unsigned long long gu64;
#define RLX_AGENT __ATOMIC_RELAXED, __HIP_MEMORY_SCOPE_AGENT
#define LDS_WAIT() asm volatile("s_waitcnt lgkmcnt(0)" ::: "memory")
#define VM_WAIT() asm volatile("s_waitcnt vmcnt(0)" ::: "memory")
__device__ __forceinline__ unsigned long long rt() { return __builtin_amdgcn_s_memrealtime(); }
__device__ __forceinline__ unsigned f2bf(float f) { unsigned u = __builtin_bit_cast(unsigned, f); return (u + 0x7fffu + ((u >> 16) & 1u)) >> 16; }
__device__ __forceinline__ unsigned pk2(float lo, float hi) { return f2bf(lo) | (f2bf(hi) << 16); }

#define XB_TMO      128
#define XB_XCNT(j)  (256  + 64 * (j))
#define XB_XSUB(j)  (1280 + 64 * (j))
#define XB_XGEN(j)  (2304 + 64 * (j))
#define XB_TOP      3328
#define XB_TOPGEN   3392
#define XCD_BAR_WORDS 3456
#define XB_SPIN_CAP (1u << 18)

__device__ __forceinline__ unsigned xb_ld(unsigned* p)              { return __hip_atomic_load(p, __ATOMIC_RELAXED, __HIP_MEMORY_SCOPE_AGENT); }
__device__ __forceinline__ unsigned xb_add(unsigned* p, unsigned v) { return __hip_atomic_fetch_add(p, v, __ATOMIC_RELAXED, __HIP_MEMORY_SCOPE_AGENT); }
__device__ __forceinline__ unsigned xb_xcc_id() { return (unsigned)__builtin_amdgcn_s_getreg((3 << 11) | 20) & 0xFu; }
#define XB_SPIN(cond, bar) do { unsigned _sp = 0; while (cond) { __builtin_amdgcn_s_sleep(1); \
    if ((++_sp & 255u) == 0u) { if (xb_ld(&(bar)[XB_TMO])) break; if (_sp > XB_SPIN_CAP) { atomicAdd(&(bar)[XB_TMO], 1u); break; } } } } while (0)

struct XcdBarrier {
    unsigned* bar; unsigned x;
    volatile LAS unsigned* st;
};

__device__ __forceinline__ XcdBarrier xcd_barrier_post(unsigned* bar, volatile LAS unsigned* st) {
    XcdBarrier b; b.bar = bar; b.x = xb_xcc_id(); b.st = st;
    if (threadIdx.x == 0) (void)xb_add(&bar[XB_XCNT(b.x)], 1u);
    return b;
}
__device__ __forceinline__ void xcd_barrier_complete(unsigned* bar, unsigned x, unsigned& nloc, unsigned& nx) {
    const unsigned G = gridDim.x * gridDim.y * gridDim.z;
    unsigned sum, cnt, mine, sp = 0u;
    for (;;) {
        sum = 0u; cnt = 0u; mine = 0u;
#pragma unroll
        for (unsigned j = 0; j < 16; ++j) { const unsigned c = xb_ld(&bar[XB_XCNT(j)]); sum += c; cnt += (c > 0u) ? 1u : 0u; mine = (j == x) ? c : mine; }
        if (sum == G) break;
        __builtin_amdgcn_s_sleep(1);
        if ((++sp & 255u) == 0u) { if (xb_ld(&bar[XB_TMO])) break; if (sp > XB_SPIN_CAP) { atomicAdd(&bar[XB_TMO], 1u); break; } }
    }
    nloc = mine > 0u ? mine : 1u; nx = cnt > 0u ? cnt : 1u;
}

__device__ __forceinline__ void xcd_barrier(const XcdBarrier& b) {
    asm volatile("s_waitcnt vmcnt(0)" ::: "memory");
    __syncthreads();
    if (threadIdx.x == 0) {
        unsigned* bar = b.bar;
        __builtin_amdgcn_s_waitcnt(0);
        unsigned nloc = b.st[0], nx = b.st[1];
        if (nloc == 0u) { xcd_barrier_complete(bar, b.x, nloc, nx); b.st[0] = nloc; b.st[1] = nx; }
        const unsigned old = xb_add(&bar[XB_XSUB(b.x)], 1u);
        const unsigned gen = old / nloc;
        if (old + 1u == (gen + 1u) * nloc) {
            __builtin_amdgcn_fence(__ATOMIC_RELEASE, "agent");
            asm volatile("s_waitcnt vmcnt(0)" ::: "memory");
            const unsigned og = xb_add(&bar[XB_TOP], 1u);
            const unsigned tg = og / nx;
            if (og + 1u == (tg + 1u) * nx) xb_add(&bar[XB_TOPGEN], 1u);
            else XB_SPIN(xb_ld(&bar[XB_TOPGEN]) == tg, bar);
            __builtin_amdgcn_fence(__ATOMIC_ACQUIRE, "agent");
            xb_add(&bar[XB_XGEN(b.x)], 1u);
            asm volatile("s_waitcnt vmcnt(0)" ::: "memory");
        } else {
            XB_SPIN(xb_ld(&bar[XB_XGEN(b.x)]) == gen, bar);
            __builtin_amdgcn_fence(__ATOMIC_ACQUIRE, "agent");
            asm volatile("s_waitcnt vmcnt(0)" ::: "memory");
        }
    }
    __syncthreads();
}
constexpr int NWAVES = 8, NTHR = 512;
constexpr int D = 1024, BATCH = 8, SEQ = 8192, MP = BATCH * SEQ, SBATCH = 128, STOK = 8, MS = SBATCH * STOK, M = MP + MS;
constexpr int AW = 512, HD = 64, NH = 8, NSHIFT = 1824, NIN = 3360, NINP = 3584, FF = 4096, LWIN = 2048;
constexpr int C_Q = 0, C_K = 512, C_V = 1024, C_P = 1536;
constexpr float RMS_EPS = 1e-6f, GN_EPS = 64e-5f;
constexpr size_t O_YP = 0, O_YS = 67108864, O_KWP = 68157440, O_VWP = 76546048, O_WKVP = 84934656, O_SHP = 85196800, O_KNS = 85211392, O_VNS = 85735680, O_WKVS = 86259968, O_SHS = 90454272, O_END = 90687744;
constexpr size_t MiB = 1u << 20;
constexpr size_t WS_CTL = 0, CTL_ZERO_BYTES = 1 * MiB;
constexpr size_t WS_SSQ = 256 * 1024;
constexpr size_t WS_WIN = 2 * MiB, WS_WO = 10 * MiB, WS_W1 = 12 * MiB, WS_W2 = 20 * MiB, WS_QS = 28 * MiB;
constexpr size_t WS_XN = 32 * MiB;
constexpr size_t WS_MIX = 1200 * MiB;
constexpr size_t WS_RSTD = 576 * 1024;
constexpr size_t WS_QB = 162 * MiB, WS_KB = 226 * MiB, WS_VB = 290 * MiB;
constexpr size_t WS_PB = 354 * MiB;
constexpr size_t WS_LORA = 30 * MiB;
constexpr size_t WS_RW = 614 * MiB;
constexpr size_t RW_STRIDE = 2 * MiB;
constexpr size_t WS_LIN = 1156 * MiB;
constexpr size_t WS_PT = 640 * MiB, WS_RP = 704 * MiB, WS_QM = 768 * MiB, WS_Y0 = 896 * MiB, WS_GC = 1024 * MiB, WS_G2 = 1028 * MiB, WS_BV = 1092 * MiB;
constexpr size_t WS_HBF = 1524 * MiB;
constexpr size_t WS_HB = 162 * MiB;
constexpr size_t WS_END = 1654 * MiB;
static_assert(WS_SSQ + (size_t)M * 4 <= WS_RSTD && WS_RSTD + (size_t)M * 4 <= CTL_ZERO_BYTES && WS_LIN + (size_t)MP * 288 * 2 <= WS_MIX && WS_MIX + (size_t)M * 1024 * 2 <= WS_HBF && WS_XN + (size_t)M * 1024 * 2 <= WS_QB && WS_PB + (size_t)M * 2048 * 2 <= WS_RW && (size_t)MS * 512 * 4 <= RW_STRIDE && WS_RW + 7 * RW_STRIDE <= WS_PT && WS_LIN + (size_t)MP * 288 * 2 <= WS_HBF && WS_HB + (size_t)M * FF * 2 <= WS_HBF && WS_END <= 2048 * MiB, "ws map");
constexpr int CW_TMO = 0, CW_BAR = 4096;
constexpr int RING_OFF = 0, RING_BYTES = 131072, LDSCTL_OFF = RING_BYTES, MISC_OFF = LDSCTL_OFF + 320, LDS_BYTES = 147456;

struct Args { const float* in[26]; float* out; unsigned char* ws; int ph_lo, ph_hi, pad0, pad1; };

struct Frame {
    LAS unsigned char* lds; volatile LAS unsigned* MISC; gu32* ctl;
    int tid, lane, wave, vcu, G;
};
__device__ __forceinline__ float wave_sum(float v) {
#pragma unroll
    for (int o = 1; o < 64; o <<= 1) v += __shfl_xor(v, o);
    return v;
}
typedef float f32x2_c __attribute__((ext_vector_type(2))); typedef __bf16 bf16x2_c __attribute__((ext_vector_type(2)));
__device__ __forceinline__ unsigned cvt2(float lo, float hi) { const f32x2_c v = {lo, hi}; const bf16x2_c b = __builtin_convertvector(v, bf16x2_c); return __builtin_bit_cast(unsigned, b); }
__device__ __forceinline__ float wave_max(float v) {
#pragma unroll
    for (int o = 1; o < 64; o <<= 1) v = fmaxf(v, __shfl_xor(v, o));
    return v;
}
__device__ __forceinline__ void p0_transpose_blk(const float* W, int K, int N, bf16* WT, const float* ks, LAS float* scr, int k0, int n0, int d0, int lane) {
#pragma unroll 8
    for (int i = 0; i < 32; ++i) { const int kk = 2 * i + (lane >> 5); float w = W[(size_t)(k0 + kk) * N + n0 + (lane & 31)]; if (ks) w *= ks[k0 + kk]; scr[kk * 33 + (lane & 31)] = w; }
    LDS_WAIT(); asm volatile("" ::: "memory");
    const int c = lane & 7;
#pragma unroll
    for (int j = 0; j < 4; ++j) { const int n = (lane >> 3) + 8 * j; const LAS float* s = scr + (8 * c) * 33 + n;
        v4u o; o.x = pk2(s[0 * 33], s[1 * 33]); o.y = pk2(s[2 * 33], s[3 * 33]); o.z = pk2(s[4 * 33], s[5 * 33]); o.w = pk2(s[6 * 33], s[7 * 33]);
        *(GAS v4u*)(WT + (size_t)(d0 + n) * K + k0 + 8 * c) = o; }
    LDS_WAIT(); asm volatile("" ::: "memory");
}
__device__ __forceinline__ void p0_transpose_item(const float* W, int K, int N, bf16* WT, const float* ks, LAS float* scr, int item, int lane) {
    const int nblk = N / 32, kb = item / nblk, nb = item % nblk;
    p0_transpose_blk(W, K, N, WT, ks, scr, 64 * kb, 32 * nb, 32 * nb, lane);
}

__device__ __forceinline__ void p0_prologue(Frame& F, const Args& A) {
    unsigned char* ws = A.ws;
    bf16* WIN = (bf16*)(ws + WS_WIN); bf16* WO = (bf16*)(ws + WS_WO); bf16* W1 = (bf16*)(ws + WS_W1); bf16* W2 = (bf16*)(ws + WS_W2); bf16* XN = (bf16*)(ws + WS_XN);
    LAS float* scr = (LAS float*)(F.lds + RING_OFF + F.wave * 16384);
    const int gw = F.vcu * NWAVES + F.wave, NGW = F.G * NWAVES;
    constexpr int I_IN = (D / 64) * (NINP / 32), I_O = (D / 64) * (D / 32), I_1 = (D / 64) * (FF / 32), I_2 = (FF / 64) * (D / 32);
    constexpr int NITEMS = I_IN + I_O + I_1 + I_2;
    for (int it = gw; it < NITEMS; it += NGW) {
        int r = it;
        if (r < I_IN) { const int kb = r / (NINP / 32), gi = r % (NINP / 32), pn = gi >> 3, gl = gi & 7; int src;
            if (pn < 6) src = (pn >> 1) * 512 + ((pn & 1) * 4 + (gl & 3)) * 64 + 32 * (gl >> 2); else src = 1536 + (pn - 6) * 256 + gl * 32;
            if (src < NIN) p0_transpose_blk(A.in[8], D, NIN, WIN, A.in[7], scr, 64 * kb, src, 32 * gi, F.lane);
            else { GAS v4u* z = (GAS v4u*)(WIN + (size_t)(32 * gi) * D + 64 * kb);
                for (int i = F.lane; i < 32 * 8; i += 64) z[(size_t)(i >> 3) * (D * 2 / 16) + (i & 7)] = (v4u){0u, 0u, 0u, 0u}; }
            continue; } r -= I_IN;
        if (r < I_O) { p0_transpose_item(A.in[22], D, D, WO, nullptr, scr, r, F.lane); continue; } r -= I_O;
        if (r < I_1) { p0_transpose_item(A.in[24], D, FF, W1, A.in[23], scr, r, F.lane); continue; } r -= I_1;
        p0_transpose_item(A.in[25], FF, D, W2, nullptr, scr, r, F.lane);
    }
    { bf16* WLt = (bf16*)(ws + WS_LORA); bf16* ALt = WLt + 512 * 64; bf16* GLt = ALt + 512 * 64;
      for (int i = F.vcu * NTHR + F.tid; i < 512 * 288; i += F.G * NTHR) { const int c = i / 288, m = i % 288;
          if (m < 64) WLt[c * 64 + m] = (bf16)f2bf(A.in[13][m * 512 + c]); else if (m < 128) ALt[c * 64 + (m - 64)] = (bf16)f2bf(A.in[15][(m - 64) * 512 + c]); else GLt[c * 160 + (m - 128)] = (bf16)f2bf(A.in[16][(m - 128) * 512 + c]); } }
    float* RSTD = (float*)(ws + WS_RSTD);
    for (int m0 = gw; m0 < M; m0 += 2 * NGW) {
        f32x4 v[2][4]; float s[2] = {0.f, 0.f};
#pragma unroll
        for (int q = 0; q < 2; ++q) { const int m = (m0 + q * NGW < M) ? m0 + q * NGW : m0;
            const float* xrow = (m < MP) ? A.in[0] + (size_t)m * D : A.in[1] + (size_t)(m - MP) * D; const GAS f32x4* xr = (const GAS f32x4*)xrow + F.lane;
#pragma unroll
            for (int j = 0; j < 4; ++j) v[q][j] = xr[64 * j]; }
#pragma unroll
        for (int q = 0; q < 2; ++q)
#pragma unroll
            for (int j = 0; j < 4; ++j) s[q] += (v[q][j].x * v[q][j].x + v[q][j].y * v[q][j].y) + (v[q][j].z * v[q][j].z + v[q][j].w * v[q][j].w);
#pragma unroll
        for (int q = 0; q < 2; ++q) { const int m = m0 + q * NGW; if (m < M) {
            const float rstd = 1.0f / sqrtf(wave_sum(s[q]) * (1.f / D) + RMS_EPS);
            if (F.lane == 0) RSTD[m] = rstd;
            GAS unsigned long long* o8 = (GAS unsigned long long*)(XN + (size_t)m * D) + F.lane;
#pragma unroll
            for (int j = 0; j < 4; ++j) o8[64 * j] = (unsigned long long)pk2(v[q][j].x, v[q][j].y) | ((unsigned long long)pk2(v[q][j].z, v[q][j].w) << 32); } }
    }
}

__device__ __forceinline__ float bf2f(bf16 v) { return __builtin_bit_cast(float, (unsigned)v << 16); }
__device__ __forceinline__ void p2_post(Frame& F, const Args& A) {
    const bf16* PB = (const bf16*)(A.ws + WS_PB);
    LAS float* lin = (LAS float*)(F.lds + RING_OFF);
    float* RW = (float*)(A.ws + WS_RW); const size_t RS = RW_STRIDE / 4;
    const float* mu = A.in[11]; const float* w0 = A.in[12]; const float* wl2 = A.in[13]; const float* a0 = A.in[14]; const float* al2 = A.in[15]; const float* gl2 = A.in[16];
    const float* k_k = A.in[17]; const float* k_a = A.in[18]; const float* sshift = A.in[5];
    const int c = F.tid;
    for (int rb = F.vcu * 4; rb < MS; rb += F.G * 4) {
#define XSR(i_, cc) ({ const int rs_ = rb + (i_); const bf16* p_ = PB + (size_t)(MP + rs_) * 2048; const float x_ = bf2f(p_[cc]); \
            const float pv_ = ((rs_ & 7) == 0) ? sshift[(size_t)(rs_ >> 3) * NSHIFT + (cc)] : bf2f(p_[(cc) - 2048]); x_ + (pv_ - x_) * mu[cc]; })
        for (int idx = c; idx < 4 * 288; idx += NTHR) { const int i = idx / 288, cc = idx % 288; const float x = XSR(i, 1536 + cc); float a;
            if (cc < 64) a = tanhf(x); else if (cc < 128) a = x; else a = 1.0f / (1.0f + expf(-x));
            lin[idx] = a; }
        __syncthreads();
        float wl[4], al[4], g[4];
#pragma unroll
        for (int i = 0; i < 4; ++i) { wl[i] = w0[c]; al[i] = a0[c]; g[i] = 0.f; }
#pragma unroll 32
        for (int m = 0; m < 64; ++m) { const float ww = wl2[m * 512 + c], aw = al2[m * 512 + c];
#pragma unroll
            for (int i = 0; i < 4; ++i) { wl[i] += lin[i * 288 + m] * ww; al[i] += lin[i * 288 + 64 + m] * aw; } }
#pragma unroll 32
        for (int m = 0; m < 160; ++m) { const float gw_ = gl2[m * 512 + c];
#pragma unroll
            for (int i = 0; i < 4; ++i) g[i] += lin[i * 288 + 128 + m] * gw_; }
#pragma unroll
        for (int i = 0; i < 4; ++i) {
            const float r = XSR(i, c), k = XSR(i, 512 + c), v = XSR(i, 1024 + c);
            const float z = -wl[i]; const float sp = (z > 20.f) ? z : log1pf(expf(z));
            const float wlog = -sp - 0.5f; const float dec = expf(-expf(wlog));
            const float a = 1.0f / (1.0f + expf(-al[i]));
            const float kkv = k * k_k[c]; const float ss = wave_sum(kkv * kkv); const float kk = kkv / fmaxf(sqrtf(ss), 1e-12f);
            const float kp = k * (1.0f + (a - 1.0f) * k_a[c]);
            const size_t o = (size_t)(rb + i) * 512 + c;
            RW[0 * RS + o] = r; RW[1 * RS + o] = dec; RW[2 * RS + o] = kp; RW[3 * RS + o] = v; RW[4 * RS + o] = kk; RW[5 * RS + o] = a; RW[6 * RS + o] = g[i];
        }
#undef XSR
        __syncthreads();
    }
}

typedef short v4i16_t __attribute__((ext_vector_type(4)));
constexpr float LOG2E = 1.4426950408889634f;
constexpr int AT_O = 0, AT_VST = 65536, AT_L = 132096, AT_LUTF = 133120, AT_BKT = 135616, AT_B2 = 137216, AT_SLUT = 137472;
__device__ __forceinline__ int vst_off(int row, int ch) { return row * 128 + ((ch ^ ((((row >> 1) & 1) << 1) | (((row >> 3) & 1) << 2))) << 4); }
__device__ __forceinline__ int o_off(int qrow, int ch) { return qrow * 256 + ((ch ^ ((qrow ^ (qrow >> 4)) & 15)) << 4); }
__device__ __forceinline__ void attn_unit2(const bf16* __restrict__ Qh, const bf16* __restrict__ Kh, const bf16* __restrict__ Vh, int qbA, int qbB, int dsh, const LAS float* lutf, LAS unsigned char* vb, int lane, f32x4 (&o)[2][4], float (&lsum)[2]) {
    const int m = lane & 15, g = lane >> 4;
    int kbase[2]; kbase[0] = qbA - (128 << dsh); kbase[1] = qbB - (128 << dsh);
    bf16x8 qf0[2], qf1[2];
#pragma unroll
    for (int u = 0; u < 2; ++u) { const bf16* qp = Qh + (size_t)((u ? qbB : qbA) + (m << dsh)) * 64 + 16 * g; qf0[u] = *(const bf16x8*)qp; qf1[u] = *(const bf16x8*)(qp + 8);
#pragma unroll
        for (int et = 0; et < 4; ++et) o[u][et] = (f32x4){0.f, 0.f, 0.f, 0.f};
        lsum[u] = 0.f; }
    const int vrow = lane >> 3, vch = lane & 7;
    v4u vreg[2][4]; bf16x8 kf[2][4];
    const int voff = (((vrow) << dsh) << 7) + vch * 16, koff = (((8 * (m >> 2) + (m & 3)) << dsh) << 7) + 32 * g;
#define AU_LOAD(grp_) do { _Pragma("unroll") for (int u = 0; u < 2; ++u) { \
        const long rb_ = ((long)(kbase[u] + ((32 * (grp_)) << dsh))) << 7; const char* vbp = (const char*)Vh + rb_; const char* kbp = (const char*)Kh + rb_; \
        _Pragma("unroll") for (int it = 0; it < 4; ++it) vreg[u][it] = *(const v4u*)(vbp + (((long)((8 * it) << dsh)) << 7) + voff); \
        kf[u][0] = *(const bf16x8*)(kbp + koff); kf[u][1] = *(const bf16x8*)(kbp + koff + 16); \
        kf[u][2] = *(const bf16x8*)(kbp + (((long)(4 << dsh)) << 7) + koff); kf[u][3] = *(const bf16x8*)(kbp + (((long)(4 << dsh)) << 7) + koff + 16); } } while (0)
    int voffc[4];
#pragma unroll
    for (int it = 0; it < 4; ++it) { const int rl = 8 * it + vrow; voffc[it] = (((rl < 15 ? rl : 15) << dsh) << 7) + vch * 16; }
    const int kl_ = 8 * (m >> 2) + (m & 3); const int koffa = (((kl_ < 15 ? kl_ : 15) << dsh) << 7) + 32 * g, koffb = ((((kl_ + 4) < 15 ? (kl_ + 4) : 15) << dsh) << 7) + 32 * g;
#define AU_LOAD4() do { _Pragma("unroll") for (int u = 0; u < 2; ++u) { \
        const long rb_ = ((long)(kbase[u] + (128 << dsh))) << 7; const char* vbp = (const char*)Vh + rb_; const char* kbp = (const char*)Kh + rb_; \
        _Pragma("unroll") for (int it = 0; it < 4; ++it) vreg[u][it] = *(const v4u*)(vbp + voffc[it]); \
        kf[u][0] = *(const bf16x8*)(kbp + koffa); kf[u][1] = *(const bf16x8*)(kbp + koffa + 16); \
        kf[u][2] = *(const bf16x8*)(kbp + koffb); kf[u][3] = *(const bf16x8*)(kbp + koffb + 16); } } while (0)
    AU_LOAD(0);
    unsigned wofs[4], rofs[4];
#pragma unroll
    for (int it = 0; it < 4; ++it) { wofs[it] = (unsigned)vst_off(it * 8 + vrow, vch); rofs[it] = (unsigned)(vst_off(8 * g + (m >> 2), 2 * it + ((m & 3) >> 1)) + 8 * (m & 1)); }
    int nmin[2];
#pragma unroll
    for (int u = 0; u < 2; ++u) nmin[u] = kbase[u] < 0 ? ((-kbase[u] + (1 << dsh) - 1) >> dsh) : 0;
#pragma unroll 1
    for (int grp = 0; grp < 5; ++grp) {
        f32x4 s0[2], s1[2];
#pragma unroll
        for (int u = 0; u < 2; ++u) {
#pragma unroll
            for (int it = 0; it < 4; ++it) *(LAS v4u*)(vb + u * 4096 + wofs[it]) = vreg[u][it];
            s0[u] = __builtin_amdgcn_mfma_f32_16x16x32_bf16(kf[u][0], qf0[u], (f32x4){0.f, 0.f, 0.f, 0.f}, 0, 0, 0);
            s1[u] = __builtin_amdgcn_mfma_f32_16x16x32_bf16(kf[u][2], qf0[u], (f32x4){0.f, 0.f, 0.f, 0.f}, 0, 0, 0); }
#pragma unroll
        for (int u = 0; u < 2; ++u) {
            s0[u] = __builtin_amdgcn_mfma_f32_16x16x32_bf16(kf[u][1], qf1[u], s0[u], 0, 0, 0);
            s1[u] = __builtin_amdgcn_mfma_f32_16x16x32_bf16(kf[u][3], qf1[u], s1[u], 0, 0, 0); }
        if (grp < 3) AU_LOAD(grp + 1); else if (grp == 3) AU_LOAD4();
        const int nl = 32 * grp + 8 * g;
        const LAS float* lp = lutf + (nl - m + 32);
        bf16x8 pbf[2];
#pragma unroll
        for (int u = 0; u < 2; ++u) {
            float p0[4], p1[4];
#pragma unroll
            for (int i = 0; i < 4; ++i) { p0[i] = __builtin_amdgcn_exp2f(s0[u][i] + lp[i]); p1[i] = __builtin_amdgcn_exp2f(s1[u][i] + lp[4 + i]); }
            if (nmin[u] > 32 * grp) {
#pragma unroll
                for (int i = 0; i < 4; ++i) { if (nl + i < nmin[u]) p0[i] = 0.f; if (nl + 4 + i < nmin[u]) p1[i] = 0.f; }
            }
            lsum[u] += ((p0[0] + p0[1]) + (p0[2] + p0[3])) + ((p1[0] + p1[1]) + (p1[2] + p1[3]));
            v4u pw; pw.x = cvt2(p0[0], p0[1]); pw.y = cvt2(p0[2], p0[3]); pw.z = cvt2(p1[0], p1[1]); pw.w = cvt2(p1[2], p1[3]);
            pbf[u] = __builtin_bit_cast(bf16x8, pw);
        }
        asm volatile("" ::: "memory");
#pragma unroll
        for (int u = 0; u < 2; ++u) {
#pragma unroll
            for (int et = 0; et < 4; ++et) {
                const v4i16_t t0 = __builtin_amdgcn_ds_read_tr16_b64_v4i16((LAS v4i16_t*)(vb + u * 4096 + rofs[et]));
                const v4i16_t t1 = __builtin_amdgcn_ds_read_tr16_b64_v4i16((LAS v4i16_t*)(vb + u * 4096 + rofs[et] + 512));
                const bf16x8 va = (bf16x8){t0[0], t0[1], t0[2], t0[3], t1[0], t1[1], t1[2], t1[3]};
                o[u][et] = __builtin_amdgcn_mfma_f32_16x16x32_bf16(va, pbf[u], o[u][et], 0, 0, 0);
            }
        }
        asm volatile("" ::: "memory");
    }
#undef AU_LOAD
#undef AU_LOAD4
#pragma unroll
    for (int u = 0; u < 2; ++u) { lsum[u] += __shfl_xor(lsum[u], 16); lsum[u] += __shfl_xor(lsum[u], 32); }
}
__device__ __forceinline__ void attn_tile32(const bf16* __restrict__ Qh, const bf16* __restrict__ Kh, const bf16* __restrict__ Vh, int qb, int dsh, const LAS float* lutf, LAS unsigned char* vb, int lane, f32x4 (&o)[2][4], float (&lsum)[2]) {
    const int m = lane & 15, g = lane >> 4;
    const int kbase = qb - (128 << dsh);
    bf16x8 qf0[2], qf1[2];
#pragma unroll
    for (int u = 0; u < 2; ++u) { const bf16* qp = Qh + (size_t)(qb + ((m + 16 * u) << dsh)) * 64 + 16 * g; qf0[u] = *(const bf16x8*)qp; qf1[u] = *(const bf16x8*)(qp + 8);
#pragma unroll
        for (int et = 0; et < 4; ++et) o[u][et] = (f32x4){0.f, 0.f, 0.f, 0.f};
        lsum[u] = 0.f; }
    const int vrow = lane >> 3, vch = lane & 7;
    v4u vrA[4], vrB[4]; bf16x8 kfA[4], kfB[4];
    const int voff = (((vrow) << dsh) << 7) + vch * 16, koff = (((8 * (m >> 2) + (m & 3)) << dsh) << 7) + 32 * g;
#define T_LOAD(VR, KF, grp_) do { \
        const long rb_ = ((long)(kbase + ((32 * (grp_)) << dsh))) << 7; const char* vbp = (const char*)Vh + rb_; const char* kbp = (const char*)Kh + rb_; \
        _Pragma("unroll") for (int it = 0; it < 4; ++it) VR[it] = *(const v4u*)(vbp + (((long)((8 * it) << dsh)) << 7) + voff); \
        KF[0] = *(const bf16x8*)(kbp + koff); KF[1] = *(const bf16x8*)(kbp + koff + 16); \
        KF[2] = *(const bf16x8*)(kbp + (((long)(4 << dsh)) << 7) + koff); KF[3] = *(const bf16x8*)(kbp + (((long)(4 << dsh)) << 7) + koff + 16); } while (0)
    T_LOAD(vrA, kfA, 0); T_LOAD(vrB, kfB, 1);
    unsigned wofs[4], rofs[4];
#pragma unroll
    for (int it = 0; it < 4; ++it) { wofs[it] = (unsigned)vst_off(it * 8 + vrow, vch); rofs[it] = (unsigned)(vst_off(8 * g + (m >> 2), 2 * it + ((m & 3) >> 1)) + 8 * (m & 1)); }
    const int nmin = kbase < 0 ? ((-kbase + (1 << dsh) - 1) >> dsh) : 0;
#define T_STEP(VR, KF, grp) do { \
        LAS unsigned char* vbg = vb + ((grp) & 1) * 4096; \
        _Pragma("unroll") for (int it = 0; it < 4; ++it) *(LAS v4u*)(vbg + wofs[it]) = VR[it]; \
        f32x4 s0[2], s1[2]; \
        _Pragma("unroll") for (int u = 0; u < 2; ++u) { \
            s0[u] = __builtin_amdgcn_mfma_f32_16x16x32_bf16(KF[0], qf0[u], (f32x4){0.f, 0.f, 0.f, 0.f}, 0, 0, 0); \
            s1[u] = __builtin_amdgcn_mfma_f32_16x16x32_bf16(KF[2], qf0[u], (f32x4){0.f, 0.f, 0.f, 0.f}, 0, 0, 0); } \
        _Pragma("unroll") for (int u = 0; u < 2; ++u) { \
            s0[u] = __builtin_amdgcn_mfma_f32_16x16x32_bf16(KF[1], qf1[u], s0[u], 0, 0, 0); \
            s1[u] = __builtin_amdgcn_mfma_f32_16x16x32_bf16(KF[3], qf1[u], s1[u], 0, 0, 0); } \
        if ((grp) + 2 < 5) T_LOAD(VR, KF, (grp) + 2); \
        const int nl = 32 * (grp) + 8 * g; \
        bf16x8 pbf[2]; \
        _Pragma("unroll") for (int u = 0; u < 2; ++u) { \
            const LAS float* lp = lutf + (nl - m - 16 * u + 32); \
            float p0[4], p1[4]; \
            _Pragma("unroll") for (int i = 0; i < 4; ++i) { p0[i] = __builtin_amdgcn_exp2f(s0[u][i] + lp[i]); p1[i] = __builtin_amdgcn_exp2f(s1[u][i] + lp[4 + i]); } \
            if (nmin > 32 * (grp)) { \
                _Pragma("unroll") for (int i = 0; i < 4; ++i) { if (nl + i < nmin) p0[i] = 0.f; if (nl + 4 + i < nmin) p1[i] = 0.f; } } \
            lsum[u] += ((p0[0] + p0[1]) + (p0[2] + p0[3])) + ((p1[0] + p1[1]) + (p1[2] + p1[3])); \
            v4u pw; pw.x = cvt2(p0[0], p0[1]); pw.y = cvt2(p0[2], p0[3]); pw.z = cvt2(p1[0], p1[1]); pw.w = cvt2(p1[2], p1[3]); \
            pbf[u] = __builtin_bit_cast(bf16x8, pw); } \
        asm volatile("" ::: "memory"); \
        _Pragma("unroll") for (int et = 0; et < 4; ++et) { \
            const v4i16_t t0 = __builtin_amdgcn_ds_read_tr16_b64_v4i16((LAS v4i16_t*)(vbg + rofs[et])); \
            const v4i16_t t1 = __builtin_amdgcn_ds_read_tr16_b64_v4i16((LAS v4i16_t*)(vbg + rofs[et] + 512)); \
            const bf16x8 va = (bf16x8){t0[0], t0[1], t0[2], t0[3], t1[0], t1[1], t1[2], t1[3]}; \
            o[0][et] = __builtin_amdgcn_mfma_f32_16x16x32_bf16(va, pbf[0], o[0][et], 0, 0, 0); \
            o[1][et] = __builtin_amdgcn_mfma_f32_16x16x32_bf16(va, pbf[1], o[1][et], 0, 0, 0); } \
        asm volatile("" ::: "memory"); } while (0)
    T_STEP(vrA, kfA, 0); T_STEP(vrB, kfB, 1); T_STEP(vrA, kfA, 2); T_STEP(vrB, kfB, 3); T_STEP(vrA, kfA, 4);
#undef T_STEP
#undef T_LOAD
#pragma unroll
    for (int u = 0; u < 2; ++u) { lsum[u] += __shfl_xor(lsum[u], 16); lsum[u] += __shfl_xor(lsum[u], 32); }
}
struct SampleCtx { const float* QS; const float* ck; const float* cv; const float* kn; const float* vn; int sb, h; };
__device__ __forceinline__ const float* s_row(const float* cache, const float* nw, int sb, int h, int cpos) {
    return (cpos >= LWIN) ? nw + ((size_t)(sb * STOK + (cpos - LWIN < STOK ? cpos - LWIN : STOK - 1)) * NH + h) * 64 : cache + ((size_t)(sb * LWIN + cpos) * NH + h) * 64;
}
__device__ __forceinline__ void attn_unit_s(const SampleCtx& C, int qb, int dsh, int nmax, const LAS float* lutf, LAS unsigned char* vb, int lane, f32x4 (&o)[4], float& lsum) {
    const int m = lane & 15, g = lane >> 4;
    const int kbase = qb - (128 << dsh);
    const int qi = qb + (m << dsh) - LWIN;
    bf16x8 qf0 = (bf16x8){0, 0, 0, 0, 0, 0, 0, 0}, qf1 = qf0;
    if ((unsigned)qi < (unsigned)STOK) { const float* qp = C.QS + (size_t)(C.sb * STOK + qi) * 512 + C.h * 64 + 16 * g; const float sc = 0.125f * LOG2E;
        const f32x4 a = *(const f32x4*)qp * sc, b = *(const f32x4*)(qp + 4) * sc, c = *(const f32x4*)(qp + 8) * sc, d = *(const f32x4*)(qp + 12) * sc;
        v4u w0, w1; w0.x = cvt2(a[0], a[1]); w0.y = cvt2(a[2], a[3]); w0.z = cvt2(b[0], b[1]); w0.w = cvt2(b[2], b[3]); w1.x = cvt2(c[0], c[1]); w1.y = cvt2(c[2], c[3]); w1.z = cvt2(d[0], d[1]); w1.w = cvt2(d[2], d[3]);
        qf0 = __builtin_bit_cast(bf16x8, w0); qf1 = __builtin_bit_cast(bf16x8, w1); }
#pragma unroll
    for (int et = 0; et < 4; ++et) o[et] = (f32x4){0.f, 0.f, 0.f, 0.f};
    lsum = 0.f;
    const int vrow = lane >> 3, vch = lane & 7;
    f32x4 vrA[4][2], krA[2][4], vrB[4][2], krB[2][4];
#define AS_LOAD(VR, KR, grp_) do { \
        _Pragma("unroll") for (int it = 0; it < 4; ++it) { const int nv_ = 32 * (grp_) + it * 8 + vrow; const float* vp = s_row(C.cv, C.vn, C.sb, C.h, kbase + ((nv_ < nmax ? nv_ : nmax) << dsh)) + vch * 8; VR[it][0] = *(const f32x4*)vp; VR[it][1] = *(const f32x4*)(vp + 4); } \
        const int n0_ = 32 * (grp_) + 8 * (m >> 2) + (m & 3); \
        const float* ka = s_row(C.ck, C.kn, C.sb, C.h, kbase + ((n0_ < nmax ? n0_ : nmax) << dsh)) + 16 * g; const float* kb = s_row(C.ck, C.kn, C.sb, C.h, kbase + (((n0_ + 4) < nmax ? (n0_ + 4) : nmax) << dsh)) + 16 * g; \
        _Pragma("unroll") for (int j = 0; j < 4; ++j) { KR[0][j] = *(const f32x4*)(ka + 4 * j); KR[1][j] = *(const f32x4*)(kb + 4 * j); } } while (0)
    AS_LOAD(vrA, krA, 0); AS_LOAD(vrB, krB, 1);
#define AS_STEP(VR, KR, grp) do { \
        LAS unsigned char* vbg = vb + ((grp) & 1) * 4096; \
        _Pragma("unroll") for (int it = 0; it < 4; ++it) { v4u w; w.x = cvt2(VR[it][0][0], VR[it][0][1]); w.y = cvt2(VR[it][0][2], VR[it][0][3]); w.z = cvt2(VR[it][1][0], VR[it][1][1]); w.w = cvt2(VR[it][1][2], VR[it][1][3]); \
            *(LAS v4u*)(vbg + vst_off(it * 8 + vrow, vch)) = w; } \
        bf16x8 kf[4]; \
        _Pragma("unroll") for (int tl = 0; tl < 2; ++tl) { v4u w0, w1; w0.x = cvt2(KR[tl][0][0], KR[tl][0][1]); w0.y = cvt2(KR[tl][0][2], KR[tl][0][3]); w0.z = cvt2(KR[tl][1][0], KR[tl][1][1]); w0.w = cvt2(KR[tl][1][2], KR[tl][1][3]); \
            w1.x = cvt2(KR[tl][2][0], KR[tl][2][1]); w1.y = cvt2(KR[tl][2][2], KR[tl][2][3]); w1.z = cvt2(KR[tl][3][0], KR[tl][3][1]); w1.w = cvt2(KR[tl][3][2], KR[tl][3][3]); \
            kf[2 * tl] = __builtin_bit_cast(bf16x8, w0); kf[2 * tl + 1] = __builtin_bit_cast(bf16x8, w1); } \
        if ((grp) + 2 < 5) AS_LOAD(VR, KR, (grp) + 2); \
        f32x4 s0 = __builtin_amdgcn_mfma_f32_16x16x32_bf16(kf[0], qf0, (f32x4){0.f, 0.f, 0.f, 0.f}, 0, 0, 0); \
        s0 = __builtin_amdgcn_mfma_f32_16x16x32_bf16(kf[1], qf1, s0, 0, 0, 0); \
        f32x4 s1 = __builtin_amdgcn_mfma_f32_16x16x32_bf16(kf[2], qf0, (f32x4){0.f, 0.f, 0.f, 0.f}, 0, 0, 0); \
        s1 = __builtin_amdgcn_mfma_f32_16x16x32_bf16(kf[3], qf1, s1, 0, 0, 0); \
        const int nl = 32 * (grp) + 8 * g; \
        const LAS float* lp = lutf + (nl - m + 16); \
        float p0[4], p1[4]; \
        _Pragma("unroll") for (int i = 0; i < 4; ++i) { p0[i] = __builtin_amdgcn_exp2f(s0[i] + lp[i]); p1[i] = __builtin_amdgcn_exp2f(s1[i] + lp[4 + i]); } \
        lsum += ((p0[0] + p0[1]) + (p0[2] + p0[3])) + ((p1[0] + p1[1]) + (p1[2] + p1[3])); \
        v4u pw; pw.x = cvt2(p0[0], p0[1]); pw.y = cvt2(p0[2], p0[3]); pw.z = cvt2(p1[0], p1[1]); pw.w = cvt2(p1[2], p1[3]); \
        const bf16x8 pbf = __builtin_bit_cast(bf16x8, pw); \
        asm volatile("" ::: "memory"); \
        _Pragma("unroll") for (int et = 0; et < 4; ++et) { \
            const int r0 = 8 * g + (m >> 2), ch = 2 * et + ((m & 3) >> 1); \
            const v4i16_t t0 = __builtin_amdgcn_ds_read_tr16_b64_v4i16((LAS v4i16_t*)(vbg + vst_off(r0, ch) + 8 * (m & 1))); \
            const v4i16_t t1 = __builtin_amdgcn_ds_read_tr16_b64_v4i16((LAS v4i16_t*)(vbg + vst_off(r0 + 4, ch) + 8 * (m & 1))); \
            const bf16x8 va = (bf16x8){t0[0], t0[1], t0[2], t0[3], t1[0], t1[1], t1[2], t1[3]}; \
            o[et] = __builtin_amdgcn_mfma_f32_16x16x32_bf16(va, pbf, o[et], 0, 0, 0); } \
        asm volatile("" ::: "memory"); } while (0)
    AS_STEP(vrA, krA, 0); AS_STEP(vrB, krB, 1); AS_STEP(vrA, krA, 2); AS_STEP(vrB, krB, 3); AS_STEP(vrA, krA, 4);
#undef AS_STEP
#undef AS_LOAD
    lsum += __shfl_xor(lsum, 16); lsum += __shfl_xor(lsum, 32);
}
constexpr int CW_Q = 8192;
__device__ __forceinline__ int q_pop(Frame& F, int k) {
    if (F.tid == 0) F.MISC[16] = __hip_atomic_fetch_add(F.ctl + CW_Q + 64 * k, 1u, __ATOMIC_RELAXED, __HIP_MEMORY_SCOPE_AGENT);
    __syncthreads(); const int it = (int)F.MISC[16]; __syncthreads(); return it;
}
__device__ __forceinline__ unsigned q_take(Frame& F, int k) { return __hip_atomic_fetch_add(F.ctl + CW_Q + 64 * k, 1u, __ATOMIC_RELAXED, __HIP_MEMORY_SCOPE_AGENT); }
__device__ __forceinline__ void p3_attn(Frame& F, const Args& A) {
    const bf16* QB = (const bf16*)(A.ws + WS_QB); const bf16* KB = (const bf16*)(A.ws + WS_KB); const bf16* VB = (const bf16*)(A.ws + WS_VB); bf16* MIX = (bf16*)(A.ws + WS_MIX);
    const float* btab = A.in[6]; const int lane = F.lane;
    LAS unsigned char* Ob = F.lds + AT_O; LAS float* Lb = (LAS float*)(F.lds + AT_L); LAS float* lutf = (LAS float*)(F.lds + AT_LUTF); LAS int* bkt = (LAS int*)(F.lds + AT_BKT); LAS float* b2p = (LAS float*)(F.lds + AT_B2);
    LAS unsigned char* vb = F.lds + AT_VST + F.wave * 8192;
    for (int i = F.tid; i < 387; i += NTHR) { const int br = i / 129, j = i % 129; const int dist = j << (2 * br);
        int bk; if (dist < 16) bk = dist; else { bk = 16 + (int)(log((double)dist / 16.0) / log(128.0) * 16.0); if (bk > 31) bk = 31; }
        bkt[i] = bk; }
    if (F.wave == 0) { const float gqm = wave_max(fabsf(A.in[9][lane])), gkm = wave_max(fabsf(A.in[10][lane]));
        const float bm = wave_max(fmaxf(fmaxf(btab[lane * 4], btab[lane * 4 + 1]), fmaxf(btab[lane * 4 + 2], btab[lane * 4 + 3])));
        if (lane == 0) b2p[0] = (8.0f * gqm * gkm + bm) * LOG2E; }
    __syncthreads();
    const float B2 = b2p[0];
    const int m = lane & 15, g = lane >> 4;
    const int xq0 = (F.vcu * 8 / F.G) & 7; int lut_h = -1, slut_h = -1;
    SampleCtx C; C.QS = (const float*)(A.ws + WS_QS); C.ck = A.in[2]; C.cv = A.in[3]; C.kn = A.out + O_KNS; C.vn = A.out + O_VNS;
    LAS float* Oacc = (LAS float*)(F.lds + AT_O);
    LAS float* Lacc = Oacc + 4 * 8 * 64;
    LAS float* slut = (LAS float*)(F.lds + AT_SLUT);
    const int pl = 0;
    int pk = 0, cnt = 0; bool p_left = true, s_left = true;
    if (F.tid == 0) { F.MISC[17] = q_take(F, xq0); F.MISC[18] = q_take(F, 8); }
    __syncthreads();
#pragma unroll 1
    while (p_left || s_left) {
      if (p_left && !(s_left && cnt >= 2)) {
        const int xq = (xq0 + pk) & 7;
        const int qi = (int)F.MISC[17];
        if (qi >= 256) { ++pk; __syncthreads(); if (pk == 8) p_left = false; else { if (F.tid == 0) F.MISC[17] = q_take(F, (xq0 + pk) & 7); __syncthreads(); } continue; }
        ++cnt; unsigned nxp = 0;
        const int bh = (qi >> 5) * 8 + xq, qblk = qi & 31, h = bh & 7, b = bh >> 3, q0 = qblk * 256;
        const bf16* Qh = QB + (size_t)bh * SEQ * 64; const bf16* Kh = KB + (size_t)bh * SEQ * 64; const bf16* Vh = VB + (size_t)bh * SEQ * 64;
        if (h != lut_h) {
            for (int i = F.tid; i < 3 * 208; i += NTHR) { const int br = i / 208, dl = (i % 208) - 32; lutf[i] = (dl >= 0 && dl <= 128) ? btab[bkt[br * 129 + (128 - dl)] * NH + h] * LOG2E - B2 : -INFINITY; }
            lut_h = h; __syncthreads(); }
#pragma unroll 1
        for (int br = 0; br < 3; ++br) {
            if (br == 2 && F.tid == 0) nxp = q_take(F, xq);
            int qrel[2];
#pragma unroll
            for (int uu = 0; uu < 2; ++uu) { if (br == 0) qrel[uu] = 32 * F.wave + 16 * uu; else if (br == 1) qrel[uu] = 128 * (F.wave >> 2) + (F.wave & 3) + 64 * uu; else qrel[uu] = F.wave + 8 * uu; }
            f32x4 o[2][4]; float lsum[2];
            int ln = lane; asm volatile("" : "+v"(ln));
            if (br < 2) attn_tile32(Qh, Kh, Vh, q0 + qrel[0], 2 * br, lutf + br * 208, vb, ln, o, lsum);
            else attn_unit2(Qh, Kh, Vh, q0 + qrel[0], q0 + qrel[1], 2 * br, lutf + br * 208, vb, ln, o, lsum);
#pragma unroll
            for (int uu = 0; uu < 2; ++uu) {
                const int qrow = qrel[uu] + (m << (2 * br));
                if (br == 0) {
#pragma unroll
                    for (int et = 0; et < 4; ++et) *(LAS f32x4*)(Ob + o_off(qrow, 4 * et + g)) = o[uu][et];
                    if (g == 0) Lb[qrow] = lsum[uu];
                } else if (br == 1) {
#pragma unroll
                    for (int et = 0; et < 4; ++et) { LAS f32x4* p = (LAS f32x4*)(Ob + o_off(qrow, 4 * et + g)); *p = *p + o[uu][et]; }
                    if (g == 0) Lb[qrow] += lsum[uu];
                } else {
                    const float inv = 1.0f / (Lb[qrow] + lsum[uu]);
                    bf16* dst = MIX + (size_t)(b * SEQ + q0 + qrow) * D + h * 64 + 4 * g;
#pragma unroll
                    for (int et = 0; et < 4; ++et) { const f32x4 v = (*(LAS f32x4*)(Ob + o_off(qrow, 4 * et + g)) + o[uu][et]) * inv;
                        *(unsigned long long*)(dst + 16 * et) = (unsigned long long)cvt2(v[0], v[1]) | ((unsigned long long)cvt2(v[2], v[3]) << 32); }
                }
            }
            if (br == 2 && F.tid == 0) F.MISC[17] = nxp;
            __syncthreads();
        }
      } else {
        cnt = 0;
        const int qi = (int)F.MISC[18]; if (qi >= SBATCH * NH) { s_left = false; continue; }
        unsigned nxs = 0;
        const int pair = qi; C.sb = pair >> 3; C.h = pair & 7;
        for (int i = F.tid; i < 8 * 64; i += NTHR) Oacc[i] = 0.f;
        if (F.tid < 8) Lacc[F.tid] = 0.f;
        if (C.h != slut_h) { for (int i = F.tid; i < 3 * 192; i += NTHR) { const int br = i / 192, dl = (i % 192) - 16; slut[i] = (dl >= 0 && dl <= 128) ? btab[bkt[br * 129 + (128 - dl)] * NH + C.h] * LOG2E - B2 : -INFINITY; } slut_h = C.h; }
        __syncthreads();
#pragma unroll 1
        for (int u = F.wave; u < 13; u += 8) {
            if (u >= 8 && F.tid == 0) nxs = q_take(F, 8);
            int br, cls; if (u == 0) { br = 0; cls = 0; } else if (u < 5) { br = 1; cls = u - 1; } else { br = 2; cls = u - 5; }
            f32x4 o[4]; float lsum;
            int ln = lane; asm volatile("" : "+v"(ln));
            attn_unit_s(C, LWIN + cls, 2 * br, 128 + ((STOK - 1 - cls) >> (2 * br)), slut + br * 192, vb, ln, o, lsum);
            const int qi2 = cls + (m << (2 * br));
            if (qi2 < STOK) {
                LAS float* op = Oacc + (pl * 8 + qi2) * 64 + 4 * g;
#pragma unroll
                for (int et = 0; et < 4; ++et) {
#pragma unroll
                    for (int r = 0; r < 4; ++r) (void)__hip_atomic_fetch_add(op + 16 * et + r, o[et][r], __ATOMIC_RELAXED, __HIP_MEMORY_SCOPE_WORKGROUP); }
                if (g == 0) (void)__hip_atomic_fetch_add(Lacc + pl * 8 + qi2, lsum, __ATOMIC_RELAXED, __HIP_MEMORY_SCOPE_WORKGROUP);
            }
        }
        __syncthreads();
        if (F.wave == 0) { const int i = lane >> 3, e8 = (lane & 7) * 8; const float inv = 1.0f / Lacc[pl * 8 + i];
            const LAS float* op = Oacc + (pl * 8 + i) * 64 + e8;
            v4u w; w.x = cvt2(op[0] * inv, op[1] * inv); w.y = cvt2(op[2] * inv, op[3] * inv); w.z = cvt2(op[4] * inv, op[5] * inv); w.w = cvt2(op[6] * inv, op[7] * inv);
            *(v4u*)(MIX + (size_t)(MP + C.sb * STOK + i) * D + C.h * 64 + e8) = w; }
        if (F.tid == 0) F.MISC[18] = nxs;
        __syncthreads();
      }
    }
}

__device__ __forceinline__ void p4_scan(Frame& F, const Args& A, int gw, int NGW) {
    const float* RW = (const float*)(A.ws + WS_RW); const size_t RS = RW_STRIDE / 4; bf16* MIX = (bf16*)(A.ws + WS_MIX);
    const float* r_k = A.in[19]; const float* lnx_g = A.in[20]; const float* lnx_b = A.in[21]; const float* wkv0 = A.in[4];
    LAS float* sh = (LAS float*)(F.lds + RING_OFF + F.wave * 2048);
    const int lane = F.lane;
    for (int it0 = gw; it0 < SBATCH * NH; it0 += NGW) {
        const int it = it0 + BATCH * NH;
        const bool prompt = false; const int sq = it0 >> 3, h = it0 & 7;
        const int T = STOK; const size_t row0 = (size_t)MP + (size_t)sq * STOK;
        float S[64];
        if (prompt) {
#pragma unroll
            for (int j = 0; j < 64; ++j) S[j] = 0.f;
        } else { const f32x4* s0 = (const f32x4*)(wkv0 + ((size_t)(sq * NH + h) * 64 + lane) * 64);
#pragma unroll
            for (int j = 0; j < 16; ++j) { const f32x4 v = s0[j]; S[4 * j] = v.x; S[4 * j + 1] = v.y; S[4 * j + 2] = v.z; S[4 * j + 3] = v.w; } }
        const int c = h * 64 + lane; const float rkc = r_k[c], lg = lnx_g[c], lb = lnx_b[c];
        float nr, ndec, nkp, nv, nkk, na, ng;
        { const size_t o = (row0 - MP) * 512 + c; nr = RW[o]; ndec = RW[RS + o]; nkp = RW[2 * RS + o]; nv = RW[3 * RS + o]; nkk = RW[4 * RS + o]; na = RW[5 * RS + o]; ng = RW[6 * RS + o]; }
        for (int t = 0; t < T; ++t) {
            const float r = nr, dec = ndec, kp = nkp, v = nv, kk = nkk, a = na, g = ng;
            { const size_t o = (row0 - MP + (t + 1 < T ? t + 1 : t)) * 512 + c; nr = RW[o]; ndec = RW[RS + o]; nkp = RW[2 * RS + o]; nv = RW[3 * RS + o]; nkk = RW[4 * RS + o]; na = RW[5 * RS + o]; ng = RW[6 * RS + o]; }
            sh[lane] = r; sh[64 + lane] = dec; sh[128 + lane] = kp; sh[192 + lane] = kk; sh[256 + lane] = kk * a;
            LDS_WAIT(); asm volatile("" ::: "memory");
            float sk = 0.f;
#pragma unroll
            for (int j = 0; j < 64; ++j) sk += S[j] * sh[192 + j];
            float y = 0.f;
#pragma unroll
            for (int j = 0; j < 64; ++j) { S[j] = S[j] * sh[64 + j] - sk * sh[256 + j] + v * sh[128 + j]; y += S[j] * sh[j]; }
            const float bon = wave_sum(r * kp * rkc);
            const float mean = wave_sum(y) * (1.f / 64.f); const float dv = y - mean; const float var = wave_sum(dv * dv) * (1.f / 64.f);
            const float yo = dv * (1.0f / sqrtf(var + GN_EPS)) * lg + lb;
            MIX[(row0 + t) * D + 512 + c] = (bf16)f2bf((yo + bon * v) * g);
            LDS_WAIT(); asm volatile("" ::: "memory");
        }
        float* so = A.out + (prompt ? O_WKVP : O_WKVS) + ((size_t)(sq * NH + h) * 64 + lane) * 64;
#pragma unroll
        for (int j = 0; j < 16; ++j) ((f32x4*)so)[j] = (f32x4){S[4 * j], S[4 * j + 1], S[4 * j + 2], S[4 * j + 3]};
    }
}

constexpr int RS = 72;
constexpr int SLOT = 9216;
typedef unsigned u32x2_t __attribute__((ext_vector_type(2)));
__device__ __forceinline__ f32x4 mfma16(bf16x8 a, bf16x8 b, f32x4 c) { return __builtin_amdgcn_mfma_f32_16x16x32_bf16(a, b, c, 0, 0, 0); }
__device__ __forceinline__ f32x4 mm64(const LAS bf16* A, const LAS bf16* B, int ta, int tb, int lane, f32x4 acc) {
    const int r = lane & 15, g = lane >> 4;
    const LAS bf16* ap = A + (16 * ta + r) * RS + 8 * g; const LAS bf16* bp = B + (16 * tb + r) * RS + 8 * g;
    const bf16x8 a0 = *(const LAS bf16x8*)ap, a1 = *(const LAS bf16x8*)(ap + 32), b0 = *(const LAS bf16x8*)bp, b1 = *(const LAS bf16x8*)(bp + 32);
    acc = mfma16(a0, b0, acc); return mfma16(a1, b1, acc);
}
template <bool SWA, bool SWB>
__device__ __forceinline__ f32x4 mm64s(const LAS bf16* A, const LAS bf16* B, int ta, int tb, int lane, f32x4 acc) {
    const int r = lane & 15, g = lane >> 4;
    const int ra = 16 * ta + r, rb = 16 * tb + r, xa = SWA ? ((ra >> 3) & 7) : 0, xb = SWB ? ((rb >> 3) & 7) : 0;
    const LAS bf16* ap = A + ra * RS; const LAS bf16* bp = B + rb * RS;
    const bf16x8 a0 = *(const LAS bf16x8*)(ap + 8 * (g ^ xa)), a1 = *(const LAS bf16x8*)(ap + 8 * ((g + 4) ^ xa)), b0 = *(const LAS bf16x8*)(bp + 8 * (g ^ xb)), b1 = *(const LAS bf16x8*)(bp + 8 * ((g + 4) ^ xb));
    acc = mfma16(a0, b0, acc); return mfma16(a1, b1, acc);
}

struct Frag2 { bf16x8 f[2][2]; };
template <bool SW> __device__ __forceinline__ void ldfrag(const LAS bf16* M, int blk, int lane, Frag2& F_) {
    const int r = lane & 15, g = lane >> 4;
#pragma unroll
    for (int x = 0; x < 2; ++x) { const int row = 32 * blk + 16 * x + r, xs = SW ? ((row >> 3) & 7) : 0; const LAS bf16* p = M + row * RS;
        F_.f[x][0] = *(const LAS bf16x8*)(p + 8 * (g ^ xs)); F_.f[x][1] = *(const LAS bf16x8*)(p + 8 * ((g + 4) ^ xs)); }
}
__device__ __forceinline__ void mmblk(const Frag2& a, const Frag2& b, f32x4 (&acc)[2][2]) {
#pragma unroll
    for (int x = 0; x < 2; ++x)
#pragma unroll
        for (int y = 0; y < 2; ++y) { acc[x][y] = mfma16(a.f[x][0], b.f[y][0], acc[x][y]); acc[x][y] = mfma16(a.f[x][1], b.f[y][1], acc[x][y]); }
}
#define ZERO22(acc) do { _Pragma("unroll") for (int x = 0; x < 2; ++x) _Pragma("unroll") for (int y = 0; y < 2; ++y) acc[x][y] = (f32x4){0.f, 0.f, 0.f, 0.f}; } while (0)
__device__ __forceinline__ int dm_off(int j, int t) { return j * RS + (t ^ (8 * ((j >> 3) & 7))); }
__device__ __forceinline__ u32x2_t pack4(f32x4 v) { u32x2_t w; w.x = cvt2(v[0], v[1]); w.y = cvt2(v[2], v[3]); return w; }
__device__ __forceinline__ void st_t(LAS bf16* Dst, int c, int r0, f32x4 v) { *(LAS u32x2_t*)(Dst + c * RS + r0) = pack4(v); }
#define BARRIER() asm volatile("s_waitcnt lgkmcnt(0)\n\ts_barrier" ::: "memory")


__device__ __forceinline__ void r1_lin(Frame& F, const bf16* PB, const float* mu, bf16* LIN) {
    const int nvec = MP * 36;
#pragma unroll 1
    for (int base = F.vcu * NTHR + F.tid; base < nvec; base += 4 * F.G * NTHR) {
        v4u xv[4], pv[4];
#pragma unroll
        for (int k = 0; k < 4; ++k) { const int vi = base + k * F.G * NTHR; xv[k] = (v4u){0u, 0u, 0u, 0u}; pv[k] = xv[k];
            if (vi < nvec) { const int row = vi / 36, v8 = vi % 36; const bf16* pr = PB + (size_t)row * 2048 + 1536 + 8 * v8;
                xv[k] = *(const v4u*)pr; if ((row & (SEQ - 1)) != 0) pv[k] = *(const v4u*)(pr - 2048); } }
#pragma unroll
        for (int k = 0; k < 4; ++k) { const int vi = base + k * F.G * NTHR;
            if (vi < nvec) { const int row = vi / 36, v8 = vi % 36; const float* mp = mu + 1536 + 8 * v8;
                const f32x4 m0 = *(const f32x4*)mp, m1 = *(const f32x4*)(mp + 4); float a[8];
#pragma unroll
                for (int i = 0; i < 8; ++i) { const unsigned sh = (i & 1) * 16;
                    const float x = __builtin_bit_cast(float, ((xv[k][i >> 1] >> sh) & 0xffffu) << 16), p = __builtin_bit_cast(float, ((pv[k][i >> 1] >> sh) & 0xffffu) << 16);
                    const float xs = x + (p - x) * (i < 4 ? m0[i & 3] : m1[i & 3]);
                    if (v8 < 8) a[i] = 1.0f - 2.0f * __builtin_amdgcn_rcpf(1.0f + __expf(2.0f * xs));
                    else if (v8 < 16) a[i] = xs;
                    else a[i] = __builtin_amdgcn_rcpf(1.0f + __expf(-xs)); }
                v4u w_; w_.x = cvt2(a[0], a[1]); w_.y = cvt2(a[2], a[3]); w_.z = cvt2(a[4], a[5]); w_.w = cvt2(a[6], a[7]);
                *(v4u*)(LIN + (size_t)row * 288 + 8 * v8) = w_; } }
    }
}
struct R1Ptrs {
    const bf16* LIN;
    const bf16* PB; const bf16* WLt; const bf16* ALt; const bf16* GLt;
    const float *mu, *w0, *a0, *k_k, *k_a, *r_k;
    bf16* PT; bf16* RP; bf16* QM; bf16* Y0; float* GC; bf16* G2; bf16* BV;
};
struct R1W { bf16x8 wa0, wa1, aa0, aa1; };
__device__ __forceinline__ void r1_load_w(Frame& F, const R1Ptrs& P, int h, R1W& W) {
    const int ta = F.wave >> 1, r = F.lane & 15, g = F.lane >> 4;
    const bf16* wa = P.WLt + (size_t)(h * 64 + 16 * ta + r) * 64 + 8 * g; const bf16* aa = P.ALt + (size_t)(h * 64 + 16 * ta + r) * 64 + 8 * g; const bf16* ga = P.GLt + (size_t)(h * 64 + 16 * ta + r) * 160 + 8 * g;
    W.wa0 = *(const bf16x8*)wa; W.wa1 = *(const bf16x8*)(wa + 32); W.aa0 = *(const bf16x8*)aa; W.aa1 = *(const bf16x8*)(aa + 32); (void)ga;
}
__device__ __forceinline__ void r1_load_par(Frame& F, const R1Ptrs& P, int h) {
    LAS float* par = (LAS float*)(F.lds + 14 * SLOT); const int i = F.tid;
    if (i < 512) { const int a = i >> 6, j = i & 63; float v;
        if (a < 3) v = P.mu[a * 512 + h * 64 + j]; else if (a == 3) v = P.w0[h * 64 + j]; else if (a == 4) v = P.a0[h * 64 + j]; else if (a == 5) v = P.k_k[h * 64 + j]; else if (a == 6) v = P.k_a[h * 64 + j]; else v = P.r_k[h * 64 + j];
        par[i] = v; }
    __syncthreads();
}
struct R1Pre { v4u xr, xk, xv, qr, qk, qv; bf16x8 lw0[2], lw1[2], la0[2], la1[2]; };
__device__ __forceinline__ void r1_prefetch(const R1Ptrs& P, int tid, int w, int bh, int c, R1Pre& N) {
    const int lane = tid & 63, h = bh & 7, b = bh >> 3; const size_t row0 = (size_t)b * SEQ + (size_t)c * 64;
    { const int t = tid >> 3, jb = (tid & 7) * 8, hj = h * 64 + jb; const bf16* pr = P.PB + (row0 + t) * 2048 + hj; const bool first = (c == 0 && t == 0);
      N.xr = *(const v4u*)pr; N.xk = *(const v4u*)(pr + 512); N.xv = *(const v4u*)(pr + 1024);
      N.qr = (v4u){0u, 0u, 0u, 0u}; N.qk = N.qr; N.qv = N.qr;
      if (!first) { N.qr = *(const v4u*)(pr - 2048); N.qk = *(const v4u*)(pr - 2048 + 512); N.qv = *(const v4u*)(pr - 2048 + 1024); } }
#pragma unroll
    for (int tt = 0; tt < 2; ++tt) { const int r = lane & 15, g = lane >> 4, tcol = 16 * (2 * (w & 1) + tt) + r; const bf16* bw = P.LIN + (row0 + tcol) * 288 + 8 * g;
      N.lw0[tt] = *(const bf16x8*)bw; N.lw1[tt] = *(const bf16x8*)(bw + 32); N.la0[tt] = *(const bf16x8*)(bw + 64); N.la1[tt] = *(const bf16x8*)(bw + 96); }
}
__device__ __forceinline__ void r1_item(Frame& F, const R1Ptrs& P, const R1W& W, R1Pre& N, int bh, int c, bool has_next) {
    int tid_ = F.tid; asm volatile("" : "+v"(tid_));
    const int tid = tid_, lane = tid & 63, w = F.wave, h = bh & 7, b = bh >> 3;
    const int ch = bh * 128 + c; const size_t row0 = (size_t)b * SEQ + (size_t)c * 64;
    LAS unsigned char* L = F.lds;
#define SL(k) ((LAS bf16*)(L + (k) * SLOT))
    LAS float* wlf = (LAS float*)(L + 0 * SLOT); LAS float* alf = (LAS float*)(L + 2 * SLOT); LAS float* cum = (LAS float*)(L + 12 * SLOT);
    LAS float* segtot = (LAS float*)(L + 11 * SLOT);
    {
        const int ta = w >> 1, r = lane & 15, g = lane >> 4;
#pragma unroll
        for (int tt = 0; tt < 2; ++tt) {
            const int tb = 2 * (w & 1) + tt, tcol = 16 * tb + r, j0 = 16 * ta + 4 * g;
            f32x4 dw = (f32x4){0.f, 0.f, 0.f, 0.f}, da = dw;
            dw = mfma16(W.wa0, N.lw0[tt], dw); dw = mfma16(W.wa1, N.lw1[tt], dw); da = mfma16(W.aa0, N.la0[tt], da); da = mfma16(W.aa1, N.la1[tt], da);
            *(LAS f32x4*)(wlf + tcol * 68 + j0) = dw; *(LAS f32x4*)(alf + tcol * 68 + j0) = da;
        }
    }
    BARRIER();
    const int t = tid >> 3, jb = (tid & 7) * 8, hj = h * 64 + jb; (void)hj;
    const LAS float* par = (const LAS float*)(L + 14 * SLOT);
    float r_[8], kp_[8], v_[8], kk_[8], lr_[8], lw_[8];
    {
        const v4u xr = N.xr, xk = N.xk, xv = N.xv, qr = N.qr, qk = N.qk, qv = N.qv;
        const f32x4 wl0 = *(const LAS f32x4*)(wlf + t * 68 + jb), wl1 = *(const LAS f32x4*)(wlf + t * 68 + jb + 4), al0 = *(const LAS f32x4*)(alf + t * 68 + jb), al1 = *(const LAS f32x4*)(alf + t * 68 + jb + 4);
        float ssq = 0.f, bon = 0.f; float kraw[8];
#pragma unroll
        for (int i = 0; i < 8; ++i) {
            const unsigned sh = (i & 1) * 16;
            const float x_r = __builtin_bit_cast(float, ((xr[i >> 1] >> sh) & 0xffffu) << 16), x_k = __builtin_bit_cast(float, ((xk[i >> 1] >> sh) & 0xffffu) << 16), x_v = __builtin_bit_cast(float, ((xv[i >> 1] >> sh) & 0xffffu) << 16);
            const float p_r = __builtin_bit_cast(float, ((qr[i >> 1] >> sh) & 0xffffu) << 16), p_k = __builtin_bit_cast(float, ((qk[i >> 1] >> sh) & 0xffffu) << 16), p_v = __builtin_bit_cast(float, ((qv[i >> 1] >> sh) & 0xffffu) << 16);
            r_[i] = x_r + (p_r - x_r) * par[jb + i]; kraw[i] = x_k + (p_k - x_k) * par[64 + jb + i]; v_[i] = x_v + (p_v - x_v) * par[128 + jb + i];
            const float wl = par[192 + jb + i] + (i < 4 ? wl0[i & 3] : wl1[i & 3]), al = par[256 + jb + i] + (i < 4 ? al0[i & 3] : al1[i & 3]);
            lw_[i] = -0.60653065971f * __builtin_amdgcn_rcpf(1.0f + __expf(-wl));
            lr_[i] = __builtin_amdgcn_rcpf(1.0f + __expf(-al));
            const float kkv = kraw[i] * par[320 + jb + i]; kk_[i] = kkv; ssq += kkv * kkv;
            kp_[i] = kraw[i] * (1.0f + (lr_[i] - 1.0f) * par[384 + jb + i]);
            bon += r_[i] * kp_[i] * par[448 + jb + i];
        }
        ssq += __shfl_xor(ssq, 1); ssq += __shfl_xor(ssq, 2); ssq += __shfl_xor(ssq, 4);
        bon += __shfl_xor(bon, 1); bon += __shfl_xor(bon, 2); bon += __shfl_xor(bon, 4);
        const float rn = 1.0f / fmaxf(sqrtf(ssq), 1e-12f);
#pragma unroll
        for (int i = 0; i < 8; ++i) kk_[i] *= rn;
        v4u bvw; bvw.x = cvt2(bon * v_[0], bon * v_[1]); bvw.y = cvt2(bon * v_[2], bon * v_[3]); bvw.z = cvt2(bon * v_[4], bon * v_[5]); bvw.w = cvt2(bon * v_[6], bon * v_[7]);
        { bf16* bg = P.BV + (((row0 + t) * 8 + h) * 16 + (jb >> 2)) * 8; *(u32x2_t*)bg = (u32x2_t){bvw.x, bvw.y}; *(u32x2_t*)(bg + 8) = (u32x2_t){bvw.z, bvw.w}; }
        *(LAS f32x4*)(cum + t * 68 + jb) = (f32x4){lw_[0], lw_[1], lw_[2], lw_[3]}; *(LAS f32x4*)(cum + t * 68 + jb + 4) = (f32x4){lw_[4], lw_[5], lw_[6], lw_[7]};
    }
    BARRIER();
    { const int seg = tid >> 6, j = tid & 63; float acc = 0.f;
#pragma unroll
      for (int i = 0; i < 8; ++i) { acc += cum[(8 * seg + i) * 68 + j]; cum[(8 * seg + i) * 68 + j] = acc; }
      segtot[seg * 64 + j] = acc; }
    BARRIER();
    { const int seg = tid >> 6, j = tid & 63; float off = 0.f;
      for (int s = 0; s < seg; ++s) off += segtot[s * 64 + j];
#pragma unroll
      for (int i = 0; i < 8; ++i) cum[(8 * seg + i) * 68 + j] += off; }
    BARRIER();
    LAS bf16* Atm = SL(0); LAS bf16* Btm = SL(1); LAS bf16* Ktm = SL(2); LAS bf16* Rtm = SL(3); LAS bf16* Adm = SL(4); LAS bf16* Bhd = SL(5); LAS bf16* Khd = SL(6); LAS bf16* Vdm = SL(7);
    {
        const f32x4 c0 = *(const LAS f32x4*)(cum + t * 68 + jb), c1 = *(const LAS f32x4*)(cum + t * 68 + jb + 4), e0 = *(const LAS f32x4*)(cum + 63 * 68 + jb), e1 = *(const LAS f32x4*)(cum + 63 * 68 + jb + 4);
        float at[8], bt[8], kt[8], rt[8], bh_[8], kh_[8];
#pragma unroll
        for (int i = 0; i < 8; ++i) {
            const float cc = (i < 4) ? c0[i & 3] : c1[i & 3], ce = (i < 4) ? e0[i & 3] : e1[i & 3];
            const float em = __expf(-cc), ep = __expf(cc), epm1 = __expf(cc - lw_[i]), ec = __expf(ce - cc);
            const float kl = kk_[i] * lr_[i];
            at[i] = -kk_[i] * epm1; bt[i] = kl * em; kt[i] = kp_[i] * em; rt[i] = r_[i] * ep; bh_[i] = kl * ec; kh_[i] = kp_[i] * ec;
            if (t == 63) P.GC[(size_t)ch * 64 + jb + i] = __expf(ce);
        }
#define ST8(M, a) do { v4u _w; _w.x = cvt2(a[0], a[1]); _w.y = cvt2(a[2], a[3]); _w.z = cvt2(a[4], a[5]); _w.w = cvt2(a[6], a[7]); *(LAS v4u*)(M + t * RS + jb) = _w; } while (0)
        ST8(Atm, at); ST8(Btm, bt); ST8(Ktm, kt); ST8(Rtm, rt);
#undef ST8
#pragma unroll
        for (int i = 0; i < 8; ++i) { const int o_ = dm_off(jb + i, t); Adm[o_] = (bf16)f2bf(at[i]); Bhd[o_] = (bf16)f2bf(bh_[i]); Khd[o_] = (bf16)f2bf(kh_[i]); Vdm[o_] = (bf16)f2bf(v_[i]); }
    }
    BARRIER();
    LAS float* TBf = (LAS float*)(L + 8 * SLOT); LAS bf16* TBb = SL(10); LAS bf16* TK = SL(11); LAS bf16* MBRt = SL(12);
    const int ta = w >> 1, cl = lane & 15, g = lane >> 4; (void)ta;
    const int bi = (w >> 1) & 1, bj = w & 1;
    if (w < 4) {
        Frag2 fa, fb, fk; ldfrag<false>(Atm, bi, lane, fa); ldfrag<false>(Btm, bj, lane, fb); ldfrag<false>(Ktm, bj, lane, fk);
        f32x4 d1[2][2], d2[2][2]; ZERO22(d1); ZERO22(d2); mmblk(fa, fb, d1); mmblk(fa, fk, d2);
#pragma unroll
        for (int x = 0; x < 2; ++x)
#pragma unroll
            for (int y = 0; y < 2; ++y) { const int col = 32 * bj + 16 * y + cl, r0 = 32 * bi + 16 * x + 4 * g;
#pragma unroll
                for (int i = 0; i < 4; ++i) if (!(col < r0 + i)) { d1[x][y][i] = 0.f; d2[x][y][i] = 0.f; }
                *(LAS f32x4*)(TBf + col * 68 + r0) = d1[x][y]; st_t(TBb, col, r0, d1[x][y]); st_t(TK, col, r0, d2[x][y]); }
    } else {
        Frag2 fb, fr; ldfrag<false>(Btm, bi, lane, fb); ldfrag<false>(Rtm, bj, lane, fr);
        f32x4 d3[2][2]; ZERO22(d3); mmblk(fb, fr, d3);
#pragma unroll
        for (int x = 0; x < 2; ++x)
#pragma unroll
            for (int y = 0; y < 2; ++y) { const int col = 32 * bj + 16 * y + cl, r0 = 32 * bi + 16 * x + 4 * g;
#pragma unroll
                for (int i = 0; i < 4; ++i) if (!(r0 + i <= col)) d3[x][y][i] = 0.f;
                st_t(MBRt, col, r0, d3[x][y]); }
    }
    BARRIER();
    LAS bf16* Minv = SL(0); LAS bf16* MinvT = SL(1); LAS bf16* Wsc = SL(13);
    for (int i = tid; i < 2 * SLOT / 4; i += NTHR) ((LAS unsigned*)Minv)[i] = 0u;
    BARRIER();
    if (w != 0) {
        const int r = lane & 15, g = lane >> 4;
#pragma unroll 1
        for (int k = w - 1; k < 16; k += 7) {
            const int ja = k >> 2, tb = k & 3, tcol = 16 * tb + r, j0 = 16 * ja + 4 * g;
            const bf16* ga = P.GLt + (size_t)(h * 64 + 16 * ja + r) * 160 + 8 * g; const bf16* bg = P.LIN + (row0 + tcol) * 288 + 128 + 8 * g;
            bf16x8 fa[5], fb[5];
#pragma unroll
            for (int ks = 0; ks < 5; ++ks) { fa[ks] = *(const bf16x8*)(ga + 32 * ks); fb[ks] = *(const bf16x8*)(bg + 32 * ks); }
            f32x4 dg = (f32x4){0.f, 0.f, 0.f, 0.f};
#pragma unroll
            for (int ks = 0; ks < 5; ++ks) dg = mfma16(fa[ks], fb[ks], dg);
            *(u32x2_t*)(P.BV + (((row0 + tcol) * 8 + h) * 16 + (j0 >> 2)) * 8 + 4) = pack4(dg);
        }
    }
    if (w == 0) {
        {
            const int blk = lane >> 4, cc = lane & 15; float x[16];
#pragma unroll
            for (int rr = 15; rr >= 0; --rr) {
                float s = (rr == cc) ? 1.f : 0.f;
                const LAS float* trow = TBf + (16 * blk + rr) * 68 + 16 * blk;
#pragma unroll
                for (int k = rr + 1; k < 16; ++k) s += trow[k] * x[k];
                x[rr] = s; asm volatile("" ::: "memory");
            }
#pragma unroll
            for (int rr = 0; rr < 16; ++rr) { const bf16 xb = (bf16)f2bf(x[rr]); Minv[(16 * blk + rr) * RS + 16 * blk + cc] = xb; MinvT[(16 * blk + cc) * RS + 16 * blk + rr] = xb; }
        }
        asm volatile("s_waitcnt lgkmcnt(0)" ::: "memory");
#pragma unroll 1
        for (int lev = 1; lev < 4; ++lev)
#pragma unroll 1
            for (int bi = 0; bi + lev < 4; ++bi) {
                const int bj = bi + lev;
                f32x4 wv = mm64(TBb, MinvT, bi, bj, lane, (f32x4){0.f, 0.f, 0.f, 0.f});
                *(LAS u32x2_t*)(Wsc + cl * RS + 4 * g) = pack4(wv);
                asm volatile("s_waitcnt lgkmcnt(0)" ::: "memory");
                bf16x8 a0 = *(const LAS bf16x8*)(Minv + (16 * bi + cl) * RS + 16 * bi + 8 * (g & 1));
                bf16x8 b0 = *(const LAS bf16x8*)(Wsc + cl * RS + 8 * (g & 1));
                if (g >= 2) { a0 = (bf16x8){0, 0, 0, 0, 0, 0, 0, 0}; b0 = a0; }
                const f32x4 xv = mfma16(a0, b0, (f32x4){0.f, 0.f, 0.f, 0.f});
                *(LAS u32x2_t*)(MinvT + (16 * bj + cl) * RS + 16 * bi + 4 * g) = pack4(xv);
#pragma unroll
                for (int i = 0; i < 4; ++i) Minv[(16 * bi + 4 * g + i) * RS + 16 * bj + cl] = (bf16)f2bf(xv[i]);
                asm volatile("s_waitcnt lgkmcnt(0)" ::: "memory");
            }
    }
    BARRIER();
    if (has_next) r1_prefetch(P, tid, w, bh, c + 1, N);
    LAS bf16* GT = SL(13); LAS bf16* ZT = SL(8);
    {
        Frag2 fa, fb; ldfrag<false>(Minv, bi, lane, fa);
        if (w < 4) ldfrag<false>(MBRt, bj, lane, fb); else ldfrag<true>(Bhd, bj, lane, fb);
        f32x4 d[2][2]; ZERO22(d); mmblk(fa, fb, d);
        LAS bf16* dst = (w < 4) ? GT : ZT;
#pragma unroll
        for (int x = 0; x < 2; ++x)
#pragma unroll
            for (int y = 0; y < 2; ++y) st_t(dst, 32 * bj + 16 * y + cl, 32 * bi + 16 * x + 4 * g, d[x][y]);
    }
    BARRIER();
    LAS bf16* HT = SL(9); LAS bf16* XT = SL(10);
    {
        Frag2 ftk; ldfrag<false>(TK, bi, lane, ftk);
        f32x4 d[2][2];
        if (w < 4) {
            Frag2 fk, fr, fg; ldfrag<false>(Ktm, bi, lane, fk); ldfrag<false>(Rtm, bj, lane, fr); ldfrag<false>(GT, bj, lane, fg);
            ZERO22(d); mmblk(fk, fr, d);
#pragma unroll
            for (int x = 0; x < 2; ++x)
#pragma unroll
                for (int y = 0; y < 2; ++y) { const int col = 32 * bj + 16 * y + cl, r0 = 32 * bi + 16 * x + 4 * g;
#pragma unroll
                    for (int i = 0; i < 4; ++i) if (!(r0 + i <= col)) d[x][y][i] = 0.f; }
            mmblk(ftk, fg, d);
#pragma unroll
            for (int x = 0; x < 2; ++x)
#pragma unroll
                for (int y = 0; y < 2; ++y) st_t(HT, 32 * bj + 16 * y + cl, 32 * bi + 16 * x + 4 * g, d[x][y]);
        } else {
            Frag2 fz; ldfrag<false>(ZT, bj, lane, fz);
#pragma unroll
            for (int x = 0; x < 2; ++x)
#pragma unroll
                for (int y = 0; y < 2; ++y) { const int col = 32 * bj + 16 * y + cl, r0 = 32 * bi + 16 * x + 4 * g;
                    const u32x2_t kh = *(const LAS u32x2_t*)(Khd + dm_off(col, r0));
                    d[x][y][0] = __builtin_bit_cast(float, kh.x << 16); d[x][y][1] = __builtin_bit_cast(float, kh.x & 0xffff0000u); d[x][y][2] = __builtin_bit_cast(float, kh.y << 16); d[x][y][3] = __builtin_bit_cast(float, kh.y & 0xffff0000u); }
            mmblk(ftk, fz, d);
#pragma unroll
            for (int x = 0; x < 2; ++x)
#pragma unroll
                for (int y = 0; y < 2; ++y) st_t(XT, 32 * bj + 16 * y + cl, 32 * bi + 16 * x + 4 * g, d[x][y]);
        }
    }
    BARRIER();
    asm volatile("; prefetch retired" :: "v"(N.xr), "v"(N.xk), "v"(N.xv), "v"(N.qr), "v"(N.qk), "v"(N.qv));
    asm volatile("; prefetch retired" :: "v"(N.lw0[0]), "v"(N.lw1[0]), "v"(N.la0[0]), "v"(N.la1[0]), "v"(N.lw0[1]), "v"(N.lw1[1]), "v"(N.la0[1]), "v"(N.la1[1]));
    {
        const int prod = w >> 1, rb = w & 1;
        Frag2 fa;
        if (prod == 0 || prod == 2) ldfrag<true>(Adm, rb, lane, fa); else if (prod == 1) ldfrag<false>(XT, rb, lane, fa); else ldfrag<true>(Vdm, rb, lane, fa);
#pragma unroll
        for (int cb = 0; cb < 2; ++cb) {
            Frag2 fb;
            if (prod == 0) ldfrag<false>(ZT, cb, lane, fb); else if (prod == 1) ldfrag<true>(Vdm, cb, lane, fb); else if (prod == 2) ldfrag<false>(GT, cb, lane, fb); else ldfrag<false>(HT, cb, lane, fb);
            f32x4 d[2][2]; ZERO22(d);
            if (prod == 2) {
#pragma unroll
                for (int x = 0; x < 2; ++x)
#pragma unroll
                    for (int y = 0; y < 2; ++y) { const u32x2_t rr = *(const LAS u32x2_t*)(Rtm + (32 * cb + 16 * y + cl) * RS + 32 * rb + 16 * x + 4 * g);
                        d[x][y][0] = __builtin_bit_cast(float, rr.x << 16); d[x][y][1] = __builtin_bit_cast(float, rr.x & 0xffff0000u); d[x][y][2] = __builtin_bit_cast(float, rr.y << 16); d[x][y][3] = __builtin_bit_cast(float, rr.y & 0xffff0000u); }
            }
            mmblk(fa, fb, d);
#pragma unroll
            for (int x = 0; x < 2; ++x)
#pragma unroll
                for (int y = 0; y < 2; ++y) { const int col = 32 * cb + 16 * y + cl, r0 = 32 * rb + 16 * x + 4 * g;
                    if (prod == 0) *(u32x2_t*)(P.PT + (size_t)ch * 4096 + col * 64 + r0) = pack4(d[x][y]);
                    else if (prod == 1) *(u32x2_t*)(P.QM + (size_t)ch * 4096 + col * 64 + r0) = pack4(d[x][y]);
                    else if (prod == 2) *(u32x2_t*)(P.RP + (size_t)ch * 4096 + col * 64 + r0) = pack4(d[x][y]);
                    else *(u32x2_t*)(P.Y0 + (size_t)ch * 4096 + col * 64 + r0) = pack4(d[x][y]); }
        }
    }
    BARRIER();
#undef SL
}

struct R2Ptrs { const bf16* PT; const bf16* RP; const bf16* QM; const bf16* Y0; const float* GC; const bf16* G2; const bf16* BV; const float* lnx_g; const float* lnx_b; bf16* MIX; float* wkv_out; };
__device__ __forceinline__ void r2_seq(Frame& F, const R2Ptrs& P, int bh) {
    const int lane = F.lane, w = F.wave, cl = lane & 15, g = lane >> 4, h = bh & 7, b = bh >> 3, x = w & 3;
    const bool isS = w < 4;
    LAS bf16* Sbf = (LAS bf16*)(F.lds);
    const size_t chb = (size_t)bh * 128;
    if (isS) {
        f32x4 S[4]; bf16x8 ptA[2], ptB[2], ptC[2], ptD[2]; u32x2_t qA[4], qB[4], qC[4], qD[4]; f32x4 gcA, gcB, gcC, gcD;
#define S_LOAD(pt, q, gc, cc_) do { const size_t cn_ = chb + ((cc_) < 128 ? (cc_) : 127); const bf16* pp = P.PT + cn_ * 4096 + (16 * x + cl) * 64 + 8 * g; pt[0] = *(const bf16x8*)pp; pt[1] = *(const bf16x8*)(pp + 32); \
            gc = *(const f32x4*)(P.GC + cn_ * 64 + 16 * x + 4 * g); \
            _Pragma("unroll") for (int it = 0; it < 4; ++it) q[it] = *(const u32x2_t*)(P.QM + cn_ * 4096 + (16 * it + cl) * 64 + 16 * x + 4 * g); } while (0)
#define S_STEP(pt, q, gc, c_) do { const LAS bf16* sr = Sbf + ((c_) & 1) * (64 * RS) + cl * RS + 8 * g; LAS bf16* sw = Sbf + (((c_) + 1) & 1) * (64 * RS) + cl * RS + 16 * x + 4 * g; \
            _Pragma("unroll") for (int it = 0; it < 4; ++it) { const bf16x8 sb0 = *(const LAS bf16x8*)(sr + 16 * it * RS), sb1 = *(const LAS bf16x8*)(sr + 16 * it * RS + 32); \
                f32x4 d = mfma16(pt[0], sb0, (f32x4){0.f, 0.f, 0.f, 0.f}); d = mfma16(pt[1], sb1, d);          \
                f32x4 qf; qf[0] = __builtin_bit_cast(float, q[it].x << 16); qf[1] = __builtin_bit_cast(float, q[it].x & 0xffff0000u); qf[2] = __builtin_bit_cast(float, q[it].y << 16); qf[3] = __builtin_bit_cast(float, q[it].y & 0xffff0000u); \
                S[it] = d + S[it] * gc + qf; *(LAS u32x2_t*)(sw + 16 * it * RS) = pack4(S[it]); } } while (0)
#pragma unroll
        for (int it = 0; it < 4; ++it) { S[it] = (f32x4){0.f, 0.f, 0.f, 0.f}; *(LAS u32x2_t*)(Sbf + (16 * it + cl) * RS + 16 * x + 4 * g) = (u32x2_t){0u, 0u}; }
        S_LOAD(ptA, qA, gcA, 0); S_LOAD(ptB, qB, gcB, 1); S_LOAD(ptC, qC, gcC, 2); S_LOAD(ptD, qD, gcD, 3);
        BARRIER();
#pragma unroll 1
        for (int c = 0; c < 128; c += 4) {
            S_STEP(ptA, qA, gcA, c); S_LOAD(ptA, qA, gcA, c + 4); BARRIER();
            S_STEP(ptB, qB, gcB, c + 1); S_LOAD(ptB, qB, gcB, c + 5); BARRIER();
            S_STEP(ptC, qC, gcC, c + 2); S_LOAD(ptC, qC, gcC, c + 6); BARRIER();
            S_STEP(ptD, qD, gcD, c + 3); S_LOAD(ptD, qD, gcD, c + 7); BARRIER();
        }
#undef S_LOAD
#undef S_STEP
#pragma unroll
        for (int it = 0; it < 4; ++it) *(f32x4*)(P.wkv_out + ((size_t)bh * 64 + 16 * it + cl) * 64 + 16 * x + 4 * g) = S[it];
    } else {
        f32x4 lg[4], lb[4];
#pragma unroll
        for (int it = 0; it < 4; ++it) { lg[it] = *(const f32x4*)(P.lnx_g + h * 64 + 16 * it + 4 * g); lb[it] = *(const f32x4*)(P.lnx_b + h * 64 + 16 * it + 4 * g); }
        bf16x8 rpA[2], rpB[2], rpC[2], rpD[2]; u32x2_t y0A[4], y0B[4], y0C[4], y0D[4]; v4u bgA[4], bgB[4], bgC[4], bgD[4];
        const size_t rowb0 = (size_t)b * SEQ;
#define Y_LOAD(rp, y0, bgw, cc_) do { const int ci_ = ((cc_) < 128 ? (cc_) : 127); const size_t cn_ = chb + ci_; const size_t rown = rowb0 + (size_t)ci_ * 64 + 16 * x + cl; \
            const bf16* rr = P.RP + cn_ * 4096 + (16 * x + cl) * 64 + 8 * g; rp[0] = *(const bf16x8*)rr; rp[1] = *(const bf16x8*)(rr + 32); \
            _Pragma("unroll") for (int it = 0; it < 4; ++it) { y0[it] = *(const u32x2_t*)(P.Y0 + cn_ * 4096 + (16 * x + cl) * 64 + 16 * it + 4 * g); \
                bgw[it] = *(const v4u*)(P.BV + ((rown * 8 + h) * 16 + 4 * it + g) * 8); } } while (0)
#define Y_STEP(rp, y0, bgw, c_) do { const LAS bf16* sr = Sbf + ((c_) & 1) * (64 * RS) + cl * RS + 8 * g; \
            f32x4 Y[4]; float s1 = 0.f, s2 = 0.f; \
            _Pragma("unroll") for (int it = 0; it < 4; ++it) { const bf16x8 sb0 = *(const LAS bf16x8*)(sr + 16 * it * RS), sb1 = *(const LAS bf16x8*)(sr + 16 * it * RS + 32); \
                f32x4 yi; yi[0] = __builtin_bit_cast(float, y0[it].x << 16); yi[1] = __builtin_bit_cast(float, y0[it].x & 0xffff0000u); yi[2] = __builtin_bit_cast(float, y0[it].y << 16); yi[3] = __builtin_bit_cast(float, y0[it].y & 0xffff0000u); \
                f32x4 y = mfma16(sb0, rp[0], yi); y = mfma16(sb1, rp[1], y); Y[it] = y;                 \
                s1 += (y[0] + y[1]) + (y[2] + y[3]); s2 += (y[0] * y[0] + y[1] * y[1]) + (y[2] * y[2] + y[3] * y[3]); } \
            s1 += __shfl_xor(s1, 16); s1 += __shfl_xor(s1, 32); s2 += __shfl_xor(s2, 16); s2 += __shfl_xor(s2, 32); \
            const float mean = s1 * (1.f / 64.f), var = fmaxf(s2 * (1.f / 64.f) - mean * mean, 0.f), rstd = 1.0f / sqrtf(var + GN_EPS); \
            const size_t row = rowb0 + (size_t)(c_) * 64 + 16 * x + cl; \
            _Pragma("unroll") for (int it = 0; it < 4; ++it) { f32x4 bv, g2; \
                bv[0] = __builtin_bit_cast(float, bgw[it].x << 16); bv[1] = __builtin_bit_cast(float, bgw[it].x & 0xffff0000u); bv[2] = __builtin_bit_cast(float, bgw[it].y << 16); bv[3] = __builtin_bit_cast(float, bgw[it].y & 0xffff0000u); \
                g2[0] = __builtin_bit_cast(float, bgw[it].z << 16); g2[1] = __builtin_bit_cast(float, bgw[it].z & 0xffff0000u); g2[2] = __builtin_bit_cast(float, bgw[it].w << 16); g2[3] = __builtin_bit_cast(float, bgw[it].w & 0xffff0000u); \
                const f32x4 o = ((Y[it] - mean) * rstd * lg[it] + lb[it] + bv) * g2; \
                *(u32x2_t*)(P.MIX + row * D + 512 + h * 64 + 16 * it + 4 * g) = pack4(o); } } while (0)
        Y_LOAD(rpA, y0A, bgA, 0); Y_LOAD(rpB, y0B, bgB, 1); Y_LOAD(rpC, y0C, bgC, 2); Y_LOAD(rpD, y0D, bgD, 3);
        BARRIER();
#pragma unroll 1
        for (int c = 0; c < 128; c += 4) {
            Y_STEP(rpA, y0A, bgA, c); Y_LOAD(rpA, y0A, bgA, c + 4); BARRIER();
            Y_STEP(rpB, y0B, bgB, c + 1); Y_LOAD(rpB, y0B, bgB, c + 5); BARRIER();
            Y_STEP(rpC, y0C, bgC, c + 2); Y_LOAD(rpC, y0C, bgC, c + 6); BARRIER();
            Y_STEP(rpD, y0D, bgD, c + 3); Y_LOAD(rpD, y0D, bgD, c + 7); BARRIER();
        }
#undef Y_LOAD
#undef Y_STEP
    }
}

#ifndef DUP0
#define DUP0 1
#endif
#ifndef DUP2
#define DUP2 1
#endif
#ifndef DUP3
#define DUP3 1
#endif
#ifndef DUP4
#define DUP4 1
#endif
__global__ void __launch_bounds__(NTHR, 2) fwd(Args args) {
    extern __shared__ __attribute__((aligned(16))) unsigned char lds[];
    Frame F;
    F.lds = (LAS unsigned char*)lds; F.MISC = (volatile LAS unsigned*)(F.lds + MISC_OFF);
    F.tid = threadIdx.x; F.lane = F.tid & 63; F.wave = __builtin_amdgcn_readfirstlane(F.tid >> 6);
    F.G = gridDim.x; { const int bx = blockIdx.x; F.vcu = (F.G % 8 == 0) ? (bx % 8) * (F.G / 8) + bx / 8 : bx; }
    unsigned char* ws = args.ws; F.ctl = (gu32*)(ws + WS_CTL);
    for (int u = F.tid; u < (LDS_BYTES - LDSCTL_OFF) / 4; u += NTHR) ((LAS unsigned*)(F.lds + LDSCTL_OFF))[u] = 0u;
    __syncthreads();
    const int lo = args.ph_lo, hi = args.ph_hi; const bool multi = (hi - lo) > 1;
    XcdBarrier bar; bar.bar = (unsigned*)(F.ctl + CW_BAR); bar.x = 0; bar.st = nullptr;
    if (multi) bar = xcd_barrier_post((unsigned*)(F.ctl + CW_BAR), F.MISC + 8);
#define IN(k) (lo <= (k) && (k) < hi)
#define SEAM(k) do { if (IN(k) && IN((k) + 1)) xcd_barrier(bar); } while (0)
    bf16* WIN = (bf16*)(ws + WS_WIN); bf16* WO = (bf16*)(ws + WS_WO); bf16* W1 = (bf16*)(ws + WS_W1); bf16* W2 = (bf16*)(ws + WS_W2);
    bf16* XN = (bf16*)(ws + WS_XN); bf16* HB = (bf16*)(ws + WS_HB); bf16* HBF = (bf16*)(ws + WS_HBF); float* SSQ = (float*)(ws + WS_SSQ);
#ifndef SKIP_0
    if (IN(0)) { for (int rep = 0; rep < DUP0; ++rep) { p0_prologue(F, args); __syncthreads(); } SEAM(0); }
#endif
#ifndef SKIP_1
    if (IN(1)) { pg8::Gemm g{XN, WIN, M, NINP, D}; pg8::StaticOrder S; S.init(M, NINP, F.G, (int)blockIdx.x);
        pg8::EpiProj E{(bf16*)(ws + WS_QB), (WS_KB - WS_QB) / 2, (bf16*)(ws + WS_PB), (float*)(ws + WS_QS), args.out, args.in[9], args.in[10], (const float*)(ws + WS_RSTD)};
        pg8::gemm_phase<pg8::EpiProj, pg8::StaticOrder, true, true>(F.lds + RING_OFF, g, S, E); SEAM(1); }
#endif
#ifndef SKIP_2
    if (IN(2)) {
#pragma unroll
      for (int rep = 0; rep < DUP2; ++rep) {
        r1_lin(F, (const bf16*)(ws + WS_PB), args.in[11], (bf16*)(ws + WS_LIN));
        p2_post(F, args);
        if (multi) xcd_barrier(bar);
        { R1Ptrs P; P.LIN = (const bf16*)(ws + WS_LIN); P.PB = (const bf16*)(ws + WS_PB); P.WLt = (const bf16*)(ws + WS_LORA); P.ALt = P.WLt + 512 * 64; P.GLt = P.ALt + 512 * 64;
          P.mu = args.in[11]; P.w0 = args.in[12]; P.a0 = args.in[14]; P.k_k = args.in[17]; P.k_a = args.in[18]; P.r_k = args.in[19];
          P.PT = (bf16*)(ws + WS_PT); P.RP = (bf16*)(ws + WS_RP); P.QM = (bf16*)(ws + WS_QM); P.Y0 = (bf16*)(ws + WS_Y0); P.GC = (float*)(ws + WS_GC); P.G2 = nullptr; P.BV = (bf16*)(ws + WS_G2);
          { const int nper = (BATCH * NH * 128) / F.G; const int it0 = F.vcu * nper; R1W W; r1_load_w(F, P, (it0 >> 7) & 7, W); r1_load_par(F, P, (it0 >> 7) & 7); R1Pre N; r1_prefetch(P, F.tid, F.wave, it0 >> 7, it0 & 127, N);
#pragma unroll 1
          for (int it = it0; it < it0 + nper; ++it) r1_item(F, P, W, N, it >> 7, it & 127, it + 1 < it0 + nper); } }
        __syncthreads(); }
        SEAM(2); }
#endif
#ifndef SKIP_3
    if (IN(3)) {
      for (int rep = 0; rep < DUP3; ++rep) {
        if ((F.vcu & 3) == 0 && (F.vcu >> 2) < BATCH * NH) {
            R2Ptrs P; P.PT = (const bf16*)(ws + WS_PT); P.RP = (const bf16*)(ws + WS_RP); P.QM = (const bf16*)(ws + WS_QM); P.Y0 = (const bf16*)(ws + WS_Y0); P.GC = (const float*)(ws + WS_GC);
            P.G2 = nullptr; P.BV = (const bf16*)(ws + WS_G2); P.lnx_g = args.in[20]; P.lnx_b = args.in[21]; P.MIX = (bf16*)(ws + WS_MIX); P.wkv_out = args.out + O_WKVP;
            r2_seq(F, P, F.vcu >> 2);
        } else { const int q = F.vcu >> 2, r = F.vcu & 3; const int idx = (q < BATCH * NH) ? 3 * q + (r - 1) : F.vcu - BATCH * NH; p4_scan(F, args, idx * NWAVES + F.wave, (F.G - BATCH * NH) * NWAVES); }
        __syncthreads();
        p3_attn(F, args); __syncthreads(); }
      SEAM(3); }
#endif
#ifndef SKIP_5
    if (IN(5)) { pg8::Gemm g{(const bf16*)(ws + WS_MIX), WO, M, D, D}; pg8::StaticOrder S; S.init(M, D, F.G, (int)blockIdx.x);
        pg8::EpiHRes E{XN, args.out + O_YP, HBF, SSQ, MP};
        pg8::gemm_phase<pg8::EpiHRes, pg8::StaticOrder, true, true>(F.lds + RING_OFF, g, S, E); SEAM(5); }
#endif
#ifndef SKIP_6
    if (IN(6)) { pg8::Gemm g{HBF, W1, M, FF, D}; pg8::StaticOrder S; S.init(M, FF, F.G, (int)blockIdx.x);
        pg8::EpiRelu2 E{HB, FF, SSQ};
        pg8::gemm_phase<pg8::EpiRelu2, pg8::StaticOrder, true, true>(F.lds + RING_OFF, g, S, E); SEAM(6); }
#endif
#ifndef SKIP_7
    if (IN(7)) { { pg8::Gemm g{HB, W2, MP, D, FF, 0}; pg8::StaticOrder S; S.init(MP, D, F.G, (int)blockIdx.x);
        pg8::EpiAddH E{args.out + O_YP, HBF, D};
        pg8::gemm_phase<pg8::EpiAddH, pg8::StaticOrder, true, true>(F.lds + RING_OFF, g, S, E); }
        { pg8::Gemm g{HB, W2, M, D, FF / 8, FF}; pg8::SplitKOrder<8, FF> S{F.G, (int)blockIdx.x};
        pg8::EpiAtomicAdd E{args.out + O_YP, D};
        pg8::gemm_phase<pg8::EpiAtomicAdd, pg8::SplitKOrder<8, FF>, true, true>(F.lds + RING_OFF, g, S, E); } }
#endif
#undef IN
#undef SEAM
}

#ifndef N_PHASES_PER_LAUNCH
#define N_PHASES_PER_LAUNCH 8
#endif
extern "C" void kernel_launch(void* const* d_in, const int* in_sizes, int n_in, void* d_out, int out_size, void* d_ws, size_t ws_size, hipStream_t stream) {
    static int grid = 0;
    if (grid == 0) {
        if (n_in != 26 || out_size != (int)O_END || ws_size < WS_END) { fprintf(stderr, "kernel_launch: unexpected shapes n_in %d out %d ws %zu\n", n_in, out_size, ws_size); grid = -1; return; }
        int dev = 0, cus = 0, per_cu = 0;
        if (hipGetDevice(&dev) != hipSuccess || hipDeviceGetAttribute(&cus, hipDeviceAttributeMultiprocessorCount, dev) != hipSuccess) { grid = -1; return; }
        if (hipFuncSetAttribute((const void*)fwd, hipFuncAttributeMaxDynamicSharedMemorySize, LDS_BYTES) != hipSuccess) { fprintf(stderr, "kernel_launch: hipFuncSetAttribute failed\n"); grid = -1; return; }
        if (hipOccupancyMaxActiveBlocksPerMultiprocessor(&per_cu, (const void*)fwd, NTHR, LDS_BYTES) != hipSuccess || per_cu < 1) { fprintf(stderr, "kernel_launch: occupancy query says %d\n", per_cu); }
        (void)hipGetLastError();
        grid = cus;
    }
    if (grid < 0) return;
    if (hipMemsetAsync((char*)d_ws + WS_CTL, 0, CTL_ZERO_BYTES, stream) != hipSuccess) return;
    Args a{};
    for (int i = 0; i < 26; ++i) a.in[i] = (const float*)d_in[i];
    a.out = (float*)d_out; a.ws = (unsigned char*)d_ws;
    constexpr int NPH = 8;
    for (int p = 0; p < NPH; p += N_PHASES_PER_LAUNCH) {
        a.ph_lo = p; a.ph_hi = (p + N_PHASES_PER_LAUNCH < NPH) ? p + N_PHASES_PER_LAUNCH : NPH;
        hipLaunchKernelGGL(fwd, dim3(grid), dim3(NTHR), LDS_BYTES, stream, a);
    }
}
```

```cpp
#include <hip/hip_runtime.h>
#include <cstdio>
#include <cstdint>
#include <cmath>
namespace pg8 {
#define PG8_LAS __attribute__((address_space(3)))
typedef unsigned short bf16_t;
typedef short bf16x8 __attribute__((ext_vector_type(8)));
typedef float f32x4 __attribute__((ext_vector_type(4)));
typedef unsigned u32x4 __attribute__((ext_vector_type(4)));
constexpr int BM = 256, BK = 64, HALF = 128, HTB = HALF * BK * 2  , STAGE_BYTES = 8 * HTB, NXCD = 8, WGM = 8;

__host__ __device__ __forceinline__ int lds_byte(int r, int c) { const int st = (r >> 4) * 2 + (c >> 5), rr = r & 15, cc = c & 31, ob = rr * 64 + cc * 2; return st * 1024 + (ob ^ (((ob >> 9) & 1) << 5)); }
__host__ __device__ __forceinline__ void stage_rc(int b, int& R, int& C) { const int st = b / 1024, sb = b % 1024, swz = sb ^ (((sb >> 9) & 1) << 5); R = (st >> 1) * 16 + swz / 64; C = (st & 1) * 32 + (swz % 64) / 2; }
__host__ __device__ __forceinline__ int perm32(int rho) { const int n = rho >> 4, i = rho & 15; return 8 * (i >> 2) + 4 * n + (i & 3); }

struct Unit { int pm, pn, ko; };
struct Gemm { const bf16_t* A; const bf16_t* Bt; int M, N, K; int ld; };

struct StaticOrder {
    int nM, nN, nwg, G, c;
    __host__ __device__ void init(int M, int N, int G_, int c_) { nM = M / BM; nN = N / BM; nwg = nM * nN; G = G_; c = c_; }
    __host__ __device__ bool next(int i, Unit& u) const {
        const long L = (long)i * G + c; if (L >= nwg) return false;
        int wgid = (int)L; { const int q = nwg / NXCD, r = nwg % NXCD, xcd = wgid % NXCD, off = wgid / NXCD; wgid = (xcd < r ? xcd * (q + 1) : r * (q + 1) + (xcd - r) * q) + off; }
        const int nig = WGM * nN, gid = wgid / nig, fm = gid * WGM, gsz = (nM - fm) < WGM ? (nM - fm) : WGM;
        u.pm = fm + ((wgid % nig) % gsz); u.pn = (wgid % nig) / gsz; u.ko = 0; return true;
    }
    __device__ __forceinline__ void a_ready(const Unit&) const {}
    __device__ __forceinline__ void done(const Unit&) const {}
};

__device__ __forceinline__ unsigned cvt_pk_bf16(float lo, float hi) { unsigned r; asm volatile("v_cvt_pk_bf16_f32 %0, %1, %2" : "=v"(r) : "v"(lo), "v"(hi)); return r; }
typedef float f32x2 __attribute__((ext_vector_type(2)));
struct NoPre {};
struct EpiF32 {
    static constexpr bool PERM = false, AFTER_DRAIN = false;
    float* C; int ldc;
    typedef NoPre Pre; __device__ __forceinline__ void pre(Pre&, const Unit&, int, int, int, int) const {}
    __device__ __forceinline__ void operator()(const f32x4 (&acc)[2][2][4][2], const Unit& u, int wr, int wc, int fr, int fq, const Pre&) const {
        const int row0 = u.pm * BM + wr * 64 + fr, col0 = u.pn * BM + wc * 32 + 4 * fq;
#pragma unroll
        for (int ai = 0; ai < 2; ++ai)
#pragma unroll
            for (int m = 0; m < 4; ++m) { float* rowp = C + (size_t)(row0 + ai * HALF + m * 16) * ldc + col0;
#pragma unroll
                for (int bj = 0; bj < 2; ++bj)
#pragma unroll
                    for (int n = 0; n < 2; ++n) *(f32x4*)(rowp + bj * HALF + n * 16) = acc[ai][bj][m][n]; }
    }
};
struct EpiHRes {
    static constexpr bool PERM = false, AFTER_DRAIN = false;
    const bf16_t* xb; float* out; bf16_t* hb; float* ssq; int mp;
    typedef NoPre Pre; __device__ __forceinline__ void pre(Pre&, const Unit&, int, int, int, int) const {}
    __device__ __forceinline__ void operator()(const f32x4 (&acc)[2][2][4][2], const Unit& u, int wr, int wc, int fr, int fq, const Pre&) const {
        const int row0 = u.pm * BM + wr * 64 + fr, col0 = u.pn * BM + wc * 32 + 4 * fq;
#pragma unroll
        for (int ai = 0; ai < 2; ++ai)
#pragma unroll
            for (int m = 0; m < 4; ++m) {
                const int row = row0 + ai * HALF + m * 16;
                const bf16_t* xrow = xb + (size_t)row * 1024 + col0;
                float* orow = out + (size_t)row * 1024 + col0; bf16_t* hrow = hb + (size_t)row * 1024 + col0;
                float s = 0.f;
#pragma unroll
                for (int bj = 0; bj < 2; ++bj)
#pragma unroll
                    for (int n = 0; n < 2; ++n) {
                        const unsigned long long xw = *(const unsigned long long*)(xrow + bj * HALF + n * 16); const unsigned xlo = (unsigned)xw, xhi = (unsigned)(xw >> 32);
                        f32x4 xv; xv[0] = __builtin_bit_cast(float, xlo << 16); xv[1] = __builtin_bit_cast(float, xlo & 0xffff0000u); xv[2] = __builtin_bit_cast(float, xhi << 16); xv[3] = __builtin_bit_cast(float, xhi & 0xffff0000u);
                        const f32x4 h = acc[ai][bj][m][n] + xv;
                        if (row >= mp) *(f32x4*)(orow + bj * HALF + n * 16) = h;
                        unsigned long long w = (unsigned long long)cvt_pk_bf16(h[0], h[1]) | ((unsigned long long)cvt_pk_bf16(h[2], h[3]) << 32);
                        *(unsigned long long*)(hrow + bj * HALF + n * 16) = w;
                        s += (h[0] * h[0] + h[1] * h[1]) + (h[2] * h[2] + h[3] * h[3]);
                    }
                s += __shfl_xor(s, 16); s += __shfl_xor(s, 32);
                if (fq == 0) atomicAdd(ssq + row, s);
            }
    }
};
struct EpiRelu2 {
    static constexpr bool PERM = true, AFTER_DRAIN = false;
    bf16_t* O; int ldc; const float* ssq;
    struct Pre { float s[8]; };
    __device__ __forceinline__ void pre(Pre& P_, const Unit& u, int wr, int wc, int fr, int fq) const {
        const int row0 = u.pm * BM + wr * 64 + fr;
#pragma unroll
        for (int ai = 0; ai < 2; ++ai)
#pragma unroll
            for (int m = 0; m < 4; ++m) P_.s[ai * 4 + m] = ssq[row0 + ai * HALF + m * 16];
    }
    __device__ __forceinline__ void operator()(const f32x4 (&acc)[2][2][4][2], const Unit& u, int wr, int wc, int fr, int fq, const Pre& P_) const {
        const int row0 = u.pm * BM + wr * 64 + fr, col0 = u.pn * BM + wc * 32 + 8 * fq;
#pragma unroll
        for (int ai = 0; ai < 2; ++ai)
#pragma unroll
            for (int m = 0; m < 4; ++m) {
                const int row = row0 + ai * HALF + m * 16;
                const float rs = __builtin_amdgcn_rsqf(P_.s[ai * 4 + m] * (1.0f / 1024.0f) + 1e-6f);
                bf16_t* rowp = O + (size_t)row * ldc + col0;
#pragma unroll
                for (int bj = 0; bj < 2; ++bj) {
                    f32x4 v0 = acc[ai][bj][m][0] * rs, v1 = acc[ai][bj][m][1] * rs;
#pragma unroll
                    for (int j = 0; j < 4; ++j) { const float a = fmaxf(v0[j], 0.f), b = fmaxf(v1[j], 0.f); v0[j] = a * a; v1[j] = b * b; }
                    u32x4 w; w.x = cvt_pk_bf16(v0[0], v0[1]); w.y = cvt_pk_bf16(v0[2], v0[3]); w.z = cvt_pk_bf16(v1[0], v1[1]); w.w = cvt_pk_bf16(v1[2], v1[3]);
                    *(u32x4*)(rowp + bj * HALF) = w;
                }
            }
    }
};
struct EpiAddOut {
    static constexpr bool PERM = false, AFTER_DRAIN = false;
    float* C; int ldc;
    typedef NoPre Pre; __device__ __forceinline__ void pre(Pre&, const Unit&, int, int, int, int) const {}
    __device__ __forceinline__ void operator()(const f32x4 (&acc)[2][2][4][2], const Unit& u, int wr, int wc, int fr, int fq, const Pre&) const {
        const int row0 = u.pm * BM + wr * 64 + fr, col0 = u.pn * BM + wc * 32 + 4 * fq;
#pragma unroll
        for (int ai = 0; ai < 2; ++ai)
#pragma unroll
            for (int m = 0; m < 4; ++m) { float* rowp = C + (size_t)(row0 + ai * HALF + m * 16) * ldc + col0;
#pragma unroll
                for (int bj = 0; bj < 2; ++bj)
#pragma unroll
                    for (int n = 0; n < 2; ++n) { f32x4* p = (f32x4*)(rowp + bj * HALF + n * 16); *p = *p + acc[ai][bj][m][n]; } }
    }
};
struct EpiProj {
    static constexpr bool PERM = true, AFTER_DRAIN = false;
    bf16_t* QKV; size_t qkv_stride;
    bf16_t* PB;
    float* QS;
    float* out; const float* gq; const float* gk; const float* rstd;
    struct Pre { float s[8]; };
    __device__ __forceinline__ void pre(Pre& P_, const Unit& u, int wr, int wc, int fr, int fq) const {
        const int row0 = u.pm * BM + wr * 64 + fr;
#pragma unroll
        for (int ai = 0; ai < 2; ++ai)
#pragma unroll
            for (int m = 0; m < 4; ++m) P_.s[ai * 4 + m] = rstd[row0 + ai * HALF + m * 16];
    }
    __device__ __forceinline__ void operator()(const f32x4 (&acc)[2][2][4][2], const Unit& u, int wr, int wc, int fr, int fq, const Pre& P_) const {
        const int pn = u.pn, pm = u.pm;
        if (pn < 6) {
            const int region = pn >> 1, h = (pn & 1) * 4 + wc;
            f32x4 gv[2][2];
#pragma unroll
            for (int bj = 0; bj < 2; ++bj)
#pragma unroll
                for (int n = 0; n < 2; ++n) gv[bj][n] = (region == 2) ? (f32x4){1.f, 1.f, 1.f, 1.f} : *(const f32x4*)((region == 0 ? gq : gk) + 32 * bj + 8 * fq + 4 * n);
#pragma unroll
            for (int ai = 0; ai < 2; ++ai)
#pragma unroll
                for (int m = 0; m < 4; ++m) {
                    const int row = pm * BM + ai * HALF + wr * 64 + m * 16 + fr;
                    f32x4 v[2][2]; const float rs1 = P_.s[ai * 4 + m];
#pragma unroll
                    for (int bj = 0; bj < 2; ++bj)
#pragma unroll
                        for (int n = 0; n < 2; ++n) v[bj][n] = acc[ai][bj][m][n] * rs1;
                    if (region < 2) {
                        float ss = 0.f;
#pragma unroll
                        for (int bj = 0; bj < 2; ++bj)
#pragma unroll
                            for (int n = 0; n < 2; ++n) ss += (v[bj][n][0] * v[bj][n][0] + v[bj][n][1] * v[bj][n][1]) + (v[bj][n][2] * v[bj][n][2] + v[bj][n][3] * v[bj][n][3]);
                        ss += __shfl_xor(ss, 16); ss += __shfl_xor(ss, 32);
                        const float rs = 1.0f / sqrtf(ss * (1.0f / 64.0f) + 1e-6f);
#pragma unroll
                        for (int bj = 0; bj < 2; ++bj)
#pragma unroll
                            for (int n = 0; n < 2; ++n) v[bj][n] = v[bj][n] * rs * gv[bj][n];
                    }
                    if (pm < 256) {
                        const int b = row >> 13, t = row & 8191;
                        bf16_t* dst = QKV + (size_t)region * qkv_stride + ((size_t)(b * 8 + h) * 8192 + t) * 64 + 8 * fq;
                        const float sc = (region == 0) ? 0.18033688011112042f : 1.0f;
#pragma unroll
                        for (int bj = 0; bj < 2; ++bj) { const f32x4 a = v[bj][0] * sc, c = v[bj][1] * sc;
                            u32x4 w; w.x = cvt_pk_bf16(a[0], a[1]); w.y = cvt_pk_bf16(a[2], a[3]); w.z = cvt_pk_bf16(c[0], c[1]); w.w = cvt_pk_bf16(c[2], c[3]);
                            *(u32x4*)(dst + 32 * bj) = w; }
                        if (region > 0 && t >= 6144) {
                            float* od = out + (region == 1 ? (size_t)68157440 : (size_t)76546048) + ((size_t)(b * 2048 + (t - 6144)) * 8 + h) * 64 + 8 * fq;
#pragma unroll
                            for (int bj = 0; bj < 2; ++bj) { *(f32x4*)(od + 32 * bj) = v[bj][0]; *(f32x4*)(od + 32 * bj + 4) = v[bj][1]; }
                        }
                    } else {
                        const int rs_ = row - 65536;
                        float* od = (region == 0) ? QS + (size_t)rs_ * 512 + h * 64 + 8 * fq : out + (region == 1 ? (size_t)85211392 : (size_t)85735680) + ((size_t)rs_ * 8 + h) * 64 + 8 * fq;
#pragma unroll
                        for (int bj = 0; bj < 2; ++bj) { *(f32x4*)(od + 32 * bj) = v[bj][0]; *(f32x4*)(od + 32 * bj + 4) = v[bj][1]; }
                    }
                }
        } else {
            const int col0 = (pn - 6) * 256 + wc * 32 + 8 * fq;
#pragma unroll
            for (int ai = 0; ai < 2; ++ai)
#pragma unroll
                for (int m = 0; m < 4; ++m) {
                    const int row = pm * BM + ai * HALF + wr * 64 + m * 16 + fr;
                    bf16_t* dst = PB + (size_t)row * 2048 + col0;
                    float* sd = nullptr;
                    if (pm < 256) { if ((row & 8191) == 8191) sd = out + (size_t)85196800 + (size_t)(row >> 13) * 1824; }
                    else { const int rs_ = row - 65536; if ((rs_ & 7) == 7) sd = out + (size_t)90454272 + (size_t)(rs_ >> 3) * 1824; }
                    const float rs1 = P_.s[ai * 4 + m];
#pragma unroll
                    for (int bj = 0; bj < 2; ++bj) { const f32x4 a = acc[ai][bj][m][0] * rs1, c = acc[ai][bj][m][1] * rs1;
                        u32x4 w; w.x = cvt_pk_bf16(a[0], a[1]); w.y = cvt_pk_bf16(a[2], a[3]); w.z = cvt_pk_bf16(c[0], c[1]); w.w = cvt_pk_bf16(c[2], c[3]);
                        const int cc = col0 + 128 * bj;
                        if (cc < 1824) *(u32x4*)(dst + 128 * bj) = w;
                        if (sd && cc < 1824) { *(f32x4*)(sd + cc) = a; *(f32x4*)(sd + cc + 4) = c; } }
                }
        }
    }
};

struct EpiAddH {
    static constexpr bool PERM = false, AFTER_DRAIN = false;
    float* C; const bf16_t* hb; int ldc;
    typedef NoPre Pre; __device__ __forceinline__ void pre(Pre&, const Unit&, int, int, int, int) const {}
    __device__ __forceinline__ void operator()(const f32x4 (&acc)[2][2][4][2], const Unit& u, int wr, int wc, int fr, int fq, const Pre&) const {
        const int row0 = u.pm * BM + wr * 64 + fr, col0 = u.pn * BM + wc * 32 + 4 * fq;
#pragma unroll
        for (int ai = 0; ai < 2; ++ai)
#pragma unroll
            for (int m = 0; m < 4; ++m) { const size_t ro = (size_t)(row0 + ai * HALF + m * 16) * ldc + col0;
#pragma unroll
                for (int bj = 0; bj < 2; ++bj)
#pragma unroll
                    for (int n = 0; n < 2; ++n) { const unsigned long long hw = *(const unsigned long long*)(hb + ro + bj * HALF + n * 16); const unsigned lo = (unsigned)hw, hi = (unsigned)(hw >> 32);
                        f32x4 h; h[0] = __builtin_bit_cast(float, lo << 16); h[1] = __builtin_bit_cast(float, lo & 0xffff0000u); h[2] = __builtin_bit_cast(float, hi << 16); h[3] = __builtin_bit_cast(float, hi & 0xffff0000u);
                        *(f32x4*)(C + ro + bj * HALF + n * 16) = h + acc[ai][bj][m][n]; } }
    }
};
template <int SPLIT, int KFULL> struct SplitKOrder {
    int G, c;
    __host__ __device__ bool next(int i, Unit& u) const { const int L = i * G + c; if (L >= 16 * SPLIT) return false; const int ks = L % SPLIT, tile = L / SPLIT; u.pm = 256 + (tile >> 2); u.pn = tile & 3; u.ko = ks * (KFULL / SPLIT); return true; }
    __device__ __forceinline__ void a_ready(const Unit&) const {}
    __device__ __forceinline__ void done(const Unit&) const {}
};
struct EpiAtomicAdd {
    static constexpr bool PERM = false, AFTER_DRAIN = false;
    float* C; int ldc;
    typedef NoPre Pre; __device__ __forceinline__ void pre(Pre&, const Unit&, int, int, int, int) const {}
    __device__ __forceinline__ void operator()(const f32x4 (&acc)[2][2][4][2], const Unit& u, int wr, int wc, int fr, int fq, const Pre&) const {
        const int row0 = u.pm * BM + wr * 64 + fr, col0 = u.pn * BM + wc * 32 + 4 * fq;
#pragma unroll
        for (int ai = 0; ai < 2; ++ai)
#pragma unroll
            for (int m = 0; m < 4; ++m) { float* rowp = C + (size_t)(row0 + ai * HALF + m * 16) * ldc + col0;
#pragma unroll
                for (int bj = 0; bj < 2; ++bj)
#pragma unroll
                    for (int n = 0; n < 2; ++n) { float* p = rowp + bj * HALF + n * 16;
#pragma unroll
                        for (int j = 0; j < 4; ++j) unsafeAtomicAdd(p + j, acc[ai][bj][m][n][j]); } }
    }
};

template <class Epi, class Sched, bool ALIGN_EPI = false, bool SP2 = false>
__device__ __forceinline__ void gemm_phase(PG8_LAS unsigned char* lds, const Gemm g, const Sched& S, const Epi& E) {
    const int tid = threadIdx.x, wid = __builtin_amdgcn_readfirstlane(tid >> 6), lane = tid & 63, wr = wid >> 2, wc = wid & 3, fr = lane & 15, fq = lane >> 4;
    const int K = g.K, nt = K / BK, LD = g.ld ? g.ld : g.K;
    unsigned voffA[2], voffB[2];
#pragma unroll
    for (int i = 0; i < 2; ++i) { int R, C; stage_rc(tid * 16 + i * 8192, R, C); const int Rb = Epi::PERM ? ((R & ~31) + perm32(R & 31)) : R;
        voffA[i] = (unsigned)(R * LD + C) * 2u; voffB[i] = (unsigned)(Rb * LD + C) * 2u; }
    const size_t kstep = (size_t)(BK * 2);
    const size_t hstep = (size_t)HALF * LD * 2;
    const size_t tstep = 2 * hstep;
    const unsigned ldsw = (unsigned)wid * 1024u;
    const int aoff = lds_byte(wr * 64 + fr, fq * 8), boff = lds_byte(wc * 32 + fr, fq * 8);
#define PG8_SA(b, h) (((b) * 2 + (h)) * HTB)
#define PG8_SB(b, h) ((4 + (b) * 2 + (h)) * HTB)
#define PG8_STAGE(bufoff, gbase, voff) do { _Pragma("unroll") for (int _i = 0; _i < 2; ++_i) \
        __builtin_amdgcn_global_load_lds((const unsigned*)((const char*)(gbase) + (voff)[_i]), (PG8_LAS unsigned*)(lds + (bufoff) + ldsw + _i * 8192), 16, 0, 0); } while (0)
#define PG8_LDA(dst, b, h) do { _Pragma("unroll") for (int m = 0; m < 4; ++m) _Pragma("unroll") for (int k = 0; k < 2; ++k) dst[m][k] = *(const PG8_LAS bf16x8*)(lds + PG8_SA(b, h) + aoff + m * 2048 + k * 1024); } while (0)
#define PG8_LDB(dst, b, h) do { _Pragma("unroll") for (int n = 0; n < 2; ++n) _Pragma("unroll") for (int k = 0; k < 2; ++k) dst[n][k] = *(const PG8_LAS bf16x8*)(lds + PG8_SB(b, h) + boff + n * 2048 + k * 1024); } while (0)
#define PG8_MMA(ai, bj, At, Bt) do { __builtin_amdgcn_s_setprio(1); _Pragma("unroll") for (int m = 0; m < 4; ++m) _Pragma("unroll") for (int n = 0; n < 2; ++n) _Pragma("unroll") for (int k = 0; k < 2; ++k) \
        acc[ai][bj][m][n] = __builtin_amdgcn_mfma_f32_16x16x32_bf16(Bt[n][k], At[m][k], acc[ai][bj][m][n], 0, 0, 0); __builtin_amdgcn_s_setprio(0); } while (0)
#define PG8_WAIT_V(n) asm volatile("s_waitcnt vmcnt(" #n ")" ::: "memory")
#define PG8_WAIT_L(n) asm volatile("s_waitcnt lgkmcnt(" #n ")" ::: "memory")
#define PG8_BAR __builtin_amdgcn_s_barrier()
#define PG8_SCHED __builtin_amdgcn_sched_barrier(0)
    Unit cur, nxt; int ui = 0;
    if (!S.next(0, cur)) return;
    f32x4 acc[2][2][4][2];
    typename Epi::Pre epre;
#pragma unroll
    for (int a = 0; a < 2; ++a)
#pragma unroll
        for (int b = 0; b < 2; ++b)
#pragma unroll
            for (int m = 0; m < 4; ++m)
#pragma unroll
                for (int n = 0; n < 2; ++n) acc[a][b][m][n] = (f32x4){0.f, 0.f, 0.f, 0.f};
    bf16x8 At[4][2], B0[2][2], B1[2][2];
    const char* cA = (const char*)g.A + (size_t)cur.pm * tstep + (size_t)cur.ko * 2; const char* cB = (const char*)g.Bt + (size_t)cur.pn * tstep + (size_t)cur.ko * 2;
    S.a_ready(cur);
    if constexpr (SP2) {
        PG8_STAGE(PG8_SB(0, 0), cB, voffB); PG8_STAGE(PG8_SB(0, 1), cB + hstep, voffB); PG8_STAGE(PG8_SA(0, 0), cA, voffA); PG8_STAGE(PG8_SA(0, 1), cA + hstep, voffA);
        if (wr == 1) PG8_BAR;
        PG8_WAIT_V(2); PG8_BAR;
        PG8_STAGE(PG8_SB(1, 0), cB + kstep, voffB); PG8_STAGE(PG8_SA(1, 0), cA + kstep, voffA); PG8_STAGE(PG8_SB(1, 1), cB + hstep + kstep, voffB);
        PG8_WAIT_V(6); PG8_BAR;
    } else {
        PG8_STAGE(PG8_SB(0, 0), cB, voffB); PG8_STAGE(PG8_SA(0, 0), cA, voffA); PG8_STAGE(PG8_SB(0, 1), cB + hstep, voffB); PG8_STAGE(PG8_SA(0, 1), cA + hstep, voffA);
        if (wr == 1) PG8_BAR;
        PG8_WAIT_V(4); PG8_BAR;
        PG8_STAGE(PG8_SB(1, 0), cB + kstep, voffB); PG8_STAGE(PG8_SA(1, 0), cA + kstep, voffA); PG8_STAGE(PG8_SB(1, 1), cB + hstep + kstep, voffB);
        PG8_WAIT_V(6); PG8_BAR;
    }
    for (;;) {
        const bool has_next = S.next(ui + 1, nxt);
        const char* nA = has_next ? (const char*)g.A + (size_t)nxt.pm * tstep + (size_t)nxt.ko * 2 : cA; const char* nB = has_next ? (const char*)g.Bt + (size_t)nxt.pn * tstep + (size_t)nxt.ko * 2 : cB;
        for (int t = 0; t < nt; t += 2) {
            const bool last = (t == nt - 2);
            const char* a1 = cA + (size_t)(t + 1) * kstep;
            const char* a2 = last ? nA : cA + (size_t)(t + 2) * kstep; const char* b2 = last ? nB : cB + (size_t)(t + 2) * kstep;
            const char* a3 = a2 + kstep; const char* b3 = b2 + kstep;
            if (last && has_next) S.a_ready(nxt);
            if (last) E.pre(epre, cur, wr, wc, fr, fq);
            if constexpr (SP2) {
            PG8_LDB(B0, 0, 0); PG8_LDB(B1, 0, 1); PG8_SCHED; PG8_LDA(At, 0, 0); PG8_STAGE(PG8_SA(1, 1), a1 + hstep, voffA);
            PG8_WAIT_V(8); PG8_WAIT_L(0); PG8_BAR; PG8_MMA(0, 0, At, B0); PG8_MMA(0, 1, At, B1); PG8_BAR; PG8_SCHED;
            PG8_LDA(At, 0, 1); PG8_STAGE(PG8_SB(0, 0), b2, voffB); PG8_STAGE(PG8_SB(0, 1), b2 + hstep, voffB); PG8_STAGE(PG8_SA(0, 0), a2, voffA);
            PG8_WAIT_V(8); PG8_WAIT_L(0); PG8_BAR; PG8_MMA(1, 0, At, B0); PG8_MMA(1, 1, At, B1); PG8_BAR; PG8_SCHED;
            PG8_LDB(B0, 1, 0); PG8_LDB(B1, 1, 1); PG8_SCHED; PG8_LDA(At, 1, 0); PG8_STAGE(PG8_SA(0, 1), a2 + hstep, voffA);
            PG8_WAIT_V(8); PG8_WAIT_L(0); PG8_BAR; PG8_MMA(0, 0, At, B0); PG8_MMA(0, 1, At, B1); PG8_BAR; PG8_SCHED;
            PG8_LDA(At, 1, 1); PG8_STAGE(PG8_SB(1, 0), b3, voffB); PG8_STAGE(PG8_SB(1, 1), b3 + hstep, voffB); PG8_STAGE(PG8_SA(1, 0), a3, voffA);
            PG8_WAIT_V(8); PG8_WAIT_L(0); PG8_BAR; PG8_MMA(1, 0, At, B0); PG8_MMA(1, 1, At, B1); PG8_BAR; PG8_SCHED;
            } else {
            PG8_LDB(B0, 0, 0); PG8_SCHED; PG8_LDA(At, 0, 0); PG8_STAGE(PG8_SA(1, 1), a1 + hstep, voffA);
            PG8_WAIT_L(8); PG8_BAR; PG8_WAIT_L(0); PG8_MMA(0, 0, At, B0); PG8_BAR; PG8_SCHED;
            PG8_LDB(B1, 0, 1); PG8_STAGE(PG8_SB(0, 0), b2, voffB);
            PG8_BAR; PG8_WAIT_L(0); PG8_MMA(0, 1, At, B1); PG8_BAR;
            PG8_LDA(At, 0, 1); PG8_STAGE(PG8_SA(0, 0), a2, voffA);
            PG8_BAR; PG8_WAIT_L(0); PG8_MMA(1, 0, At, B0); PG8_BAR; PG8_SCHED;
            PG8_STAGE(PG8_SB(0, 1), b2 + hstep, voffB);
            PG8_WAIT_V(6); PG8_BAR; PG8_MMA(1, 1, At, B1); PG8_BAR;
            PG8_LDB(B0, 1, 0); PG8_SCHED; PG8_LDA(At, 1, 0); PG8_STAGE(PG8_SA(0, 1), a2 + hstep, voffA);
            PG8_WAIT_L(8); PG8_BAR; PG8_WAIT_L(0); PG8_MMA(0, 0, At, B0); PG8_BAR; PG8_SCHED;
            PG8_LDB(B1, 1, 1); PG8_STAGE(PG8_SB(1, 0), b3, voffB);
            PG8_BAR; PG8_WAIT_L(0); PG8_MMA(0, 1, At, B1); PG8_BAR;
            PG8_LDA(At, 1, 1); PG8_STAGE(PG8_SA(1, 0), a3, voffA);
            PG8_BAR; PG8_WAIT_L(0); PG8_MMA(1, 0, At, B0); PG8_BAR; PG8_SCHED;
            PG8_STAGE(PG8_SB(1, 1), b3 + hstep, voffB);
            PG8_WAIT_V(6); PG8_BAR; PG8_MMA(1, 1, At, B1); PG8_BAR;
            }
        }
        if constexpr (ALIGN_EPI) { if (wr == 0) PG8_BAR; }
        if constexpr (!Epi::AFTER_DRAIN) { E(acc, cur, wr, wc, fr, fq, epre); S.done(cur); }
        if (!has_next) break;
#pragma unroll
        for (int a = 0; a < 2; ++a)
#pragma unroll
            for (int b = 0; b < 2; ++b)
#pragma unroll
                for (int m = 0; m < 4; ++m)
#pragma unroll
                    for (int n = 0; n < 2; ++n) acc[a][b][m][n] = (f32x4){0.f, 0.f, 0.f, 0.f};
        cur = nxt; cA = nA; cB = nB; ++ui;
        if constexpr (ALIGN_EPI) { if (wr == 1) PG8_BAR; }
    }
    PG8_WAIT_V(0);
    if constexpr (!ALIGN_EPI) { if (wr == 0) PG8_BAR; }
    PG8_BAR;
    if constexpr (Epi::AFTER_DRAIN) { E.fused(acc, cur, wr, wc, fr, fq, lds, wid, lane); S.done(cur); }
#undef PG8_SA
#undef PG8_SB
#undef PG8_STAGE
#undef PG8_LDA
#undef PG8_LDB
#undef PG8_MMA
#undef PG8_WAIT_V
#undef PG8_WAIT_L
#undef PG8_BAR
#undef PG8_SCHED
}
}
#define GAS __attribute__((address_space(1)))
#define LAS __attribute__((address_space(3)))
typedef unsigned short bf16;
typedef unsigned v4u __attribute__((ext_vector_type(4)));
typedef float f32x4 __attribute__((ext_vector_type(4)));
typedef short bf16x8 __attribute__((ext_vector_type(8)));
typedef GAS unsigned gu32;
typedef GAS unsigned long long gu64;
#define RLX_AGENT __ATOMIC_RELAXED, __HIP_MEMORY_SCOPE_AGENT
#define LDS_WAIT() asm volatile("s_waitcnt lgkmcnt(0)" ::: "memory")
#define VM_WAIT() asm volatile("s_waitcnt vmcnt(0)" ::: "memory")
__device__ __forceinline__ unsigned long long rt() { return __builtin_amdgcn_s_memrealtime(); }
__device__ __forceinline__ unsigned f2bf(float f) { unsigned u = __builtin_bit_cast(unsigned, f); return (u + 0x7fffu + ((u >> 16) & 1u)) >> 16; }
__device__ __forceinline__ unsigned pk2(float lo, float hi) { return f2bf(lo) | (f2bf(hi) << 16); }

#define XB_TMO      128
#define XB_XCNT(j)  (256  + 64 * (j))
#define XB_XSUB(j)  (1280 + 64 * (j))
#define XB_XGEN(j)  (2304 + 64 * (j))
#define XB_TOP      3328
#define XB_TOPGEN   3392
#define XCD_BAR_WORDS 3456
#define XB_SPIN_CAP (1u << 18)

__device__ __forceinline__ unsigned xb_ld(unsigned* p)              { return __hip_atomic_load(p, __ATOMIC_RELAXED, __HIP_MEMORY_SCOPE_AGENT); }
__device__ __forceinline__ unsigned xb_add(unsigned* p, unsigned v) { return __hip_atomic_fetch_add(p, v, __ATOMIC_RELAXED, __HIP_MEMORY_SCOPE_AGENT); }
__device__ __forceinline__ unsigned xb_xcc_id() { return (unsigned)__builtin_amdgcn_s_getreg((3 << 11) | 20) & 0xFu; }
#define XB_SPIN(cond, bar) do { unsigned _sp = 0; while (cond) { __builtin_amdgcn_s_sleep(1); \
    if ((++_sp & 255u) == 0u) { if (xb_ld(&(bar)[XB_TMO])) break; if (_sp > XB_SPIN_CAP) { atomicAdd(&(bar)[XB_TMO], 1u); break; } } } } while (0)

struct XcdBarrier {
    unsigned* bar; unsigned x;
    volatile LAS unsigned* st;
};

__device__ __forceinline__ XcdBarrier xcd_barrier_post(unsigned* bar, volatile LAS unsigned* st) {
    XcdBarrier b; b.bar = bar; b.x = xb_xcc_id(); b.st = st;
    if (threadIdx.x == 0) (void)xb_add(&bar[XB_XCNT(b.x)], 1u);
    return b;
}
__device__ __forceinline__ void xcd_barrier_complete(unsigned* bar, unsigned x, unsigned& nloc, unsigned& nx) {
    const unsigned G = gridDim.x * gridDim.y * gridDim.z;
    unsigned sum, cnt, mine, sp = 0u;
    for (;;) {
        sum = 0u; cnt = 0u; mine = 0u;
#pragma unroll
        for (unsigned j = 0; j < 16; ++j) { const unsigned c = xb_ld(&bar[XB_XCNT(j)]); sum += c; cnt += (c > 0u) ? 1u : 0u; mine = (j == x) ? c : mine; }
        if (sum == G) break;
        __builtin_amdgcn_s_sleep(1);
        if ((++sp & 255u) == 0u) { if (xb_ld(&bar[XB_TMO])) break; if (sp > XB_SPIN_CAP) { atomicAdd(&bar[XB_TMO], 1u); break; } }
    }
    nloc = mine > 0u ? mine : 1u; nx = cnt > 0u ? cnt : 1u;
}

__device__ __forceinline__ void xcd_barrier(const XcdBarrier& b) {
    asm volatile("s_waitcnt vmcnt(0)" ::: "memory");
    __syncthreads();
    if (threadIdx.x == 0) {
        unsigned* bar = b.bar;
        __builtin_amdgcn_s_waitcnt(0);
        unsigned nloc = b.st[0], nx = b.st[1];
        if (nloc == 0u) { xcd_barrier_complete(bar, b.x, nloc, nx); b.st[0] = nloc; b.st[1] = nx; }
        const unsigned old = xb_add(&bar[XB_XSUB(b.x)], 1u);
        const unsigned gen = old / nloc;
        if (old + 1u == (gen + 1u) * nloc) {
            __builtin_amdgcn_fence(__ATOMIC_RELEASE, "agent");
            asm volatile("s_waitcnt vmcnt(0)" ::: "memory");
            const unsigned og = xb_add(&bar[XB_TOP], 1u);
            const unsigned tg = og / nx;
            if (og + 1u == (tg + 1u) * nx) xb_add(&bar[XB_TOPGEN], 1u);
            else XB_SPIN(xb_ld(&bar[XB_TOPGEN]) == tg, bar);
            __builtin_amdgcn_fence(__ATOMIC_ACQUIRE, "agent");
            xb_add(&bar[XB_XGEN(b.x)], 1u);
            asm volatile("s_waitcnt vmcnt(0)" ::: "memory");
        } else {
            XB_SPIN(xb_ld(&bar[XB_XGEN(b.x)]) == gen, bar);
            __builtin_amdgcn_fence(__ATOMIC_ACQUIRE, "agent");
            asm volatile("s_waitcnt vmcnt(0)" ::: "memory");
        }
    }
    __syncthreads();
}
constexpr int NWAVES = 8, NTHR = 512;
constexpr int D = 1024, BATCH = 8, SEQ = 8192, MP = BATCH * SEQ, SBATCH = 128, STOK = 8, MS = SBATCH * STOK, M = MP + MS;
constexpr int AW = 512, HD = 64, NH = 8, NSHIFT = 1824, NIN = 3360, NINP = 3584, FF = 4096, LWIN = 2048;
constexpr int C_Q = 0, C_K = 512, C_V = 1024, C_P = 1536;
constexpr float RMS_EPS = 1e-6f, GN_EPS = 64e-5f;
constexpr size_t O_YP = 0, O_YS = 67108864, O_KWP = 68157440, O_VWP = 76546048, O_WKVP = 84934656, O_SHP = 85196800, O_KNS = 85211392, O_VNS = 85735680, O_WKVS = 86259968, O_SHS = 90454272, O_END = 90687744;
constexpr size_t MiB = 1u << 20;
constexpr size_t WS_CTL = 0, CTL_ZERO_BYTES = 1 * MiB;
constexpr size_t WS_SSQ = 256 * 1024;
constexpr size_t WS_WIN = 2 * MiB, WS_WO = 10 * MiB, WS_W1 = 12 * MiB, WS_W2 = 20 * MiB, WS_QS = 28 * MiB;
constexpr size_t WS_XN = 32 * MiB;
constexpr size_t WS_MIX = 1200 * MiB;
constexpr size_t WS_RSTD = 576 * 1024;
constexpr size_t WS_QB = 162 * MiB, WS_KB = 226 * MiB, WS_VB = 290 * MiB;
constexpr size_t WS_PB = 354 * MiB;
constexpr size_t WS_LORA = 30 * MiB;
constexpr size_t WS_RW = 614 * MiB;
constexpr size_t RW_STRIDE = 2 * MiB;
constexpr size_t WS_LIN = 1156 * MiB;
constexpr size_t WS_PT = 640 * MiB, WS_RP = 704 * MiB, WS_QM = 768 * MiB, WS_Y0 = 896 * MiB, WS_GC = 1024 * MiB, WS_G2 = 1028 * MiB, WS_BV = 1092 * MiB;
constexpr size_t WS_HBF = 1524 * MiB;
constexpr size_t WS_HB = 162 * MiB;
constexpr size_t WS_END = 1654 * MiB;
static_assert(WS_SSQ + (size_t)M * 4 <= WS_RSTD && WS_RSTD + (size_t)M * 4 <= CTL_ZERO_BYTES && WS_LIN + (size_t)MP * 288 * 2 <= WS_MIX && WS_MIX + (size_t)M * 1024 * 2 <= WS_HBF && WS_XN + (size_t)M * 1024 * 2 <= WS_QB && WS_PB + (size_t)M * 2048 * 2 <= WS_RW && (size_t)MS * 512 * 4 <= RW_STRIDE && WS_RW + 7 * RW_STRIDE <= WS_PT && WS_LIN + (size_t)MP * 288 * 2 <= WS_HBF && WS_HB + (size_t)M * FF * 2 <= WS_HBF && WS_END <= 2048 * MiB, "ws map");
constexpr int CW_TMO = 0, CW_BAR = 4096;
constexpr int RING_OFF = 0, RING_BYTES = 131072, LDSCTL_OFF = RING_BYTES, MISC_OFF = LDSCTL_OFF + 320, LDS_BYTES = 147456;

struct Args { const float* in[26]; float* out; unsigned char* ws; int ph_lo, ph_hi, pad0, pad1; };

struct Frame {
    LAS unsigned char* lds; volatile LAS unsigned* MISC; gu32* ctl;
    int tid, lane, wave, vcu, G;
};
__device__ __forceinline__ float wave_sum(float v) {
#pragma unroll
    for (int o = 1; o < 64; o <<= 1) v += __shfl_xor(v, o);
    return v;
}
typedef float f32x2_c __attribute__((ext_vector_type(2))); typedef __bf16 bf16x2_c __attribute__((ext_vector_type(2)));
__device__ __forceinline__ unsigned cvt2(float lo, float hi) { const f32x2_c v = {lo, hi}; const bf16x2_c b = __builtin_convertvector(v, bf16x2_c); return __builtin_bit_cast(unsigned, b); }
__device__ __forceinline__ float wave_max(float v) {
#pragma unroll
    for (int o = 1; o < 64; o <<= 1) v = fmaxf(v, __shfl_xor(v, o));
    return v;
}
__device__ __forceinline__ void p0_transpose_blk(const float* W, int K, int N, bf16* WT, const float* ks, LAS float* scr, int k0, int n0, int d0, int lane) {
#pragma unroll 8
    for (int i = 0; i < 32; ++i) { const int kk = 2 * i + (lane >> 5); float w = W[(size_t)(k0 + kk) * N + n0 + (lane & 31)]; if (ks) w *= ks[k0 + kk]; scr[kk * 33 + (lane & 31)] = w; }
    LDS_WAIT(); asm volatile("" ::: "memory");
    const int c = lane & 7;
#pragma unroll
    for (int j = 0; j < 4; ++j) { const int n = (lane >> 3) + 8 * j; const LAS float* s = scr + (8 * c) * 33 + n;
        v4u o; o.x = pk2(s[0 * 33], s[1 * 33]); o.y = pk2(s[2 * 33], s[3 * 33]); o.z = pk2(s[4 * 33], s[5 * 33]); o.w = pk2(s[6 * 33], s[7 * 33]);
        *(GAS v4u*)(WT + (size_t)(d0 + n) * K + k0 + 8 * c) = o; }
    LDS_WAIT(); asm volatile("" ::: "memory");
}
__device__ __forceinline__ void p0_transpose_item(const float* W, int K, int N, bf16* WT, const float* ks, LAS float* scr, int item, int lane) {
    const int nblk = N / 32, kb = item / nblk, nb = item % nblk;
    p0_transpose_blk(W, K, N, WT, ks, scr, 64 * kb, 32 * nb, 32 * nb, lane);
}

__device__ __forceinline__ void p0_prologue(Frame& F, const Args& A) {
    unsigned char* ws = A.ws;
    bf16* WIN = (bf16*)(ws + WS_WIN); bf16* WO = (bf16*)(ws + WS_WO); bf16* W1 = (bf16*)(ws + WS_W1); bf16* W2 = (bf16*)(ws + WS_W2); bf16* XN = (bf16*)(ws + WS_XN);
    LAS float* scr = (LAS float*)(F.lds + RING_OFF + F.wave * 16384);
    const int gw = F.vcu * NWAVES + F.wave, NGW = F.G * NWAVES;
    constexpr int I_IN = (D / 64) * (NINP / 32), I_O = (D / 64) * (D / 32), I_1 = (D / 64) * (FF / 32), I_2 = (FF / 64) * (D / 32);
    constexpr int NITEMS = I_IN + I_O + I_1 + I_2;
    for (int it = gw; it < NITEMS; it += NGW) {
        int r = it;
        if (r < I_IN) { const int kb = r / (NINP / 32), gi = r % (NINP / 32), pn = gi >> 3, gl = gi & 7; int src;
            if (pn < 6) src = (pn >> 1) * 512 + ((pn & 1) * 4 + (gl & 3)) * 64 + 32 * (gl >> 2); else src = 1536 + (pn - 6) * 256 + gl * 32;
            if (src < NIN) p0_transpose_blk(A.in[8], D, NIN, WIN, A.in[7], scr, 64 * kb, src, 32 * gi, F.lane);
            else { GAS v4u* z = (GAS v4u*)(WIN + (size_t)(32 * gi) * D + 64 * kb);
                for (int i = F.lane; i < 32 * 8; i += 64) z[(size_t)(i >> 3) * (D * 2 / 16) + (i & 7)] = (v4u){0u, 0u, 0u, 0u}; }
            continue; } r -= I_IN;
        if (r < I_O) { p0_transpose_item(A.in[22], D, D, WO, nullptr, scr, r, F.lane); continue; } r -= I_O;
        if (r < I_1) { p0_transpose_item(A.in[24], D, FF, W1, A.in[23], scr, r, F.lane); continue; } r -= I_1;
        p0_transpose_item(A.in[25], FF, D, W2, nullptr, scr, r, F.lane);
    }
    { bf16* WLt = (bf16*)(ws + WS_LORA); bf16* ALt = WLt + 512 * 64; bf16* GLt = ALt + 512 * 64;
      for (int i = F.vcu * NTHR + F.tid; i < 512 * 288; i += F.G * NTHR) { const int c = i / 288, m = i % 288;
          if (m < 64) WLt[c * 64 + m] = (bf16)f2bf(A.in[13][m * 512 + c]); else if (m < 128) ALt[c * 64 + (m - 64)] = (bf16)f2bf(A.in[15][(m - 64) * 512 + c]); else GLt[c * 160 + (m - 128)] = (bf16)f2bf(A.in[16][(m - 128) * 512 + c]); } }
    float* RSTD = (float*)(ws + WS_RSTD);
    for (int m0 = gw; m0 < M; m0 += 2 * NGW) {
        f32x4 v[2][4]; float s[2] = {0.f, 0.f};
#pragma unroll
        for (int q = 0; q < 2; ++q) { const int m = (m0 + q * NGW < M) ? m0 + q * NGW : m0;
            const float* xrow = (m < MP) ? A.in[0] + (size_t)m * D : A.in[1] + (size_t)(m - MP) * D; const GAS f32x4* xr = (const GAS f32x4*)xrow + F.lane;
#pragma unroll
            for (int j = 0; j < 4; ++j) v[q][j] = xr[64 * j]; }
#pragma unroll
        for (int q = 0; q < 2; ++q)
#pragma unroll
            for (int j = 0; j < 4; ++j) s[q] += (v[q][j].x * v[q][j].x + v[q][j].y * v[q][j].y) + (v[q][j].z * v[q][j].z + v[q][j].w * v[q][j].w);
#pragma unroll
        for (int q = 0; q < 2; ++q) { const int m = m0 + q * NGW; if (m < M) {
            const float rstd = 1.0f / sqrtf(wave_sum(s[q]) * (1.f / D) + RMS_EPS);
            if (F.lane == 0) RSTD[m] = rstd;
            GAS unsigned long long* o8 = (GAS unsigned long long*)(XN + (size_t)m * D) + F.lane;
#pragma unroll
            for (int j = 0; j < 4; ++j) o8[64 * j] = (unsigned long long)pk2(v[q][j].x, v[q][j].y) | ((unsigned long long)pk2(v[q][j].z, v[q][j].w) << 32); } }
    }
}

__device__ __forceinline__ float bf2f(bf16 v) { return __builtin_bit_cast(float, (unsigned)v << 16); }
__device__ __forceinline__ void p2_post(Frame& F, const Args& A) {
    const bf16* PB = (const bf16*)(A.ws + WS_PB);
    LAS float* lin = (LAS float*)(F.lds + RING_OFF);
    float* RW = (float*)(A.ws + WS_RW); const size_t RS = RW_STRIDE / 4;
    const float* mu = A.in[11]; const float* w0 = A.in[12]; const float* wl2 = A.in[13]; const float* a0 = A.in[14]; const float* al2 = A.in[15]; const float* gl2 = A.in[16];
    const float* k_k = A.in[17]; const float* k_a = A.in[18]; const float* sshift = A.in[5];
    const int c = F.tid;
    for (int rb = F.vcu * 4; rb < MS; rb += F.G * 4) {
#define XSR(i_, cc) ({ const int rs_ = rb + (i_); const bf16* p_ = PB + (size_t)(MP + rs_) * 2048; const float x_ = bf2f(p_[cc]); \
            const float pv_ = ((rs_ & 7) == 0) ? sshift[(size_t)(rs_ >> 3) * NSHIFT + (cc)] : bf2f(p_[(cc) - 2048]); x_ + (pv_ - x_) * mu[cc]; })
        for (int idx = c; idx < 4 * 288; idx += NTHR) { const int i = idx / 288, cc = idx % 288; const float x = XSR(i, 1536 + cc); float a;
            if (cc < 64) a = tanhf(x); else if (cc < 128) a = x; else a = 1.0f / (1.0f + expf(-x));
            lin[idx] = a; }
        __syncthreads();
        float wl[4], al[4], g[4];
#pragma unroll
        for (int i = 0; i < 4; ++i) { wl[i] = w0[c]; al[i] = a0[c]; g[i] = 0.f; }
#pragma unroll 32
        for (int m = 0; m < 64; ++m) { const float ww = wl2[m * 512 + c], aw = al2[m * 512 + c];
#pragma unroll
            for (int i = 0; i < 4; ++i) { wl[i] += lin[i * 288 + m] * ww; al[i] += lin[i * 288 + 64 + m] * aw; } }
#pragma unroll 32
        for (int m = 0; m < 160; ++m) { const float gw_ = gl2[m * 512 + c];
#pragma unroll
            for (int i = 0; i < 4; ++i) g[i] += lin[i * 288 + 128 + m] * gw_; }
#pragma unroll
        for (int i = 0; i < 4; ++i) {
            const float r = XSR(i, c), k = XSR(i, 512 + c), v = XSR(i, 1024 + c);
            const float z = -wl[i]; const float sp = (z > 20.f) ? z : log1pf(expf(z));
            const float wlog = -sp - 0.5f; const float dec = expf(-expf(wlog));
            const float a = 1.0f / (1.0f + expf(-al[i]));
            const float kkv = k * k_k[c]; const float ss = wave_sum(kkv * kkv); const float kk = kkv / fmaxf(sqrtf(ss), 1e-12f);
            const float kp = k * (1.0f + (a - 1.0f) * k_a[c]);
            const size_t o = (size_t)(rb + i) * 512 + c;
            RW[0 * RS + o] = r; RW[1 * RS + o] = dec; RW[2 * RS + o] = kp; RW[3 * RS + o] = v; RW[4 * RS + o] = kk; RW[5 * RS + o] = a; RW[6 * RS + o] = g[i];
        }
#undef XSR
        __syncthreads();
    }
}

typedef short v4i16_t __attribute__((ext_vector_type(4)));
constexpr float LOG2E = 1.4426950408889634f;
constexpr int AT_O = 0, AT_VST = 65536, AT_L = 132096, AT_LUTF = 133120, AT_BKT = 135616, AT_B2 = 137216, AT_SLUT = 137472;
__device__ __forceinline__ int vst_off(int row, int ch) { return row * 128 + ((ch ^ ((((row >> 1) & 1) << 1) | (((row >> 3) & 1) << 2))) << 4); }
__device__ __forceinline__ int o_off(int qrow, int ch) { return qrow * 256 + ((ch ^ ((qrow ^ (qrow >> 4)) & 15)) << 4); }
__device__ __forceinline__ void attn_unit2(const bf16* __restrict__ Qh, const bf16* __restrict__ Kh, const bf16* __restrict__ Vh, int qbA, int qbB, int dsh, const LAS float* lutf, LAS unsigned char* vb, int lane, f32x4 (&o)[2][4], float (&lsum)[2]) {
    const int m = lane & 15, g = lane >> 4;
    int kbase[2]; kbase[0] = qbA - (128 << dsh); kbase[1] = qbB - (128 << dsh);
    bf16x8 qf0[2], qf1[2];
#pragma unroll
    for (int u = 0; u < 2; ++u) { const bf16* qp = Qh + (size_t)((u ? qbB : qbA) + (m << dsh)) * 64 + 16 * g; qf0[u] = *(const bf16x8*)qp; qf1[u] = *(const bf16x8*)(qp + 8);
#pragma unroll
        for (int et = 0; et < 4; ++et) o[u][et] = (f32x4){0.f, 0.f, 0.f, 0.f};
        lsum[u] = 0.f; }
    const int vrow = lane >> 3, vch = lane & 7;
    v4u vreg[2][4]; bf16x8 kf[2][4];
    const int voff = (((vrow) << dsh) << 7) + vch * 16, koff = (((8 * (m >> 2) + (m & 3)) << dsh) << 7) + 32 * g;
#define AU_LOAD(grp_) do { _Pragma("unroll") for (int u = 0; u < 2; ++u) { \
        const long rb_ = ((long)(kbase[u] + ((32 * (grp_)) << dsh))) << 7; const char* vbp = (const char*)Vh + rb_; const char* kbp = (const char*)Kh + rb_; \
        _Pragma("unroll") for (int it = 0; it < 4; ++it) vreg[u][it] = *(const v4u*)(vbp + (((long)((8 * it) << dsh)) << 7) + voff); \
        kf[u][0] = *(const bf16x8*)(kbp + koff); kf[u][1] = *(const bf16x8*)(kbp + koff + 16); \
        kf[u][2] = *(const bf16x8*)(kbp + (((long)(4 << dsh)) << 7) + koff); kf[u][3] = *(const bf16x8*)(kbp + (((long)(4 << dsh)) << 7) + koff + 16); } } while (0)
    int voffc[4];
#pragma unroll
    for (int it = 0; it < 4; ++it) { const int rl = 8 * it + vrow; voffc[it] = (((rl < 15 ? rl : 15) << dsh) << 7) + vch * 16; }
    const int kl_ = 8 * (m >> 2) + (m & 3); const int koffa = (((kl_ < 15 ? kl_ : 15) << dsh) << 7) + 32 * g, koffb = ((((kl_ + 4) < 15 ? (kl_ + 4) : 15) << dsh) << 7) + 32 * g;
#define AU_LOAD4() do { _Pragma("unroll") for (int u = 0; u < 2; ++u) { \
        const long rb_ = ((long)(kbase[u] + (128 << dsh))) << 7; const char* vbp = (const char*)Vh + rb_; const char* kbp = (const char*)Kh + rb_; \
        _Pragma("unroll") for (int it = 0; it < 4; ++it) vreg[u][it] = *(const v4u*)(vbp + voffc[it]); \
        kf[u][0] = *(const bf16x8*)(kbp + koffa); kf[u][1] = *(const bf16x8*)(kbp + koffa + 16); \
        kf[u][2] = *(const bf16x8*)(kbp + koffb); kf[u][3] = *(const bf16x8*)(kbp + koffb + 16); } } while (0)
    AU_LOAD(0);
    unsigned wofs[4], rofs[4];
#pragma unroll
    for (int it = 0; it < 4; ++it) { wofs[it] = (unsigned)vst_off(it * 8 + vrow, vch); rofs[it] = (unsigned)(vst_off(8 * g + (m >> 2), 2 * it + ((m & 3) >> 1)) + 8 * (m & 1)); }
    int nmin[2];
#pragma unroll
    for (int u = 0; u < 2; ++u) nmin[u] = kbase[u] < 0 ? ((-kbase[u] + (1 << dsh) - 1) >> dsh) : 0;
#pragma unroll 1
    for (int grp = 0; grp < 5; ++grp) {
        f32x4 s0[2], s1[2];
#pragma unroll
        for (int u = 0; u < 2; ++u) {
#pragma unroll
            for (int it = 0; it < 4; ++it) *(LAS v4u*)(vb + u * 4096 + wofs[it]) = vreg[u][it];
            s0[u] = __builtin_amdgcn_mfma_f32_16x16x32_bf16(kf[u][0], qf0[u], (f32x4){0.f, 0.f, 0.f, 0.f}, 0, 0, 0);
            s1[u] = __builtin_amdgcn_mfma_f32_16x16x32_bf16(kf[u][2], qf0[u], (f32x4){0.f, 0.f, 0.f, 0.f}, 0, 0, 0); }
#pragma unroll
        for (int u = 0; u < 2; ++u) {
            s0[u] = __builtin_amdgcn_mfma_f32_16x16x32_bf16(kf[u][1], qf1[u], s0[u], 0, 0, 0);
            s1[u] = __builtin_amdgcn_mfma_f32_16x16x32_bf16(kf[u][3], qf1[u], s1[u], 0, 0, 0); }
        if (grp < 3) AU_LOAD(grp + 1); else if (grp == 3) AU_LOAD4();
        const int nl = 32 * grp + 8 * g;
        const LAS float* lp = lutf + (nl - m + 32);
        bf16x8 pbf[2];
#pragma unroll
        for (int u = 0; u < 2; ++u) {
            float p0[4], p1[4];
#pragma unroll
            for (int i = 0; i < 4; ++i) { p0[i] = __builtin_amdgcn_exp2f(s0[u][i] + lp[i]); p1[i] = __builtin_amdgcn_exp2f(s1[u][i] + lp[4 + i]); }
            if (nmin[u] > 32 * grp) {
#pragma unroll
                for (int i = 0; i < 4; ++i) { if (nl + i < nmin[u]) p0[i] = 0.f; if (nl + 4 + i < nmin[u]) p1[i] = 0.f; }
            }
            lsum[u] += ((p0[0] + p0[1]) + (p0[2] + p0[3])) + ((p1[0] + p1[1]) + (p1[2] + p1[3]));
            v4u pw; pw.x = cvt2(p0[0], p0[1]); pw.y = cvt2(p0[2], p0[3]); pw.z = cvt2(p1[0], p1[1]); pw.w = cvt2(p1[2], p1[3]);
            pbf[u] = __builtin_bit_cast(bf16x8, pw);
        }
        asm volatile("" ::: "memory");
#pragma unroll
        for (int u = 0; u < 2; ++u) {
#pragma unroll
            for (int et = 0; et < 4; ++et) {
                const v4i16_t t0 = __builtin_amdgcn_ds_read_tr16_b64_v4i16((LAS v4i16_t*)(vb + u * 4096 + rofs[et]));
                const v4i16_t t1 = __builtin_amdgcn_ds_read_tr16_b64_v4i16((LAS v4i16_t*)(vb + u * 4096 + rofs[et] + 512));
                const bf16x8 va = (bf16x8){t0[0], t0[1], t0[2], t0[3], t1[0], t1[1], t1[2], t1[3]};
                o[u][et] = __builtin_amdgcn_mfma_f32_16x16x32_bf16(va, pbf[u], o[u][et], 0, 0, 0);
            }
        }
        asm volatile("" ::: "memory");
    }
#undef AU_LOAD
#undef AU_LOAD4
#pragma unroll
    for (int u = 0; u < 2; ++u) { lsum[u] += __shfl_xor(lsum[u], 16); lsum[u] += __shfl_xor(lsum[u], 32); }
}
__device__ __forceinline__ void attn_tile32(const bf16* __restrict__ Qh, const bf16* __restrict__ Kh, const bf16* __restrict__ Vh, int qb, int dsh, const LAS float* lutf, LAS unsigned char* vb, int lane, f32x4 (&o)[2][4], float (&lsum)[2]) {
    const int m = lane & 15, g = lane >> 4;
    const int kbase = qb - (128 << dsh);
    bf16x8 qf0[2], qf1[2];
#pragma unroll
    for (int u = 0; u < 2; ++u) { const bf16* qp = Qh + (size_t)(qb + ((m + 16 * u) << dsh)) * 64 + 16 * g; qf0[u] = *(const bf16x8*)qp; qf1[u] = *(const bf16x8*)(qp + 8);
#pragma unroll
        for (int et = 0; et < 4; ++et) o[u][et] = (f32x4){0.f, 0.f, 0.f, 0.f};
        lsum[u] = 0.f; }
    const int vrow = lane >> 3, vch = lane & 7;
    v4u vrA[4], vrB[4]; bf16x8 kfA[4], kfB[4];
    const int voff = (((vrow) << dsh) << 7) + vch * 16, koff = (((8 * (m >> 2) + (m & 3)) << dsh) << 7) + 32 * g;
#define T_LOAD(VR, KF, grp_) do { \
        const long rb_ = ((long)(kbase + ((32 * (grp_)) << dsh))) << 7; const char* vbp = (const char*)Vh + rb_; const char* kbp = (const char*)Kh + rb_; \
        _Pragma("unroll") for (int it = 0; it < 4; ++it) VR[it] = *(const v4u*)(vbp + (((long)((8 * it) << dsh)) << 7) + voff); \
        KF[0] = *(const bf16x8*)(kbp + koff); KF[1] = *(const bf16x8*)(kbp + koff + 16); \
        KF[2] = *(const bf16x8*)(kbp + (((long)(4 << dsh)) << 7) + koff); KF[3] = *(const bf16x8*)(kbp + (((long)(4 << dsh)) << 7) + koff + 16); } while (0)
    T_LOAD(vrA, kfA, 0); T_LOAD(vrB, kfB, 1);
    unsigned wofs[4], rofs[4];
#pragma unroll
    for (int it = 0; it < 4; ++it) { wofs[it] = (unsigned)vst_off(it * 8 + vrow, vch); rofs[it] = (unsigned)(vst_off(8 * g + (m >> 2), 2 * it + ((m & 3) >> 1)) + 8 * (m & 1)); }
    const int nmin = kbase < 0 ? ((-kbase + (1 << dsh) - 1) >> dsh) : 0;
#define T_STEP(VR, KF, grp) do { \
        LAS unsigned char* vbg = vb + ((grp) & 1) * 4096; \
        _Pragma("unroll") for (int it = 0; it < 4; ++it) *(LAS v4u*)(vbg + wofs[it]) = VR[it]; \
        f32x4 s0[2], s1[2]; \
        _Pragma("unroll") for (int u = 0; u < 2; ++u) { \
            s0[u] = __builtin_amdgcn_mfma_f32_16x16x32_bf16(KF[0], qf0[u], (f32x4){0.f, 0.f, 0.f, 0.f}, 0, 0, 0); \
            s1[u] = __builtin_amdgcn_mfma_f32_16x16x32_bf16(KF[2], qf0[u], (f32x4){0.f, 0.f, 0.f, 0.f}, 0, 0, 0); } \
        _Pragma("unroll") for (int u = 0; u < 2; ++u) { \
            s0[u] = __builtin_amdgcn_mfma_f32_16x16x32_bf16(KF[1], qf1[u], s0[u], 0, 0, 0); \
            s1[u] = __builtin_amdgcn_mfma_f32_16x16x32_bf16(KF[3], qf1[u], s1[u], 0, 0, 0); } \
        if ((grp) + 2 < 5) T_LOAD(VR, KF, (grp) + 2); \
        const int nl = 32 * (grp) + 8 * g; \
        bf16x8 pbf[2]; \
        _Pragma("unroll") for (int u = 0; u < 2; ++u) { \
            const LAS float* lp = lutf + (nl - m - 16 * u + 32); \
            float p0[4], p1[4]; \
            _Pragma("unroll") for (int i = 0; i < 4; ++i) { p0[i] = __builtin_amdgcn_exp2f(s0[u][i] + lp[i]); p1[i] = __builtin_amdgcn_exp2f(s1[u][i] + lp[4 + i]); } \
            if (nmin > 32 * (grp)) { \
                _Pragma("unroll") for (int i = 0; i < 4; ++i) { if (nl + i < nmin) p0[i] = 0.f; if (nl + 4 + i < nmin) p1[i] = 0.f; } } \
            lsum[u] += ((p0[0] + p0[1]) + (p0[2] + p0[3])) + ((p1[0] + p1[1]) + (p1[2] + p1[3])); \
            v4u pw; pw.x = cvt2(p0[0], p0[1]); pw.y = cvt2(p0[2], p0[3]); pw.z = cvt2(p1[0], p1[1]); pw.w = cvt2(p1[2], p1[3]); \
            pbf[u] = __builtin_bit_cast(bf16x8, pw); } \
        asm volatile("" ::: "memory"); \
        _Pragma("unroll") for (int et = 0; et < 4; ++et) { \
            const v4i16_t t0 = __builtin_amdgcn_ds_read_tr16_b64_v4i16((LAS v4i16_t*)(vbg + rofs[et])); \
            const v4i16_t t1 = __builtin_amdgcn_ds_read_tr16_b64_v4i16((LAS v4i16_t*)(vbg + rofs[et] + 512)); \
            const bf16x8 va = (bf16x8){t0[0], t0[1], t0[2], t0[3], t1[0], t1[1], t1[2], t1[3]}; \
            o[0][et] = __builtin_amdgcn_mfma_f32_16x16x32_bf16(va, pbf[0], o[0][et], 0, 0, 0); \
            o[1][et] = __builtin_amdgcn_mfma_f32_16x16x32_bf16(va, pbf[1], o[1][et], 0, 0, 0); } \
        asm volatile("" ::: "memory"); } while (0)
    T_STEP(vrA, kfA, 0); T_STEP(vrB, kfB, 1); T_STEP(vrA, kfA, 2); T_STEP(vrB, kfB, 3); T_STEP(vrA, kfA, 4);
#undef T_STEP
#undef T_LOAD
#pragma unroll
    for (int u = 0; u < 2; ++u) { lsum[u] += __shfl_xor(lsum[u], 16); lsum[u] += __shfl_xor(lsum[u], 32); }
}
struct SampleCtx { const float* QS; const float* ck; const float* cv; const float* kn; const float* vn; int sb, h; };
__device__ __forceinline__ const float* s_row(const float* cache, const float* nw, int sb, int h, int cpos) {
    return (cpos >= LWIN) ? nw + ((size_t)(sb * STOK + (cpos - LWIN < STOK ? cpos - LWIN : STOK - 1)) * NH + h) * 64 : cache + ((size_t)(sb * LWIN + cpos) * NH + h) * 64;
}
__device__ __forceinline__ void attn_unit_s(const SampleCtx& C, int qb, int dsh, int nmax, const LAS float* lutf, LAS unsigned char* vb, int lane, f32x4 (&o)[4], float& lsum) {
    const int m = lane & 15, g = lane >> 4;
    const int kbase = qb - (128 << dsh);
    const int qi = qb + (m << dsh) - LWIN;
    bf16x8 qf0 = (bf16x8){0, 0, 0, 0, 0, 0, 0, 0}, qf1 = qf0;
    if ((unsigned)qi < (unsigned)STOK) { const float* qp = C.QS + (size_t)(C.sb * STOK + qi) * 512 + C.h * 64 + 16 * g; const float sc = 0.125f * LOG2E;
        const f32x4 a = *(const f32x4*)qp * sc, b = *(const f32x4*)(qp + 4) * sc, c = *(const f32x4*)(qp + 8) * sc, d = *(const f32x4*)(qp + 12) * sc;
        v4u w0, w1; w0.x = cvt2(a[0], a[1]); w0.y = cvt2(a[2], a[3]); w0.z = cvt2(b[0], b[1]); w0.w = cvt2(b[2], b[3]); w1.x = cvt2(c[0], c[1]); w1.y = cvt2(c[2], c[3]); w1.z = cvt2(d[0], d[1]); w1.w = cvt2(d[2], d[3]);
        qf0 = __builtin_bit_cast(bf16x8, w0); qf1 = __builtin_bit_cast(bf16x8, w1); }
#pragma unroll
    for (int et = 0; et < 4; ++et) o[et] = (f32x4){0.f, 0.f, 0.f, 0.f};
    lsum = 0.f;
    const int vrow = lane >> 3, vch = lane & 7;
    f32x4 vrA[4][2], krA[2][4], vrB[4][2], krB[2][4];
#define AS_LOAD(VR, KR, grp_) do { \
        _Pragma("unroll") for (int it = 0; it < 4; ++it) { const int nv_ = 32 * (grp_) + it * 8 + vrow; const float* vp = s_row(C.cv, C.vn, C.sb, C.h, kbase + ((nv_ < nmax ? nv_ : nmax) << dsh)) + vch * 8; VR[it][0] = *(const f32x4*)vp; VR[it][1] = *(const f32x4*)(vp + 4); } \
        const int n0_ = 32 * (grp_) + 8 * (m >> 2) + (m & 3); \
        const float* ka = s_row(C.ck, C.kn, C.sb, C.h, kbase + ((n0_ < nmax ? n0_ : nmax) << dsh)) + 16 * g; const float* kb = s_row(C.ck, C.kn, C.sb, C.h, kbase + (((n0_ + 4) < nmax ? (n0_ + 4) : nmax) << dsh)) + 16 * g; \
        _Pragma("unroll") for (int j = 0; j < 4; ++j) { KR[0][j] = *(const f32x4*)(ka + 4 * j); KR[1][j] = *(const f32x4*)(kb + 4 * j); } } while (0)
    AS_LOAD(vrA, krA, 0); AS_LOAD(vrB, krB, 1);
#define AS_STEP(VR, KR, grp) do { \
        LAS unsigned char* vbg = vb + ((grp) & 1) * 4096; \
        _Pragma("unroll") for (int it = 0; it < 4; ++it) { v4u w; w.x = cvt2(VR[it][0][0], VR[it][0][1]); w.y = cvt2(VR[it][0][2], VR[it][0][3]); w.z = cvt2(VR[it][1][0], VR[it][1][1]); w.w = cvt2(VR[it][1][2], VR[it][1][3]); \
            *(LAS v4u*)(vbg + vst_off(it * 8 + vrow, vch)) = w; } \
        bf16x8 kf[4]; \
        _Pragma("unroll") for (int tl = 0; tl < 2; ++tl) { v4u w0, w1; w0.x = cvt2(KR[tl][0][0], KR[tl][0][1]); w0.y = cvt2(KR[tl][0][2], KR[tl][0][3]); w0.z = cvt2(KR[tl][1][0], KR[tl][1][1]); w0.w = cvt2(KR[tl][1][2], KR[tl][1][3]); \
            w1.x = cvt2(KR[tl][2][0], KR[tl][2][1]); w1.y = cvt2(KR[tl][2][2], KR[tl][2][3]); w1.z = cvt2(KR[tl][3][0], KR[tl][3][1]); w1.w = cvt2(KR[tl][3][2], KR[tl][3][3]); \
            kf[2 * tl] = __builtin_bit_cast(bf16x8, w0); kf[2 * tl + 1] = __builtin_bit_cast(bf16x8, w1); } \
        if ((grp) + 2 < 5) AS_LOAD(VR, KR, (grp) + 2); \
        f32x4 s0 = __builtin_amdgcn_mfma_f32_16x16x32_bf16(kf[0], qf0, (f32x4){0.f, 0.f, 0.f, 0.f}, 0, 0, 0); \
        s0 = __builtin_amdgcn_mfma_f32_16x16x32_bf16(kf[1], qf1, s0, 0, 0, 0); \
        f32x4 s1 = __builtin_amdgcn_mfma_f32_16x16x32_bf16(kf[2], qf0, (f32x4){0.f, 0.f, 0.f, 0.f}, 0, 0, 0); \
        s1 = __builtin_amdgcn_mfma_f32_16x16x32_bf16(kf[3], qf1, s1, 0, 0, 0); \
        const int nl = 32 * (grp) + 8 * g; \
        const LAS float* lp = lutf + (nl - m + 16); \
        float p0[4], p1[4]; \
        _Pragma("unroll") for (int i = 0; i < 4; ++i) { p0[i] = __builtin_amdgcn_exp2f(s0[i] + lp[i]); p1[i] = __builtin_amdgcn_exp2f(s1[i] + lp[4 + i]); } \
        lsum += ((p0[0] + p0[1]) + (p0[2] + p0[3])) + ((p1[0] + p1[1]) + (p1[2] + p1[3])); \
        v4u pw; pw.x = cvt2(p0[0], p0[1]); pw.y = cvt2(p0[2], p0[3]); pw.z = cvt2(p1[0], p1[1]); pw.w = cvt2(p1[2], p1[3]); \
        const bf16x8 pbf = __builtin_bit_cast(bf16x8, pw); \
        asm volatile("" ::: "memory"); \
        _Pragma("unroll") for (int et = 0; et < 4; ++et) { \
            const int r0 = 8 * g + (m >> 2), ch = 2 * et + ((m & 3) >> 1); \
            const v4i16_t t0 = __builtin_amdgcn_ds_read_tr16_b64_v4i16((LAS v4i16_t*)(vbg + vst_off(r0, ch) + 8 * (m & 1))); \
            const v4i16_t t1 = __builtin_amdgcn_ds_read_tr16_b64_v4i16((LAS v4i16_t*)(vbg + vst_off(r0 + 4, ch) + 8 * (m & 1))); \
            const bf16x8 va = (bf16x8){t0[0], t0[1], t0[2], t0[3], t1[0], t1[1], t1[2], t1[3]}; \
            o[et] = __builtin_amdgcn_mfma_f32_16x16x32_bf16(va, pbf, o[et], 0, 0, 0); } \
        asm volatile("" ::: "memory"); } while (0)
    AS_STEP(vrA, krA, 0); AS_STEP(vrB, krB, 1); AS_STEP(vrA, krA, 2); AS_STEP(vrB, krB, 3); AS_STEP(vrA, krA, 4);
#undef AS_STEP
#undef AS_LOAD
    lsum += __shfl_xor(lsum, 16); lsum += __shfl_xor(lsum, 32);
}
constexpr int CW_Q = 8192;
__device__ __forceinline__ int q_pop(Frame& F, int k) {
    if (F.tid == 0) F.MISC[16] = __hip_atomic_fetch_add(F.ctl + CW_Q + 64 * k, 1u, __ATOMIC_RELAXED, __HIP_MEMORY_SCOPE_AGENT);
    __syncthreads(); const int it = (int)F.MISC[16]; __syncthreads(); return it;
}
__device__ __forceinline__ void p3_attn(Frame& F, const Args& A) {
    const bf16* QB = (const bf16*)(A.ws + WS_QB); const bf16* KB = (const bf16*)(A.ws + WS_KB); const bf16* VB = (const bf16*)(A.ws + WS_VB); bf16* MIX = (bf16*)(A.ws + WS_MIX);
    const float* btab = A.in[6]; const int lane = F.lane;
    LAS unsigned char* Ob = F.lds + AT_O; LAS float* Lb = (LAS float*)(F.lds + AT_L); LAS float* lutf = (LAS float*)(F.lds + AT_LUTF); LAS int* bkt = (LAS int*)(F.lds + AT_BKT); LAS float* b2p = (LAS float*)(F.lds + AT_B2);
    LAS unsigned char* vb = F.lds + AT_VST + F.wave * 8192;
    for (int i = F.tid; i < 387; i += NTHR) { const int br = i / 129, j = i % 129; const int dist = j << (2 * br);
        int bk; if (dist < 16) bk = dist; else { bk = 16 + (int)(log((double)dist / 16.0) / log(128.0) * 16.0); if (bk > 31) bk = 31; }
        bkt[i] = bk; }
    if (F.wave == 0) { const float gqm = wave_max(fabsf(A.in[9][lane])), gkm = wave_max(fabsf(A.in[10][lane]));
        const float bm = wave_max(fmaxf(fmaxf(btab[lane * 4], btab[lane * 4 + 1]), fmaxf(btab[lane * 4 + 2], btab[lane * 4 + 3])));
        if (lane == 0) b2p[0] = (8.0f * gqm * gkm + bm) * LOG2E; }
    __syncthreads();
    const float B2 = b2p[0];
    const int m = lane & 15, g = lane >> 4;
    const int xq0 = (F.vcu * 8 / F.G) & 7; int lut_h = -1, slut_h = -1;
    SampleCtx C; C.QS = (const float*)(A.ws + WS_QS); C.ck = A.in[2]; C.cv = A.in[3]; C.kn = A.out + O_KNS; C.vn = A.out + O_VNS;
    LAS float* Oacc = (LAS float*)(F.lds + AT_O);
    LAS float* Lacc = Oacc + 4 * 8 * 64;
    LAS float* slut = (LAS float*)(F.lds + AT_SLUT);
    const int pl = 0;
    int pk = 0, cnt = 0; bool p_left = true, s_left = true;
#pragma unroll 1
    while (p_left || s_left) {
      if (p_left && !(s_left && cnt >= 2)) {
        const int xq = (xq0 + pk) & 7;
        const int qi = q_pop(F, xq); if (qi >= 256) { if (++pk == 8) p_left = false; continue; }
        ++cnt;
        const int bh = (qi >> 5) * 8 + xq, qblk = qi & 31, h = bh & 7, b = bh >> 3, q0 = qblk * 256;
        const bf16* Qh = QB + (size_t)bh * SEQ * 64; const bf16* Kh = KB + (size_t)bh * SEQ * 64; const bf16* Vh = VB + (size_t)bh * SEQ * 64;
        if (h != lut_h) {
            for (int i = F.tid; i < 3 * 208; i += NTHR) { const int br = i / 208, dl = (i % 208) - 32; lutf[i] = (dl >= 0 && dl <= 128) ? btab[bkt[br * 129 + (128 - dl)] * NH + h] * LOG2E - B2 : -INFINITY; }
            lut_h = h; __syncthreads(); }
#pragma unroll 1
        for (int br = 0; br < 3; ++br) {
            int qrel[2];
#pragma unroll
            for (int uu = 0; uu < 2; ++uu) { if (br == 0) qrel[uu] = 32 * F.wave + 16 * uu; else if (br == 1) qrel[uu] = 128 * (F.wave >> 2) + (F.wave & 3) + 64 * uu; else qrel[uu] = F.wave + 8 * uu; }
            f32x4 o[2][4]; float lsum[2];
            int ln = lane; asm volatile("" : "+v"(ln));
            if (br < 2) attn_tile32(Qh, Kh, Vh, q0 + qrel[0], 2 * br, lutf + br * 208, vb, ln, o, lsum);
            else attn_unit2(Qh, Kh, Vh, q0 + qrel[0], q0 + qrel[1], 2 * br, lutf + br * 208, vb, ln, o, lsum);
#pragma unroll
            for (int uu = 0; uu < 2; ++uu) {
                const int qrow = qrel[uu] + (m << (2 * br));
                if (br == 0) {
#pragma unroll
                    for (int et = 0; et < 4; ++et) *(LAS f32x4*)(Ob + o_off(qrow, 4 * et + g)) = o[uu][et];
                    if (g == 0) Lb[qrow] = lsum[uu];
                } else if (br == 1) {
#pragma unroll
                    for (int et = 0; et < 4; ++et) { LAS f32x4* p = (LAS f32x4*)(Ob + o_off(qrow, 4 * et + g)); *p = *p + o[uu][et]; }
                    if (g == 0) Lb[qrow] += lsum[uu];
                } else {
                    const float inv = 1.0f / (Lb[qrow] + lsum[uu]);
                    bf16* dst = MIX + (size_t)(b * SEQ + q0 + qrow) * D + h * 64 + 4 * g;
#pragma unroll
                    for (int et = 0; et < 4; ++et) { const f32x4 v = (*(LAS f32x4*)(Ob + o_off(qrow, 4 * et + g)) + o[uu][et]) * inv;
                        *(unsigned long long*)(dst + 16 * et) = (unsigned long long)cvt2(v[0], v[1]) | ((unsigned long long)cvt2(v[2], v[3]) << 32); }
                }
            }
            __syncthreads();
        }
      } else {
        cnt = 0;
        const int qi = q_pop(F, 8); if (qi >= SBATCH * NH) { s_left = false; continue; }
        const int pair = qi; C.sb = pair >> 3; C.h = pair & 7;
        for (int i = F.tid; i < 8 * 64; i += NTHR) Oacc[i] = 0.f;
        if (F.tid < 8) Lacc[F.tid] = 0.f;
        if (C.h != slut_h) { for (int i = F.tid; i < 3 * 192; i += NTHR) { const int br = i / 192, dl = (i % 192) - 16; slut[i] = (dl >= 0 && dl <= 128) ? btab[bkt[br * 129 + (128 - dl)] * NH + C.h] * LOG2E - B2 : -INFINITY; } slut_h = C.h; }
        __syncthreads();
#pragma unroll 1
        for (int u = F.wave; u < 13; u += 8) {
            int br, cls; if (u == 0) { br = 0; cls = 0; } else if (u < 5) { br = 1; cls = u - 1; } else { br = 2; cls = u - 5; }
            f32x4 o[4]; float lsum;
            int ln = lane; asm volatile("" : "+v"(ln));
            attn_unit_s(C, LWIN + cls, 2 * br, 128 + ((STOK - 1 - cls) >> (2 * br)), slut + br * 192, vb, ln, o, lsum);
            const int qi2 = cls + (m << (2 * br));
            if (qi2 < STOK) {
                LAS float* op = Oacc + (pl * 8 + qi2) * 64 + 4 * g;
#pragma unroll
                for (int et = 0; et < 4; ++et) {
#pragma unroll
                    for (int r = 0; r < 4; ++r) (void)__hip_atomic_fetch_add(op + 16 * et + r, o[et][r], __ATOMIC_RELAXED, __HIP_MEMORY_SCOPE_WORKGROUP); }
                if (g == 0) (void)__hip_atomic_fetch_add(Lacc + pl * 8 + qi2, lsum, __ATOMIC_RELAXED, __HIP_MEMORY_SCOPE_WORKGROUP);
            }
        }
        __syncthreads();
        if (F.wave == 0) { const int i = lane >> 3, e8 = (lane & 7) * 8; const float inv = 1.0f / Lacc[pl * 8 + i];
            const LAS float* op = Oacc + (pl * 8 + i) * 64 + e8;
            v4u w; w.x = cvt2(op[0] * inv, op[1] * inv); w.y = cvt2(op[2] * inv, op[3] * inv); w.z = cvt2(op[4] * inv, op[5] * inv); w.w = cvt2(op[6] * inv, op[7] * inv);
            *(v4u*)(MIX + (size_t)(MP + C.sb * STOK + i) * D + C.h * 64 + e8) = w; }
        __syncthreads();
      }
    }
}

__device__ __forceinline__ void p4_scan(Frame& F, const Args& A, int gw, int NGW) {
    const float* RW = (const float*)(A.ws + WS_RW); const size_t RS = RW_STRIDE / 4; bf16* MIX = (bf16*)(A.ws + WS_MIX);
    const float* r_k = A.in[19]; const float* lnx_g = A.in[20]; const float* lnx_b = A.in[21]; const float* wkv0 = A.in[4];
    LAS float* sh = (LAS float*)(F.lds + RING_OFF + F.wave * 2048);
    const int lane = F.lane;
    for (int it0 = gw; it0 < SBATCH * NH; it0 += NGW) {
        const int it = it0 + BATCH * NH;
        const bool prompt = false; const int sq = it0 >> 3, h = it0 & 7;
        const int T = STOK; const size_t row0 = (size_t)MP + (size_t)sq * STOK;
        float S[64];
        if (prompt) {
#pragma unroll
            for (int j = 0; j < 64; ++j) S[j] = 0.f;
        } else { const f32x4* s0 = (const f32x4*)(wkv0 + ((size_t)(sq * NH + h) * 64 + lane) * 64);
#pragma unroll
            for (int j = 0; j < 16; ++j) { const f32x4 v = s0[j]; S[4 * j] = v.x; S[4 * j + 1] = v.y; S[4 * j + 2] = v.z; S[4 * j + 3] = v.w; } }
        const int c = h * 64 + lane; const float rkc = r_k[c], lg = lnx_g[c], lb = lnx_b[c];
        float nr, ndec, nkp, nv, nkk, na, ng;
        { const size_t o = (row0 - MP) * 512 + c; nr = RW[o]; ndec = RW[RS + o]; nkp = RW[2 * RS + o]; nv = RW[3 * RS + o]; nkk = RW[4 * RS + o]; na = RW[5 * RS + o]; ng = RW[6 * RS + o]; }
        for (int t = 0; t < T; ++t) {
            const float r = nr, dec = ndec, kp = nkp, v = nv, kk = nkk, a = na, g = ng;
            { const size_t o = (row0 - MP + (t + 1 < T ? t + 1 : t)) * 512 + c; nr = RW[o]; ndec = RW[RS + o]; nkp = RW[2 * RS + o]; nv = RW[3 * RS + o]; nkk = RW[4 * RS + o]; na = RW[5 * RS + o]; ng = RW[6 * RS + o]; }
            sh[lane] = r; sh[64 + lane] = dec; sh[128 + lane] = kp; sh[192 + lane] = kk; sh[256 + lane] = kk * a;
            LDS_WAIT(); asm volatile("" ::: "memory");
            float sk = 0.f;
#pragma unroll
            for (int j = 0; j < 64; ++j) sk += S[j] * sh[192 + j];
            float y = 0.f;
#pragma unroll
            for (int j = 0; j < 64; ++j) { S[j] = S[j] * sh[64 + j] - sk * sh[256 + j] + v * sh[128 + j]; y += S[j] * sh[j]; }
            const float bon = wave_sum(r * kp * rkc);
            const float mean = wave_sum(y) * (1.f / 64.f); const float dv = y - mean; const float var = wave_sum(dv * dv) * (1.f / 64.f);
            const float yo = dv * (1.0f / sqrtf(var + GN_EPS)) * lg + lb;
            MIX[(row0 + t) * D + 512 + c] = (bf16)f2bf((yo + bon * v) * g);
            LDS_WAIT(); asm volatile("" ::: "memory");
        }
        float* so = A.out + (prompt ? O_WKVP : O_WKVS) + ((size_t)(sq * NH + h) * 64 + lane) * 64;
#pragma unroll
        for (int j = 0; j < 16; ++j) ((f32x4*)so)[j] = (f32x4){S[4 * j], S[4 * j + 1], S[4 * j + 2], S[4 * j + 3]};
    }
}

constexpr int RS = 72;
constexpr int SLOT = 9216;
typedef unsigned u32x2_t __attribute__((ext_vector_type(2)));
__device__ __forceinline__ f32x4 mfma16(bf16x8 a, bf16x8 b, f32x4 c) { return __builtin_amdgcn_mfma_f32_16x16x32_bf16(a, b, c, 0, 0, 0); }
__device__ __forceinline__ f32x4 mm64(const LAS bf16* A, const LAS bf16* B, int ta, int tb, int lane, f32x4 acc) {
    const int r = lane & 15, g = lane >> 4;
    const LAS bf16* ap = A + (16 * ta + r) * RS + 8 * g; const LAS bf16* bp = B + (16 * tb + r) * RS + 8 * g;
    const bf16x8 a0 = *(const LAS bf16x8*)ap, a1 = *(const LAS bf16x8*)(ap + 32), b0 = *(const LAS bf16x8*)bp, b1 = *(const LAS bf16x8*)(bp + 32);
    acc = mfma16(a0, b0, acc); return mfma16(a1, b1, acc);
}
template <bool SWA, bool SWB>
__device__ __forceinline__ f32x4 mm64s(const LAS bf16* A, const LAS bf16* B, int ta, int tb, int lane, f32x4 acc) {
    const int r = lane & 15, g = lane >> 4;
    const int ra = 16 * ta + r, rb = 16 * tb + r, xa = SWA ? ((ra >> 3) & 7) : 0, xb = SWB ? ((rb >> 3) & 7) : 0;
    const LAS bf16* ap = A + ra * RS; const LAS bf16* bp = B + rb * RS;
    const bf16x8 a0 = *(const LAS bf16x8*)(ap + 8 * (g ^ xa)), a1 = *(const LAS bf16x8*)(ap + 8 * ((g + 4) ^ xa)), b0 = *(const LAS bf16x8*)(bp + 8 * (g ^ xb)), b1 = *(const LAS bf16x8*)(bp + 8 * ((g + 4) ^ xb));
    acc = mfma16(a0, b0, acc); return mfma16(a1, b1, acc);
}

struct Frag2 { bf16x8 f[2][2]; };
template <bool SW> __device__ __forceinline__ void ldfrag(const LAS bf16* M, int blk, int lane, Frag2& F_) {
    const int r = lane & 15, g = lane >> 4;
#pragma unroll
    for (int x = 0; x < 2; ++x) { const int row = 32 * blk + 16 * x + r, xs = SW ? ((row >> 3) & 7) : 0; const LAS bf16* p = M + row * RS;
        F_.f[x][0] = *(const LAS bf16x8*)(p + 8 * (g ^ xs)); F_.f[x][1] = *(const LAS bf16x8*)(p + 8 * ((g + 4) ^ xs)); }
}
__device__ __forceinline__ void mmblk(const Frag2& a, const Frag2& b, f32x4 (&acc)[2][2]) {
#pragma unroll
    for (int x = 0; x < 2; ++x)
#pragma unroll
        for (int y = 0; y < 2; ++y) { acc[x][y] = mfma16(a.f[x][0], b.f[y][0], acc[x][y]); acc[x][y] = mfma16(a.f[x][1], b.f[y][1], acc[x][y]); }
}
#define ZERO22(acc) do { _Pragma("unroll") for (int x = 0; x < 2; ++x) _Pragma("unroll") for (int y = 0; y < 2; ++y) acc[x][y] = (f32x4){0.f, 0.f, 0.f, 0.f}; } while (0)
__device__ __forceinline__ int dm_off(int j, int t) { return j * RS + (t ^ (8 * ((j >> 3) & 7))); }
__device__ __forceinline__ u32x2_t pack4(f32x4 v) { u32x2_t w; w.x = cvt2(v[0], v[1]); w.y = cvt2(v[2], v[3]); return w; }
__device__ __forceinline__ void st_t(LAS bf16* Dst, int c, int r0, f32x4 v) { *(LAS u32x2_t*)(Dst + c * RS + r0) = pack4(v); }
#define BARRIER() asm volatile("s_waitcnt lgkmcnt(0)\n\ts_barrier" ::: "memory")


__device__ __forceinline__ void r1_lin(Frame& F, const bf16* PB, const float* mu, bf16* LIN) {
    const int nvec = MP * 36;
#pragma unroll 1
    for (int base = F.vcu * NTHR + F.tid; base < nvec; base += 4 * F.G * NTHR) {
        v4u xv[4], pv[4];
#pragma unroll
        for (int k = 0; k < 4; ++k) { const int vi = base + k * F.G * NTHR; xv[k] = (v4u){0u, 0u, 0u, 0u}; pv[k] = xv[k];
            if (vi < nvec) { const int row = vi / 36, v8 = vi % 36; const bf16* pr = PB + (size_t)row * 2048 + 1536 + 8 * v8;
                xv[k] = *(const v4u*)pr; if ((row & (SEQ - 1)) != 0) pv[k] = *(const v4u*)(pr - 2048); } }
#pragma unroll
        for (int k = 0; k < 4; ++k) { const int vi = base + k * F.G * NTHR;
            if (vi < nvec) { const int row = vi / 36, v8 = vi % 36; const float* mp = mu + 1536 + 8 * v8;
                const f32x4 m0 = *(const f32x4*)mp, m1 = *(const f32x4*)(mp + 4); float a[8];
#pragma unroll
                for (int i = 0; i < 8; ++i) { const unsigned sh = (i & 1) * 16;
                    const float x = __builtin_bit_cast(float, ((xv[k][i >> 1] >> sh) & 0xffffu) << 16), p = __builtin_bit_cast(float, ((pv[k][i >> 1] >> sh) & 0xffffu) << 16);
                    const float xs = x + (p - x) * (i < 4 ? m0[i & 3] : m1[i & 3]);
                    if (v8 < 8) a[i] = 1.0f - 2.0f * __builtin_amdgcn_rcpf(1.0f + __expf(2.0f * xs));
                    else if (v8 < 16) a[i] = xs;
                    else a[i] = __builtin_amdgcn_rcpf(1.0f + __expf(-xs)); }
                v4u w_; w_.x = cvt2(a[0], a[1]); w_.y = cvt2(a[2], a[3]); w_.z = cvt2(a[4], a[5]); w_.w = cvt2(a[6], a[7]);
                *(v4u*)(LIN + (size_t)row * 288 + 8 * v8) = w_; } }
    }
}
struct R1Ptrs {
    const bf16* LIN;
    const bf16* PB; const bf16* WLt; const bf16* ALt; const bf16* GLt;
    const float *mu, *w0, *a0, *k_k, *k_a, *r_k;
    bf16* PT; bf16* RP; bf16* QM; bf16* Y0; float* GC; bf16* G2; bf16* BV;
};
struct R1W { bf16x8 wa0, wa1, aa0, aa1; };
__device__ __forceinline__ void r1_load_w(Frame& F, const R1Ptrs& P, int h, R1W& W) {
    const int ta = F.wave >> 1, r = F.lane & 15, g = F.lane >> 4;
    const bf16* wa = P.WLt + (size_t)(h * 64 + 16 * ta + r) * 64 + 8 * g; const bf16* aa = P.ALt + (size_t)(h * 64 + 16 * ta + r) * 64 + 8 * g; const bf16* ga = P.GLt + (size_t)(h * 64 + 16 * ta + r) * 160 + 8 * g;
    W.wa0 = *(const bf16x8*)wa; W.wa1 = *(const bf16x8*)(wa + 32); W.aa0 = *(const bf16x8*)aa; W.aa1 = *(const bf16x8*)(aa + 32); (void)ga;
}
__device__ __forceinline__ void r1_load_par(Frame& F, const R1Ptrs& P, int h) {
    LAS float* par = (LAS float*)(F.lds + 14 * SLOT); const int i = F.tid;
    if (i < 512) { const int a = i >> 6, j = i & 63; float v;
        if (a < 3) v = P.mu[a * 512 + h * 64 + j]; else if (a == 3) v = P.w0[h * 64 + j]; else if (a == 4) v = P.a0[h * 64 + j]; else if (a == 5) v = P.k_k[h * 64 + j]; else if (a == 6) v = P.k_a[h * 64 + j]; else v = P.r_k[h * 64 + j];
        par[i] = v; }
    __syncthreads();
}
struct R1Pre { v4u xr, xk, xv, qr, qk, qv; bf16x8 lw0[2], lw1[2], la0[2], la1[2]; unsigned touch; };
__device__ __forceinline__ void r1_prefetch(const R1Ptrs& P, int tid, int w, int bh, int c, R1Pre& N) {
    const int lane = tid & 63, h = bh & 7, b = bh >> 3; const size_t row0 = (size_t)b * SEQ + (size_t)c * 64;
    { const int t = tid >> 3, jb = (tid & 7) * 8, hj = h * 64 + jb; const bf16* pr = P.PB + (row0 + t) * 2048 + hj; const bool first = (c == 0 && t == 0);
      N.xr = *(const v4u*)pr; N.xk = *(const v4u*)(pr + 512); N.xv = *(const v4u*)(pr + 1024);
      N.qr = (v4u){0u, 0u, 0u, 0u}; N.qk = N.qr; N.qv = N.qr;
      if (!first) { N.qr = *(const v4u*)(pr - 2048); N.qk = *(const v4u*)(pr - 2048 + 512); N.qv = *(const v4u*)(pr - 2048 + 1024); } }
#pragma unroll
    for (int tt = 0; tt < 2; ++tt) { const int r = lane & 15, g = lane >> 4, tcol = 16 * (2 * (w & 1) + tt) + r; const bf16* bw = P.LIN + (row0 + tcol) * 288 + 8 * g;
      N.lw0[tt] = *(const bf16x8*)bw; N.lw1[tt] = *(const bf16x8*)(bw + 32); N.la0[tt] = *(const bf16x8*)(bw + 64); N.la1[tt] = *(const bf16x8*)(bw + 96); }
    N.touch = 0u; if (tid < 320) { const int rw = tid / 5, sg = tid % 5; N.touch = *(const unsigned*)(P.LIN + (row0 + rw) * 288 + 128 + 32 * sg); }
}
__device__ __forceinline__ void r1_item(Frame& F, const R1Ptrs& P, const R1W& W, R1Pre& N, int bh, int c, bool has_next) {
    int tid_ = F.tid; asm volatile("" : "+v"(tid_));
    const int tid = tid_, lane = tid & 63, w = F.wave, h = bh & 7, b = bh >> 3;
    const int ch = bh * 128 + c; const size_t row0 = (size_t)b * SEQ + (size_t)c * 64;
    LAS unsigned char* L = F.lds;
#define SL(k) ((LAS bf16*)(L + (k) * SLOT))
    LAS float* wlf = (LAS float*)(L + 0 * SLOT); LAS float* alf = (LAS float*)(L + 2 * SLOT); LAS float* cum = (LAS float*)(L + 12 * SLOT);
    LAS float* segtot = (LAS float*)(L + 11 * SLOT);
    {
        const int ta = w >> 1, r = lane & 15, g = lane >> 4;
#pragma unroll
        for (int tt = 0; tt < 2; ++tt) {
            const int tb = 2 * (w & 1) + tt, tcol = 16 * tb + r, j0 = 16 * ta + 4 * g;
            f32x4 dw = (f32x4){0.f, 0.f, 0.f, 0.f}, da = dw;
            dw = mfma16(W.wa0, N.lw0[tt], dw); dw = mfma16(W.wa1, N.lw1[tt], dw); da = mfma16(W.aa0, N.la0[tt], da); da = mfma16(W.aa1, N.la1[tt], da);
            *(LAS f32x4*)(wlf + tcol * 68 + j0) = dw; *(LAS f32x4*)(alf + tcol * 68 + j0) = da;
        }
    }
    BARRIER();
    const int t = tid >> 3, jb = (tid & 7) * 8, hj = h * 64 + jb; (void)hj;
    const LAS float* par = (const LAS float*)(L + 14 * SLOT);
    float r_[8], kp_[8], v_[8], kk_[8], lr_[8], lw_[8];
    {
        const v4u xr = N.xr, xk = N.xk, xv = N.xv, qr = N.qr, qk = N.qk, qv = N.qv;
        const f32x4 wl0 = *(const LAS f32x4*)(wlf + t * 68 + jb), wl1 = *(const LAS f32x4*)(wlf + t * 68 + jb + 4), al0 = *(const LAS f32x4*)(alf + t * 68 + jb), al1 = *(const LAS f32x4*)(alf + t * 68 + jb + 4);
        float ssq = 0.f, bon = 0.f; float kraw[8];
#pragma unroll
        for (int i = 0; i < 8; ++i) {
            const unsigned sh = (i & 1) * 16;
            const float x_r = __builtin_bit_cast(float, ((xr[i >> 1] >> sh) & 0xffffu) << 16), x_k = __builtin_bit_cast(float, ((xk[i >> 1] >> sh) & 0xffffu) << 16), x_v = __builtin_bit_cast(float, ((xv[i >> 1] >> sh) & 0xffffu) << 16);
            const float p_r = __builtin_bit_cast(float, ((qr[i >> 1] >> sh) & 0xffffu) << 16), p_k = __builtin_bit_cast(float, ((qk[i >> 1] >> sh) & 0xffffu) << 16), p_v = __builtin_bit_cast(float, ((qv[i >> 1] >> sh) & 0xffffu) << 16);
            r_[i] = x_r + (p_r - x_r) * par[jb + i]; kraw[i] = x_k + (p_k - x_k) * par[64 + jb + i]; v_[i] = x_v + (p_v - x_v) * par[128 + jb + i];
            const float wl = par[192 + jb + i] + (i < 4 ? wl0[i & 3] : wl1[i & 3]), al = par[256 + jb + i] + (i < 4 ? al0[i & 3] : al1[i & 3]);
            lw_[i] = -0.60653065971f * __builtin_amdgcn_rcpf(1.0f + __expf(-wl));
            lr_[i] = __builtin_amdgcn_rcpf(1.0f + __expf(-al));
            const float kkv = kraw[i] * par[320 + jb + i]; kk_[i] = kkv; ssq += kkv * kkv;
            kp_[i] = kraw[i] * (1.0f + (lr_[i] - 1.0f) * par[384 + jb + i]);
            bon += r_[i] * kp_[i] * par[448 + jb + i];
        }
        ssq += __shfl_xor(ssq, 1); ssq += __shfl_xor(ssq, 2); ssq += __shfl_xor(ssq, 4);
        bon += __shfl_xor(bon, 1); bon += __shfl_xor(bon, 2); bon += __shfl_xor(bon, 4);
        const float rn = 1.0f / fmaxf(sqrtf(ssq), 1e-12f);
#pragma unroll
        for (int i = 0; i < 8; ++i) kk_[i] *= rn;
        v4u bvw; bvw.x = cvt2(bon * v_[0], bon * v_[1]); bvw.y = cvt2(bon * v_[2], bon * v_[3]); bvw.z = cvt2(bon * v_[4], bon * v_[5]); bvw.w = cvt2(bon * v_[6], bon * v_[7]);
        { bf16* bg = P.BV + (((row0 + t) * 8 + h) * 16 + (jb >> 2)) * 8; *(u32x2_t*)bg = (u32x2_t){bvw.x, bvw.y}; *(u32x2_t*)(bg + 8) = (u32x2_t){bvw.z, bvw.w}; }
        *(LAS f32x4*)(cum + t * 68 + jb) = (f32x4){lw_[0], lw_[1], lw_[2], lw_[3]}; *(LAS f32x4*)(cum + t * 68 + jb + 4) = (f32x4){lw_[4], lw_[5], lw_[6], lw_[7]};
    }
    BARRIER();
    { const int seg = tid >> 6, j = tid & 63; float acc = 0.f;
#pragma unroll
      for (int i = 0; i < 8; ++i) { acc += cum[(8 * seg + i) * 68 + j]; cum[(8 * seg + i) * 68 + j] = acc; }
      segtot[seg * 64 + j] = acc; }
    BARRIER();
    { const int seg = tid >> 6, j = tid & 63; float off = 0.f;
      for (int s = 0; s < seg; ++s) off += segtot[s * 64 + j];
#pragma unroll
      for (int i = 0; i < 8; ++i) cum[(8 * seg + i) * 68 + j] += off; }
    BARRIER();
    LAS bf16* Atm = SL(0); LAS bf16* Btm = SL(1); LAS bf16* Ktm = SL(2); LAS bf16* Rtm = SL(3); LAS bf16* Adm = SL(4); LAS bf16* Bhd = SL(5); LAS bf16* Khd = SL(6); LAS bf16* Vdm = SL(7);
    {
        const f32x4 c0 = *(const LAS f32x4*)(cum + t * 68 + jb), c1 = *(const LAS f32x4*)(cum + t * 68 + jb + 4), e0 = *(const LAS f32x4*)(cum + 63 * 68 + jb), e1 = *(const LAS f32x4*)(cum + 63 * 68 + jb + 4);
        float at[8], bt[8], kt[8], rt[8], bh_[8], kh_[8];
#pragma unroll
        for (int i = 0; i < 8; ++i) {
            const float cc = (i < 4) ? c0[i & 3] : c1[i & 3], ce = (i < 4) ? e0[i & 3] : e1[i & 3];
            const float em = __expf(-cc), ep = __expf(cc), epm1 = __expf(cc - lw_[i]), ec = __expf(ce - cc);
            const float kl = kk_[i] * lr_[i];
            at[i] = -kk_[i] * epm1; bt[i] = kl * em; kt[i] = kp_[i] * em; rt[i] = r_[i] * ep; bh_[i] = kl * ec; kh_[i] = kp_[i] * ec;
            if (t == 63) P.GC[(size_t)ch * 64 + jb + i] = __expf(ce);
        }
#define ST8(M, a) do { v4u _w; _w.x = cvt2(a[0], a[1]); _w.y = cvt2(a[2], a[3]); _w.z = cvt2(a[4], a[5]); _w.w = cvt2(a[6], a[7]); *(LAS v4u*)(M + t * RS + jb) = _w; } while (0)
        ST8(Atm, at); ST8(Btm, bt); ST8(Ktm, kt); ST8(Rtm, rt);
#undef ST8
#pragma unroll
        for (int i = 0; i < 8; i += 2) { const int o0 = dm_off(jb + i, t), o1 = dm_off(jb + i + 1, t);
            const unsigned wa_ = cvt2(at[i], at[i + 1]), wb_ = cvt2(bh_[i], bh_[i + 1]), wk_ = cvt2(kh_[i], kh_[i + 1]), wv_ = cvt2(v_[i], v_[i + 1]);
            Adm[o0] = (bf16)(wa_ & 0xffffu); Adm[o1] = (bf16)(wa_ >> 16); Bhd[o0] = (bf16)(wb_ & 0xffffu); Bhd[o1] = (bf16)(wb_ >> 16);
            Khd[o0] = (bf16)(wk_ & 0xffffu); Khd[o1] = (bf16)(wk_ >> 16); Vdm[o0] = (bf16)(wv_ & 0xffffu); Vdm[o1] = (bf16)(wv_ >> 16); }
    }
    BARRIER();
    LAS float* TBf = (LAS float*)(L + 8 * SLOT); LAS bf16* TBb = SL(10); LAS bf16* TK = SL(11); LAS bf16* MBRt = SL(12);
    const int ta = w >> 1, cl = lane & 15, g = lane >> 4; (void)ta;
    const int bi = (w >> 1) & 1, bj = w & 1;
    if (w < 4) {
        Frag2 fa, fb, fk; ldfrag<false>(Atm, bi, lane, fa); ldfrag<false>(Btm, bj, lane, fb); ldfrag<false>(Ktm, bj, lane, fk);
        f32x4 d1[2][2], d2[2][2]; ZERO22(d1); ZERO22(d2); mmblk(fa, fb, d1); mmblk(fa, fk, d2);
#pragma unroll
        for (int x = 0; x < 2; ++x)
#pragma unroll
            for (int y = 0; y < 2; ++y) { const int col = 32 * bj + 16 * y + cl, r0 = 32 * bi + 16 * x + 4 * g;
#pragma unroll
                for (int i = 0; i < 4; ++i) if (!(col < r0 + i)) { d1[x][y][i] = 0.f; d2[x][y][i] = 0.f; }
                *(LAS f32x4*)(TBf + col * 68 + r0) = d1[x][y]; st_t(TBb, col, r0, d1[x][y]); st_t(TK, col, r0, d2[x][y]); }
    } else {
        Frag2 fb, fr; ldfrag<false>(Btm, bi, lane, fb); ldfrag<false>(Rtm, bj, lane, fr);
        f32x4 d3[2][2]; ZERO22(d3); mmblk(fb, fr, d3);
#pragma unroll
        for (int x = 0; x < 2; ++x)
#pragma unroll
            for (int y = 0; y < 2; ++y) { const int col = 32 * bj + 16 * y + cl, r0 = 32 * bi + 16 * x + 4 * g;
#pragma unroll
                for (int i = 0; i < 4; ++i) if (!(r0 + i <= col)) d3[x][y][i] = 0.f;
                st_t(MBRt, col, r0, d3[x][y]); }
    }
    BARRIER();
    LAS bf16* Minv = SL(0); LAS bf16* MinvT = SL(1); LAS bf16* Wsc = SL(13);
    for (int i = tid; i < 2 * SLOT / 4; i += NTHR) ((LAS unsigned*)Minv)[i] = 0u;
    BARRIER();
    if (w != 0) {
        const int r = lane & 15, g = lane >> 4;
#define G_LOAD(FA, FB, k_) do { const int ja_ = (k_) >> 2, tb_ = (k_) & 3; const bf16* ga = P.GLt + (size_t)(h * 64 + 16 * ja_ + r) * 160 + 8 * g; const bf16* bg = P.LIN + (row0 + 16 * tb_ + r) * 288 + 128 + 8 * g; \
            _Pragma("unroll") for (int ks = 0; ks < 5; ++ks) { FA[ks] = *(const bf16x8*)(ga + 32 * ks); FB[ks] = *(const bf16x8*)(bg + 32 * ks); } } while (0)
#define G_DO(FA, FB, k_) do { const int ja_ = (k_) >> 2, tb_ = (k_) & 3, tcol = 16 * tb_ + r, j0 = 16 * ja_ + 4 * g; f32x4 dg = (f32x4){0.f, 0.f, 0.f, 0.f}; \
            _Pragma("unroll") for (int ks = 0; ks < 5; ++ks) dg = mfma16(FA[ks], FB[ks], dg); \
            *(u32x2_t*)(P.BV + (((row0 + tcol) * 8 + h) * 16 + (j0 >> 2)) * 8 + 4) = pack4(dg); } while (0)
        bf16x8 faA[5], fbA[5], faB[5], fbB[5];
        G_LOAD(faA, fbA, w - 1); G_LOAD(faB, fbB, w + 6);
        G_DO(faA, fbA, w - 1);
        if (w <= 2) G_LOAD(faA, fbA, w + 13);
        G_DO(faB, fbB, w + 6);
        if (w <= 2) G_DO(faA, fbA, w + 13);
#undef G_LOAD
#undef G_DO
    }
    if (w == 0) {
        {
            const int blk = lane >> 4, cc = lane & 15; float x[16];
#pragma unroll
            for (int rr = 15; rr >= 0; --rr) {
                float s = (rr == cc) ? 1.f : 0.f;
                const LAS float* trow = TBf + (16 * blk + rr) * 68 + 16 * blk;
#pragma unroll
                for (int k = rr + 1; k < 16; ++k) s += trow[k] * x[k];
                x[rr] = s; asm volatile("" ::: "memory");
            }
#pragma unroll
            for (int rr = 0; rr < 16; ++rr) { const bf16 xb = (bf16)f2bf(x[rr]); Minv[(16 * blk + rr) * RS + 16 * blk + cc] = xb; MinvT[(16 * blk + cc) * RS + 16 * blk + rr] = xb; }
        }
        asm volatile("s_waitcnt lgkmcnt(0)" ::: "memory");
#pragma unroll
        for (int lev = 1; lev < 4; ++lev) {
            f32x4 wv[3], xv[3];
#pragma unroll
            for (int bi = 0; bi + lev < 4; ++bi) wv[bi] = mm64(TBb, MinvT, bi, bi + lev, lane, (f32x4){0.f, 0.f, 0.f, 0.f});
#pragma unroll
            for (int bi = 0; bi + lev < 4; ++bi) *(LAS u32x2_t*)(Wsc + (16 * bi + cl) * RS + 4 * g) = pack4(wv[bi]);
            asm volatile("s_waitcnt lgkmcnt(0)" ::: "memory");
#pragma unroll
            for (int bi = 0; bi + lev < 4; ++bi) {
                bf16x8 a0 = *(const LAS bf16x8*)(Minv + (16 * bi + cl) * RS + 16 * bi + 8 * (g & 1));
                bf16x8 b0 = *(const LAS bf16x8*)(Wsc + (16 * bi + cl) * RS + 8 * (g & 1));
                if (g >= 2) { a0 = (bf16x8){0, 0, 0, 0, 0, 0, 0, 0}; b0 = a0; }
                xv[bi] = mfma16(a0, b0, (f32x4){0.f, 0.f, 0.f, 0.f});
            }
            asm volatile("" ::: "memory");
#pragma unroll
            for (int bi = 0; bi + lev < 4; ++bi) { const int bj = bi + lev;
                *(LAS u32x2_t*)(MinvT + (16 * bj + cl) * RS + 16 * bi + 4 * g) = pack4(xv[bi]);
                const u32x2_t pw = pack4(xv[bi]);
                Minv[(16 * bi + 4 * g + 0) * RS + 16 * bj + cl] = (bf16)(pw.x & 0xffffu); Minv[(16 * bi + 4 * g + 1) * RS + 16 * bj + cl] = (bf16)(pw.x >> 16);
                Minv[(16 * bi + 4 * g + 2) * RS + 16 * bj + cl] = (bf16)(pw.y & 0xffffu); Minv[(16 * bi + 4 * g + 3) * RS + 16 * bj + cl] = (bf16)(pw.y >> 16); }
            asm volatile("s_waitcnt lgkmcnt(0)" ::: "memory");
        }
    }
    BARRIER();
    if (has_next) r1_prefetch(P, tid, w, bh, c + 1, N);
    LAS bf16* GT = SL(13); LAS bf16* ZT = SL(8);
    {
        Frag2 fa, fb; ldfrag<false>(Minv, bi, lane, fa);
        if (w < 4) ldfrag<false>(MBRt, bj, lane, fb); else ldfrag<true>(Bhd, bj, lane, fb);
        f32x4 d[2][2]; ZERO22(d); mmblk(fa, fb, d);
        LAS bf16* dst = (w < 4) ? GT : ZT;
#pragma unroll
        for (int x = 0; x < 2; ++x)
#pragma unroll
            for (int y = 0; y < 2; ++y) st_t(dst, 32 * bj + 16 * y + cl, 32 * bi + 16 * x + 4 * g, d[x][y]);
    }
    BARRIER();
    LAS bf16* HT = SL(9); LAS bf16* XT = SL(10);
    {
        Frag2 ftk; ldfrag<false>(TK, bi, lane, ftk);
        f32x4 d[2][2];
        if (w < 4) {
            Frag2 fk, fr, fg; ldfrag<false>(Ktm, bi, lane, fk); ldfrag<false>(Rtm, bj, lane, fr); ldfrag<false>(GT, bj, lane, fg);
            ZERO22(d); mmblk(fk, fr, d);
#pragma unroll
            for (int x = 0; x < 2; ++x)
#pragma unroll
                for (int y = 0; y < 2; ++y) { const int col = 32 * bj + 16 * y + cl, r0 = 32 * bi + 16 * x + 4 * g;
#pragma unroll
                    for (int i = 0; i < 4; ++i) if (!(r0 + i <= col)) d[x][y][i] = 0.f; }
            mmblk(ftk, fg, d);
#pragma unroll
            for (int x = 0; x < 2; ++x)
#pragma unroll
                for (int y = 0; y < 2; ++y) st_t(HT, 32 * bj + 16 * y + cl, 32 * bi + 16 * x + 4 * g, d[x][y]);
        } else {
            Frag2 fz; ldfrag<false>(ZT, bj, lane, fz);
#pragma unroll
            for (int x = 0; x < 2; ++x)
#pragma unroll
                for (int y = 0; y < 2; ++y) { const int col = 32 * bj + 16 * y + cl, r0 = 32 * bi + 16 * x + 4 * g;
                    const u32x2_t kh = *(const LAS u32x2_t*)(Khd + dm_off(col, r0));
                    d[x][y][0] = __builtin_bit_cast(float, kh.x << 16); d[x][y][1] = __builtin_bit_cast(float, kh.x & 0xffff0000u); d[x][y][2] = __builtin_bit_cast(float, kh.y << 16); d[x][y][3] = __builtin_bit_cast(float, kh.y & 0xffff0000u); }
            mmblk(ftk, fz, d);
#pragma unroll
            for (int x = 0; x < 2; ++x)
#pragma unroll
                for (int y = 0; y < 2; ++y) st_t(XT, 32 * bj + 16 * y + cl, 32 * bi + 16 * x + 4 * g, d[x][y]);
        }
    }
    BARRIER();
    asm volatile("; prefetch retired" :: "v"(N.xr), "v"(N.xk), "v"(N.xv), "v"(N.qr), "v"(N.qk), "v"(N.qv), "v"(N.touch));
    asm volatile("; prefetch retired" :: "v"(N.lw0[0]), "v"(N.lw1[0]), "v"(N.la0[0]), "v"(N.la1[0]), "v"(N.lw0[1]), "v"(N.lw1[1]), "v"(N.la0[1]), "v"(N.la1[1]));
    {
        const int prod = w >> 1, rb = w & 1;
        Frag2 fa;
        if (prod == 0 || prod == 2) ldfrag<true>(Adm, rb, lane, fa); else if (prod == 1) ldfrag<false>(XT, rb, lane, fa); else ldfrag<true>(Vdm, rb, lane, fa);
#pragma unroll
        for (int cb = 0; cb < 2; ++cb) {
            Frag2 fb;
            if (prod == 0) ldfrag<false>(ZT, cb, lane, fb); else if (prod == 1) ldfrag<true>(Vdm, cb, lane, fb); else if (prod == 2) ldfrag<false>(GT, cb, lane, fb); else ldfrag<false>(HT, cb, lane, fb);
            f32x4 d[2][2]; ZERO22(d);
            if (prod == 2) {
#pragma unroll
                for (int x = 0; x < 2; ++x)
#pragma unroll
                    for (int y = 0; y < 2; ++y) { const u32x2_t rr = *(const LAS u32x2_t*)(Rtm + (32 * cb + 16 * y + cl) * RS + 32 * rb + 16 * x + 4 * g);
                        d[x][y][0] = __builtin_bit_cast(float, rr.x << 16); d[x][y][1] = __builtin_bit_cast(float, rr.x & 0xffff0000u); d[x][y][2] = __builtin_bit_cast(float, rr.y << 16); d[x][y][3] = __builtin_bit_cast(float, rr.y & 0xffff0000u); }
            }
            mmblk(fa, fb, d);
#pragma unroll
            for (int x = 0; x < 2; ++x)
#pragma unroll
                for (int y = 0; y < 2; ++y) { const int col = 32 * cb + 16 * y + cl, r0 = 32 * rb + 16 * x + 4 * g;
                    if (prod == 0) *(u32x2_t*)(P.PT + (size_t)ch * 4096 + col * 64 + r0) = pack4(d[x][y]);
                    else if (prod == 1) *(u32x2_t*)(P.QM + (size_t)ch * 4096 + col * 64 + r0) = pack4(d[x][y]);
                    else if (prod == 2) *(u32x2_t*)(P.RP + (size_t)ch * 4096 + col * 64 + r0) = pack4(d[x][y]);
                    else *(u32x2_t*)(P.Y0 + (size_t)ch * 4096 + col * 64 + r0) = pack4(d[x][y]); }
        }
    }
    BARRIER();
#undef SL
}

struct R2Ptrs { const bf16* PT; const bf16* RP; const bf16* QM; const bf16* Y0; const float* GC; const bf16* G2; const bf16* BV; const float* lnx_g; const float* lnx_b; bf16* MIX; float* wkv_out; };
__device__ __forceinline__ void r2_seq(Frame& F, const R2Ptrs& P, int bh) {
    const int lane = F.lane, w = F.wave, cl = lane & 15, g = lane >> 4, h = bh & 7, b = bh >> 3, x = w & 3;
    const bool isS = w < 4;
    LAS bf16* Sbf = (LAS bf16*)(F.lds);
    const size_t chb = (size_t)bh * 128;
    if (isS) {
        f32x4 S[4]; bf16x8 ptA[2], ptB[2], ptC[2], ptD[2]; u32x2_t qA[4], qB[4], qC[4], qD[4]; f32x4 gcA, gcB, gcC, gcD;
#define S_LOAD(pt, q, gc, cc_) do { const size_t cn_ = chb + ((cc_) < 128 ? (cc_) : 127); const bf16* pp = P.PT + cn_ * 4096 + (16 * x + cl) * 64 + 8 * g; pt[0] = *(const bf16x8*)pp; pt[1] = *(const bf16x8*)(pp + 32); \
            gc = *(const f32x4*)(P.GC + cn_ * 64 + 16 * x + 4 * g); \
            _Pragma("unroll") for (int it = 0; it < 4; ++it) q[it] = *(const u32x2_t*)(P.QM + cn_ * 4096 + (16 * it + cl) * 64 + 16 * x + 4 * g); } while (0)
#define S_STEP(pt, q, gc, c_) do { const LAS bf16* sr = Sbf + ((c_) & 1) * (64 * RS) + cl * RS + 8 * g; LAS bf16* sw = Sbf + (((c_) + 1) & 1) * (64 * RS) + cl * RS + 16 * x + 4 * g; \
            _Pragma("unroll") for (int it = 0; it < 4; ++it) { const bf16x8 sb0 = *(const LAS bf16x8*)(sr + 16 * it * RS), sb1 = *(const LAS bf16x8*)(sr + 16 * it * RS + 32); \
                f32x4 d = mfma16(pt[0], sb0, (f32x4){0.f, 0.f, 0.f, 0.f}); d = mfma16(pt[1], sb1, d);          \
                f32x4 qf; qf[0] = __builtin_bit_cast(float, q[it].x << 16); qf[1] = __builtin_bit_cast(float, q[it].x & 0xffff0000u); qf[2] = __builtin_bit_cast(float, q[it].y << 16); qf[3] = __builtin_bit_cast(float, q[it].y & 0xffff0000u); \
                S[it] = d + S[it] * gc + qf; *(LAS u32x2_t*)(sw + 16 * it * RS) = pack4(S[it]); } } while (0)
#pragma unroll
        for (int it = 0; it < 4; ++it) { S[it] = (f32x4){0.f, 0.f, 0.f, 0.f}; *(LAS u32x2_t*)(Sbf + (16 * it + cl) * RS + 16 * x + 4 * g) = (u32x2_t){0u, 0u}; }
        S_LOAD(ptA, qA, gcA, 0); S_LOAD(ptB, qB, gcB, 1); S_LOAD(ptC, qC, gcC, 2); S_LOAD(ptD, qD, gcD, 3);
        BARRIER();
#pragma unroll 1
        for (int c = 0; c < 128; c += 4) {
            S_STEP(ptA, qA, gcA, c); S_LOAD(ptA, qA, gcA, c + 4); BARRIER();
            S_STEP(ptB, qB, gcB, c + 1); S_LOAD(ptB, qB, gcB, c + 5); BARRIER();
            S_STEP(ptC, qC, gcC, c + 2); S_LOAD(ptC, qC, gcC, c + 6); BARRIER();
            S_STEP(ptD, qD, gcD, c + 3); S_LOAD(ptD, qD, gcD, c + 7); BARRIER();
        }
#undef S_LOAD
#undef S_STEP
#pragma unroll
        for (int it = 0; it < 4; ++it) *(f32x4*)(P.wkv_out + ((size_t)bh * 64 + 16 * it + cl) * 64 + 16 * x + 4 * g) = S[it];
    } else {
        f32x4 lg[4], lb[4];
#pragma unroll
        for (int it = 0; it < 4; ++it) { lg[it] = *(const f32x4*)(P.lnx_g + h * 64 + 16 * it + 4 * g); lb[it] = *(const f32x4*)(P.lnx_b + h * 64 + 16 * it + 4 * g); }
        bf16x8 rpA[2], rpB[2], rpC[2], rpD[2]; u32x2_t y0A[4], y0B[4], y0C[4], y0D[4]; v4u bgA[4], bgB[4], bgC[4], bgD[4];
        const size_t rowb0 = (size_t)b * SEQ;
#define Y_LOAD(rp, y0, bgw, cc_) do { const int ci_ = ((cc_) < 128 ? (cc_) : 127); const size_t cn_ = chb + ci_; const size_t rown = rowb0 + (size_t)ci_ * 64 + 16 * x + cl; \
            const bf16* rr = P.RP + cn_ * 4096 + (16 * x + cl) * 64 + 8 * g; rp[0] = *(const bf16x8*)rr; rp[1] = *(const bf16x8*)(rr + 32); \
            _Pragma("unroll") for (int it = 0; it < 4; ++it) { y0[it] = *(const u32x2_t*)(P.Y0 + cn_ * 4096 + (16 * x + cl) * 64 + 16 * it + 4 * g); \
                bgw[it] = *(const v4u*)(P.BV + ((rown * 8 + h) * 16 + 4 * it + g) * 8); } } while (0)
#define Y_STEP(rp, y0, bgw, c_) do { const LAS bf16* sr = Sbf + ((c_) & 1) * (64 * RS) + cl * RS + 8 * g; \
            f32x4 Y[4]; float s1 = 0.f, s2 = 0.f; \
            _Pragma("unroll") for (int it = 0; it < 4; ++it) { const bf16x8 sb0 = *(const LAS bf16x8*)(sr + 16 * it * RS), sb1 = *(const LAS bf16x8*)(sr + 16 * it * RS + 32); \
                f32x4 yi; yi[0] = __builtin_bit_cast(float, y0[it].x << 16); yi[1] = __builtin_bit_cast(float, y0[it].x & 0xffff0000u); yi[2] = __builtin_bit_cast(float, y0[it].y << 16); yi[3] = __builtin_bit_cast(float, y0[it].y & 0xffff0000u); \
                f32x4 y = mfma16(sb0, rp[0], yi); y = mfma16(sb1, rp[1], y); Y[it] = y;                 \
                s1 += (y[0] + y[1]) + (y[2] + y[3]); s2 += (y[0] * y[0] + y[1] * y[1]) + (y[2] * y[2] + y[3] * y[3]); } \
            s1 += __shfl_xor(s1, 16); s1 += __shfl_xor(s1, 32); s2 += __shfl_xor(s2, 16); s2 += __shfl_xor(s2, 32); \
            const float mean = s1 * (1.f / 64.f), var = fmaxf(s2 * (1.f / 64.f) - mean * mean, 0.f), rstd = 1.0f / sqrtf(var + GN_EPS); \
            const size_t row = rowb0 + (size_t)(c_) * 64 + 16 * x + cl; \
            _Pragma("unroll") for (int it = 0; it < 4; ++it) { f32x4 bv, g2; \
                bv[0] = __builtin_bit_cast(float, bgw[it].x << 16); bv[1] = __builtin_bit_cast(float, bgw[it].x & 0xffff0000u); bv[2] = __builtin_bit_cast(float, bgw[it].y << 16); bv[3] = __builtin_bit_cast(float, bgw[it].y & 0xffff0000u); \
                g2[0] = __builtin_bit_cast(float, bgw[it].z << 16); g2[1] = __builtin_bit_cast(float, bgw[it].z & 0xffff0000u); g2[2] = __builtin_bit_cast(float, bgw[it].w << 16); g2[3] = __builtin_bit_cast(float, bgw[it].w & 0xffff0000u); \
                const f32x4 o = ((Y[it] - mean) * rstd * lg[it] + lb[it] + bv) * g2; \
                *(u32x2_t*)(P.MIX + row * D + 512 + h * 64 + 16 * it + 4 * g) = pack4(o); } } while (0)
        Y_LOAD(rpA, y0A, bgA, 0); Y_LOAD(rpB, y0B, bgB, 1); Y_LOAD(rpC, y0C, bgC, 2); Y_LOAD(rpD, y0D, bgD, 3);
        BARRIER();
#pragma unroll 1
        for (int c = 0; c < 128; c += 4) {
            Y_STEP(rpA, y0A, bgA, c); Y_LOAD(rpA, y0A, bgA, c + 4); BARRIER();
            Y_STEP(rpB, y0B, bgB, c + 1); Y_LOAD(rpB, y0B, bgB, c + 5); BARRIER();
            Y_STEP(rpC, y0C, bgC, c + 2); Y_LOAD(rpC, y0C, bgC, c + 6); BARRIER();
            Y_STEP(rpD, y0D, bgD, c + 3); Y_LOAD(rpD, y0D, bgD, c + 7); BARRIER();
        }
#undef Y_LOAD
#undef Y_STEP
    }
}

#ifndef DUP0
#define DUP0 1
#endif
#ifndef DUP2
#define DUP2 1
#endif
#ifndef DUP3
#define DUP3 1
#endif
#ifndef DUP4
#define DUP4 1
#endif
__global__ void __launch_bounds__(NTHR, 2) fwd(Args args) {
    extern __shared__ __attribute__((aligned(16))) unsigned char lds[];
    Frame F;
    F.lds = (LAS unsigned char*)lds; F.MISC = (volatile LAS unsigned*)(F.lds + MISC_OFF);
    F.tid = threadIdx.x; F.lane = F.tid & 63; F.wave = __builtin_amdgcn_readfirstlane(F.tid >> 6);
    F.G = gridDim.x; { const int bx = blockIdx.x; F.vcu = (F.G % 8 == 0) ? (bx % 8) * (F.G / 8) + bx / 8 : bx; }
    unsigned char* ws = args.ws; F.ctl = (gu32*)(ws + WS_CTL);
    for (int u = F.tid; u < (LDS_BYTES - LDSCTL_OFF) / 4; u += NTHR) ((LAS unsigned*)(F.lds + LDSCTL_OFF))[u] = 0u;
    __syncthreads();
    const int lo = args.ph_lo, hi = args.ph_hi; const bool multi = (hi - lo) > 1;
    XcdBarrier bar; bar.bar = (unsigned*)(F.ctl + CW_BAR); bar.x = 0; bar.st = nullptr;
    if (multi) bar = xcd_barrier_post((unsigned*)(F.ctl + CW_BAR), F.MISC + 8);
#define IN(k) (lo <= (k) && (k) < hi)
#define SEAM(k) do { if (IN(k) && IN((k) + 1)) xcd_barrier(bar); } while (0)
    bf16* WIN = (bf16*)(ws + WS_WIN); bf16* WO = (bf16*)(ws + WS_WO); bf16* W1 = (bf16*)(ws + WS_W1); bf16* W2 = (bf16*)(ws + WS_W2);
    bf16* XN = (bf16*)(ws + WS_XN); bf16* HB = (bf16*)(ws + WS_HB); bf16* HBF = (bf16*)(ws + WS_HBF); float* SSQ = (float*)(ws + WS_SSQ);
#ifndef SKIP_0
    if (IN(0)) { for (int rep = 0; rep < DUP0; ++rep) { p0_prologue(F, args); __syncthreads(); } SEAM(0); }
#endif
#ifndef SKIP_1
    if (IN(1)) { pg8::Gemm g{XN, WIN, M, NINP, D}; pg8::StaticOrder S; S.init(M, NINP, F.G, (int)blockIdx.x);
        pg8::EpiProj E{(bf16*)(ws + WS_QB), (WS_KB - WS_QB) / 2, (bf16*)(ws + WS_PB), (float*)(ws + WS_QS), args.out, args.in[9], args.in[10], (const float*)(ws + WS_RSTD)};
        pg8::gemm_phase<pg8::EpiProj, pg8::StaticOrder, true, true>(F.lds + RING_OFF, g, S, E); SEAM(1); }
#endif
#ifndef SKIP_2
    if (IN(2)) {
#pragma unroll
      for (int rep = 0; rep < DUP2; ++rep) {
        r1_lin(F, (const bf16*)(ws + WS_PB), args.in[11], (bf16*)(ws + WS_LIN));
        p2_post(F, args);
        if (multi) xcd_barrier(bar);
        { R1Ptrs P; P.LIN = (const bf16*)(ws + WS_LIN); P.PB = (const bf16*)(ws + WS_PB); P.WLt = (const bf16*)(ws + WS_LORA); P.ALt = P.WLt + 512 * 64; P.GLt = P.ALt + 512 * 64;
          P.mu = args.in[11]; P.w0 = args.in[12]; P.a0 = args.in[14]; P.k_k = args.in[17]; P.k_a = args.in[18]; P.r_k = args.in[19];
          P.PT = (bf16*)(ws + WS_PT); P.RP = (bf16*)(ws + WS_RP); P.QM = (bf16*)(ws + WS_QM); P.Y0 = (bf16*)(ws + WS_Y0); P.GC = (float*)(ws + WS_GC); P.G2 = nullptr; P.BV = (bf16*)(ws + WS_G2);
          { const int nper = (BATCH * NH * 128) / F.G; const int it0 = F.vcu * nper; R1W W; r1_load_w(F, P, (it0 >> 7) & 7, W); r1_load_par(F, P, (it0 >> 7) & 7); R1Pre N; r1_prefetch(P, F.tid, F.wave, it0 >> 7, it0 & 127, N);
#pragma unroll 1
          for (int it = it0; it < it0 + nper; ++it) r1_item(F, P, W, N, it >> 7, it & 127, it + 1 < it0 + nper); } }
        __syncthreads(); }
        SEAM(2); }
#endif
#ifndef SKIP_3
    if (IN(3)) {
      for (int rep = 0; rep < DUP3; ++rep) {
        if ((F.vcu & 3) == 0 && (F.vcu >> 2) < BATCH * NH) {
            R2Ptrs P; P.PT = (const bf16*)(ws + WS_PT); P.RP = (const bf16*)(ws + WS_RP); P.QM = (const bf16*)(ws + WS_QM); P.Y0 = (const bf16*)(ws + WS_Y0); P.GC = (const float*)(ws + WS_GC);
            P.G2 = nullptr; P.BV = (const bf16*)(ws + WS_G2); P.lnx_g = args.in[20]; P.lnx_b = args.in[21]; P.MIX = (bf16*)(ws + WS_MIX); P.wkv_out = args.out + O_WKVP;
            r2_seq(F, P, F.vcu >> 2);
        } else { const int q = F.vcu >> 2, r = F.vcu & 3; const int idx = (q < BATCH * NH) ? 3 * q + (r - 1) : F.vcu - BATCH * NH; p4_scan(F, args, idx * NWAVES + F.wave, (F.G - BATCH * NH) * NWAVES); }
        __syncthreads();
        p3_attn(F, args); __syncthreads(); }
      SEAM(3); }
#endif
#ifndef SKIP_5
    if (IN(5)) { pg8::Gemm g{(const bf16*)(ws + WS_MIX), WO, M, D, D}; pg8::StaticOrder S; S.init(M, D, F.G, (int)blockIdx.x);
        pg8::EpiHRes E{XN, args.out + O_YP, HBF, SSQ, MP};
        pg8::gemm_phase<pg8::EpiHRes, pg8::StaticOrder, true, true>(F.lds + RING_OFF, g, S, E); SEAM(5); }
#endif
#ifndef SKIP_6
    if (IN(6)) { pg8::Gemm g{HBF, W1, M, FF, D}; pg8::StaticOrder S; S.init(M, FF, F.G, (int)blockIdx.x);
        pg8::EpiRelu2 E{HB, FF, SSQ};
        pg8::gemm_phase<pg8::EpiRelu2, pg8::StaticOrder, true, true>(F.lds + RING_OFF, g, S, E); SEAM(6); }
#endif
#ifndef SKIP_7
    if (IN(7)) { { pg8::Gemm g{HB, W2, MP, D, FF, 0}; pg8::StaticOrder S; S.init(MP, D, F.G, (int)blockIdx.x);
        pg8::EpiAddH E{args.out + O_YP, HBF, D};
        pg8::gemm_phase<pg8::EpiAddH, pg8::StaticOrder, true, true>(F.lds + RING_OFF, g, S, E); }
        { pg8::Gemm g{HB, W2, M, D, FF / 8, FF}; pg8::SplitKOrder<8, FF> S{F.G, (int)blockIdx.x};
        pg8::EpiAtomicAdd E{args.out + O_YP, D};
        pg8::gemm_phase<pg8::EpiAtomicAdd, pg8::SplitKOrder<8, FF>, true, true>(F.lds + RING_OFF, g, S, E); } }
#endif
#undef IN
#undef SEAM
}

#ifndef N_PHASES_PER_LAUNCH
#define N_PHASES_PER_LAUNCH 8
#endif
extern "C" void kernel_launch(void* const* d_in, const int* in_sizes, int n_in, void* d_out, int out_size, void* d_ws, size_t ws_size, hipStream_t stream) {
    static int grid = 0;
    if (grid == 0) {
        if (n_in != 26 || out_size != (int)O_END || ws_size < WS_END) { fprintf(stderr, "kernel_launch: unexpected shapes n_in %d out %d ws %zu\n", n_in, out_size, ws_size); grid = -1; return; }
        int dev = 0, cus = 0, per_cu = 0;
        if (hipGetDevice(&dev) != hipSuccess || hipDeviceGetAttribute(&cus, hipDeviceAttributeMultiprocessorCount, dev) != hipSuccess) { grid = -1; return; }
        if (hipFuncSetAttribute((const void*)fwd, hipFuncAttributeMaxDynamicSharedMemorySize, LDS_BYTES) != hipSuccess) { fprintf(stderr, "kernel_launch: hipFuncSetAttribute failed\n"); grid = -1; return; }
        if (hipOccupancyMaxActiveBlocksPerMultiprocessor(&per_cu, (const void*)fwd, NTHR, LDS_BYTES) != hipSuccess || per_cu < 1) { fprintf(stderr, "kernel_launch: occupancy query says %d\n", per_cu); }
        (void)hipGetLastError();
        grid = cus;
    }
    if (grid < 0) return;
    if (hipMemsetAsync((char*)d_ws + WS_CTL, 0, CTL_ZERO_BYTES, stream) != hipSuccess) return;
    Args a{};
    for (int i = 0; i < 26; ++i) a.in[i] = (const float*)d_in[i];
    a.out = (float*)d_out; a.ws = (unsigned char*)d_ws;
    constexpr int NPH = 8;
    for (int p = 0; p < NPH; p += N_PHASES_PER_LAUNCH) {
        a.ph_lo = p; a.ph_hi = (p + N_PHASES_PER_LAUNCH < NPH) ? p + N_PHASES_PER_LAUNCH : NPH;
        hipLaunchKernelGGL(fwd, dim3(grid), dim3(NTHR), LDS_BYTES, stream, a);
    }
}
```

```cpp
#include <hip/hip_runtime.h>
#include <cstdio>
#include <cstdint>
#include <cmath>
namespace pg8 {
#define PG8_LAS __attribute__((address_space(3)))
typedef unsigned short bf16_t;
typedef short bf16x8 __attribute__((ext_vector_type(8)));
typedef float f32x4 __attribute__((ext_vector_type(4)));
typedef unsigned u32x4 __attribute__((ext_vector_type(4)));
constexpr int BM = 256, BK = 64, HALF = 128, HTB = HALF * BK * 2  , STAGE_BYTES = 8 * HTB, NXCD = 8, WGM = 8;

__host__ __device__ __forceinline__ int lds_byte(int r, int c) { const int st = (r >> 4) * 2 + (c >> 5), rr = r & 15, cc = c & 31, ob = rr * 64 + cc * 2; return st * 1024 + (ob ^ (((ob >> 9) & 1) << 5)); }
__host__ __device__ __forceinline__ void stage_rc(int b, int& R, int& C) { const int st = b / 1024, sb = b % 1024, swz = sb ^ (((sb >> 9) & 1) << 5); R = (st >> 1) * 16 + swz / 64; C = (st & 1) * 32 + (swz % 64) / 2; }
__host__ __device__ __forceinline__ int perm32(int rho) { const int n = rho >> 4, i = rho & 15; return 8 * (i >> 2) + 4 * n + (i & 3); }

struct Unit { int pm, pn, ko; };
struct Gemm { const bf16_t* A; const bf16_t* Bt; int M, N, K; int ld; };

struct StaticOrder {
    int nM, nN, nwg, G, c;
    __host__ __device__ void init(int M, int N, int G_, int c_) { nM = M / BM; nN = N / BM; nwg = nM * nN; G = G_; c = c_; }
    __host__ __device__ bool next(int i, Unit& u) const {
        const long L = (long)i * G + c; if (L >= nwg) return false;
        int wgid = (int)L; { const int q = nwg / NXCD, r = nwg % NXCD, xcd = wgid % NXCD, off = wgid / NXCD; wgid = (xcd < r ? xcd * (q + 1) : r * (q + 1) + (xcd - r) * q) + off; }
        const int nig = WGM * nN, gid = wgid / nig, fm = gid * WGM, gsz = (nM - fm) < WGM ? (nM - fm) : WGM;
        u.pm = fm + ((wgid % nig) % gsz); u.pn = (wgid % nig) / gsz; u.ko = 0; return true;
    }
    __device__ __forceinline__ void a_ready(const Unit&) const {}
    __device__ __forceinline__ void done(const Unit&) const {}
};

__device__ __forceinline__ unsigned cvt_pk_bf16(float lo, float hi) { unsigned r; asm volatile("v_cvt_pk_bf16_f32 %0, %1, %2" : "=v"(r) : "v"(lo), "v"(hi)); return r; }
typedef float f32x2 __attribute__((ext_vector_type(2)));
struct NoPre {};
struct EpiF32 {
    static constexpr bool PERM = false, AFTER_DRAIN = false;
    float* C; int ldc;
    typedef NoPre Pre; __device__ __forceinline__ void pre(Pre&, const Unit&, int, int, int, int) const {}
    __device__ __forceinline__ void operator()(const f32x4 (&acc)[2][2][4][2], const Unit& u, int wr, int wc, int fr, int fq, const Pre&) const {
        const int row0 = u.pm * BM + wr * 64 + fr, col0 = u.pn * BM + wc * 32 + 4 * fq;
#pragma unroll
        for (int ai = 0; ai < 2; ++ai)
#pragma unroll
            for (int m = 0; m < 4; ++m) { float* rowp = C + (size_t)(row0 + ai * HALF + m * 16) * ldc + col0;
#pragma unroll
                for (int bj = 0; bj < 2; ++bj)
#pragma unroll
                    for (int n = 0; n < 2; ++n) *(f32x4*)(rowp + bj * HALF + n * 16) = acc[ai][bj][m][n]; }
    }
};
struct EpiHRes {
    static constexpr bool PERM = false, AFTER_DRAIN = false;
    const bf16_t* xb; float* out; bf16_t* hb; float* ssq; int mp;
    typedef NoPre Pre; __device__ __forceinline__ void pre(Pre&, const Unit&, int, int, int, int) const {}
    __device__ __forceinline__ void operator()(const f32x4 (&acc)[2][2][4][2], const Unit& u, int wr, int wc, int fr, int fq, const Pre&) const {
        const int row0 = u.pm * BM + wr * 64 + fr, col0 = u.pn * BM + wc * 32 + 4 * fq;
        unsigned long long xw_[2][4][2][2];
#pragma unroll
        for (int ai = 0; ai < 2; ++ai)
#pragma unroll
            for (int m = 0; m < 4; ++m) { const bf16_t* xrow = xb + (size_t)(row0 + ai * HALF + m * 16) * 1024 + col0;
#pragma unroll
                for (int bj = 0; bj < 2; ++bj)
#pragma unroll
                    for (int n = 0; n < 2; ++n) xw_[ai][m][bj][n] = *(const unsigned long long*)(xrow + bj * HALF + n * 16); }
#pragma unroll
        for (int ai = 0; ai < 2; ++ai)
#pragma unroll
            for (int m = 0; m < 4; ++m) {
                const int row = row0 + ai * HALF + m * 16;
                float* orow = out + (size_t)row * 1024 + col0; bf16_t* hrow = hb + (size_t)row * 1024 + col0;
                float s = 0.f;
#pragma unroll
                for (int bj = 0; bj < 2; ++bj)
#pragma unroll
                    for (int n = 0; n < 2; ++n) {
                        const unsigned long long xw = xw_[ai][m][bj][n]; const unsigned xlo = (unsigned)xw, xhi = (unsigned)(xw >> 32);
                        f32x4 xv; xv[0] = __builtin_bit_cast(float, xlo << 16); xv[1] = __builtin_bit_cast(float, xlo & 0xffff0000u); xv[2] = __builtin_bit_cast(float, xhi << 16); xv[3] = __builtin_bit_cast(float, xhi & 0xffff0000u);
                        const f32x4 h = acc[ai][bj][m][n] + xv;
                        if (row >= mp) *(f32x4*)(orow + bj * HALF + n * 16) = h;
                        unsigned long long w = (unsigned long long)cvt_pk_bf16(h[0], h[1]) | ((unsigned long long)cvt_pk_bf16(h[2], h[3]) << 32);
                        *(unsigned long long*)(hrow + bj * HALF + n * 16) = w;
                        s += (h[0] * h[0] + h[1] * h[1]) + (h[2] * h[2] + h[3] * h[3]);
                    }
                s += __shfl_xor(s, 16); s += __shfl_xor(s, 32);
                if (fq == 0) atomicAdd(ssq + row, s);
            }
    }
};
struct EpiRelu2 {
    static constexpr bool PERM = true, AFTER_DRAIN = false;
    bf16_t* O; int ldc; const float* ssq;
    struct Pre { float s[8]; };
    __device__ __forceinline__ void pre(Pre& P_, const Unit& u, int wr, int wc, int fr, int fq) const {
        const int row0 = u.pm * BM + wr * 64 + fr;
#pragma unroll
        for (int ai = 0; ai < 2; ++ai)
#pragma unroll
            for (int m = 0; m < 4; ++m) P_.s[ai * 4 + m] = ssq[row0 + ai * HALF + m * 16];
    }
    __device__ __forceinline__ void operator()(const f32x4 (&acc)[2][2][4][2], const Unit& u, int wr, int wc, int fr, int fq, const Pre& P_) const {
        const int row0 = u.pm * BM + wr * 64 + fr, col0 = u.pn * BM + wc * 32 + 8 * fq;
#pragma unroll
        for (int ai = 0; ai < 2; ++ai)
#pragma unroll
            for (int m = 0; m < 4; ++m) {
                const int row = row0 + ai * HALF + m * 16;
                const float rs = __builtin_amdgcn_rsqf(P_.s[ai * 4 + m] * (1.0f / 1024.0f) + 1e-6f);
                bf16_t* rowp = O + (size_t)row * ldc + col0;
#pragma unroll
                for (int bj = 0; bj < 2; ++bj) {
                    f32x4 v0 = acc[ai][bj][m][0] * rs, v1 = acc[ai][bj][m][1] * rs;
#pragma unroll
                    for (int j = 0; j < 4; ++j) { const float a = fmaxf(v0[j], 0.f), b = fmaxf(v1[j], 0.f); v0[j] = a * a; v1[j] = b * b; }
                    u32x4 w; w.x = cvt_pk_bf16(v0[0], v0[1]); w.y = cvt_pk_bf16(v0[2], v0[3]); w.z = cvt_pk_bf16(v1[0], v1[1]); w.w = cvt_pk_bf16(v1[2], v1[3]);
                    *(u32x4*)(rowp + bj * HALF) = w;
                }
            }
    }
};
struct EpiAddOut {
    static constexpr bool PERM = false, AFTER_DRAIN = false;
    float* C; int ldc;
    typedef NoPre Pre; __device__ __forceinline__ void pre(Pre&, const Unit&, int, int, int, int) const {}
    __device__ __forceinline__ void operator()(const f32x4 (&acc)[2][2][4][2], const Unit& u, int wr, int wc, int fr, int fq, const Pre&) const {
        const int row0 = u.pm * BM + wr * 64 + fr, col0 = u.pn * BM + wc * 32 + 4 * fq;
#pragma unroll
        for (int ai = 0; ai < 2; ++ai)
#pragma unroll
            for (int m = 0; m < 4; ++m) { float* rowp = C + (size_t)(row0 + ai * HALF + m * 16) * ldc + col0;
#pragma unroll
                for (int bj = 0; bj < 2; ++bj)
#pragma unroll
                    for (int n = 0; n < 2; ++n) { f32x4* p = (f32x4*)(rowp + bj * HALF + n * 16); *p = *p + acc[ai][bj][m][n]; } }
    }
};
struct EpiProj {
    static constexpr bool PERM = true, AFTER_DRAIN = false;
    bf16_t* QKV; size_t qkv_stride;
    bf16_t* PB;
    float* QS;
    float* out; const float* gq; const float* gk; const float* rstd;
    struct Pre { float s[8]; };
    __device__ __forceinline__ void pre(Pre& P_, const Unit& u, int wr, int wc, int fr, int fq) const {
        const int row0 = u.pm * BM + wr * 64 + fr;
#pragma unroll
        for (int ai = 0; ai < 2; ++ai)
#pragma unroll
            for (int m = 0; m < 4; ++m) P_.s[ai * 4 + m] = rstd[row0 + ai * HALF + m * 16];
    }
    __device__ __forceinline__ void operator()(const f32x4 (&acc)[2][2][4][2], const Unit& u, int wr, int wc, int fr, int fq, const Pre& P_) const {
        const int pn = u.pn, pm = u.pm;
        if (pn < 6) {
            const int region = pn >> 1, h = (pn & 1) * 4 + wc;
            f32x4 gv[2][2];
#pragma unroll
            for (int bj = 0; bj < 2; ++bj)
#pragma unroll
                for (int n = 0; n < 2; ++n) gv[bj][n] = (region == 2) ? (f32x4){1.f, 1.f, 1.f, 1.f} : *(const f32x4*)((region == 0 ? gq : gk) + 32 * bj + 8 * fq + 4 * n);
#pragma unroll
            for (int ai = 0; ai < 2; ++ai)
#pragma unroll
                for (int m = 0; m < 4; ++m) {
                    const int row = pm * BM + ai * HALF + wr * 64 + m * 16 + fr;
                    f32x4 v[2][2]; const float rs1 = P_.s[ai * 4 + m];
#pragma unroll
                    for (int bj = 0; bj < 2; ++bj)
#pragma unroll
                        for (int n = 0; n < 2; ++n) v[bj][n] = acc[ai][bj][m][n] * rs1;
                    if (region < 2) {
                        float ss = 0.f;
#pragma unroll
                        for (int bj = 0; bj < 2; ++bj)
#pragma unroll
                            for (int n = 0; n < 2; ++n) ss += (v[bj][n][0] * v[bj][n][0] + v[bj][n][1] * v[bj][n][1]) + (v[bj][n][2] * v[bj][n][2] + v[bj][n][3] * v[bj][n][3]);
                        ss += __shfl_xor(ss, 16); ss += __shfl_xor(ss, 32);
                        const float rs = 1.0f / sqrtf(ss * (1.0f / 64.0f) + 1e-6f);
#pragma unroll
                        for (int bj = 0; bj < 2; ++bj)
#pragma unroll
                            for (int n = 0; n < 2; ++n) v[bj][n] = v[bj][n] * rs * gv[bj][n];
                    }
                    if (pm < 256) {
                        const int b = row >> 13, t = row & 8191;
                        bf16_t* dst = QKV + (size_t)region * qkv_stride + ((size_t)(b * 8 + h) * 8192 + t) * 64 + 8 * fq;
                        const float sc = (region == 0) ? 0.18033688011112042f : 1.0f;
#pragma unroll
                        for (int bj = 0; bj < 2; ++bj) { const f32x4 a = v[bj][0] * sc, c = v[bj][1] * sc;
                            u32x4 w; w.x = cvt_pk_bf16(a[0], a[1]); w.y = cvt_pk_bf16(a[2], a[3]); w.z = cvt_pk_bf16(c[0], c[1]); w.w = cvt_pk_bf16(c[2], c[3]);
                            *(u32x4*)(dst + 32 * bj) = w; }
                        if (region > 0 && t >= 6144) {
                            float* od = out + (region == 1 ? (size_t)68157440 : (size_t)76546048) + ((size_t)(b * 2048 + (t - 6144)) * 8 + h) * 64 + 8 * fq;
#pragma unroll
                            for (int bj = 0; bj < 2; ++bj) { *(f32x4*)(od + 32 * bj) = v[bj][0]; *(f32x4*)(od + 32 * bj + 4) = v[bj][1]; }
                        }
                    } else {
                        const int rs_ = row - 65536;
                        float* od = (region == 0) ? QS + (size_t)rs_ * 512 + h * 64 + 8 * fq : out + (region == 1 ? (size_t)85211392 : (size_t)85735680) + ((size_t)rs_ * 8 + h) * 64 + 8 * fq;
#pragma unroll
                        for (int bj = 0; bj < 2; ++bj) { *(f32x4*)(od + 32 * bj) = v[bj][0]; *(f32x4*)(od + 32 * bj + 4) = v[bj][1]; }
                    }
                }
        } else {
            const int col0 = (pn - 6) * 256 + wc * 32 + 8 * fq;
#pragma unroll
            for (int ai = 0; ai < 2; ++ai)
#pragma unroll
                for (int m = 0; m < 4; ++m) {
                    const int row = pm * BM + ai * HALF + wr * 64 + m * 16 + fr;
                    bf16_t* dst = PB + (size_t)row * 2048 + col0;
                    float* sd = nullptr;
                    if (pm < 256) { if ((row & 8191) == 8191) sd = out + (size_t)85196800 + (size_t)(row >> 13) * 1824; }
                    else { const int rs_ = row - 65536; if ((rs_ & 7) == 7) sd = out + (size_t)90454272 + (size_t)(rs_ >> 3) * 1824; }
                    const float rs1 = P_.s[ai * 4 + m];
#pragma unroll
                    for (int bj = 0; bj < 2; ++bj) { const f32x4 a = acc[ai][bj][m][0] * rs1, c = acc[ai][bj][m][1] * rs1;
                        u32x4 w; w.x = cvt_pk_bf16(a[0], a[1]); w.y = cvt_pk_bf16(a[2], a[3]); w.z = cvt_pk_bf16(c[0], c[1]); w.w = cvt_pk_bf16(c[2], c[3]);
                        const int cc = col0 + 128 * bj;
                        if (cc < 1824) *(u32x4*)(dst + 128 * bj) = w;
                        if (sd && cc < 1824) { *(f32x4*)(sd + cc) = a; *(f32x4*)(sd + cc + 4) = c; } }
                }
        }
    }
};

struct EpiAddH {
    static constexpr bool PERM = false, AFTER_DRAIN = false;
    float* C; const bf16_t* hb; int ldc;
    typedef NoPre Pre; __device__ __forceinline__ void pre(Pre&, const Unit&, int, int, int, int) const {}
    __device__ __forceinline__ void operator()(const f32x4 (&acc)[2][2][4][2], const Unit& u, int wr, int wc, int fr, int fq, const Pre&) const {
        const int row0 = u.pm * BM + wr * 64 + fr, col0 = u.pn * BM + wc * 32 + 4 * fq;
        unsigned long long hw[2][4][2][2];
#pragma unroll
        for (int ai = 0; ai < 2; ++ai)
#pragma unroll
            for (int m = 0; m < 4; ++m) { const size_t ro = (size_t)(row0 + ai * HALF + m * 16) * ldc + col0;
#pragma unroll
                for (int bj = 0; bj < 2; ++bj)
#pragma unroll
                    for (int n = 0; n < 2; ++n) hw[ai][m][bj][n] = *(const unsigned long long*)(hb + ro + bj * HALF + n * 16); }
#pragma unroll
        for (int ai = 0; ai < 2; ++ai)
#pragma unroll
            for (int m = 0; m < 4; ++m) { const size_t ro = (size_t)(row0 + ai * HALF + m * 16) * ldc + col0;
#pragma unroll
                for (int bj = 0; bj < 2; ++bj)
#pragma unroll
                    for (int n = 0; n < 2; ++n) { const unsigned lo = (unsigned)hw[ai][m][bj][n], hi = (unsigned)(hw[ai][m][bj][n] >> 32);
                        f32x4 h; h[0] = __builtin_bit_cast(float, lo << 16); h[1] = __builtin_bit_cast(float, lo & 0xffff0000u); h[2] = __builtin_bit_cast(float, hi << 16); h[3] = __builtin_bit_cast(float, hi & 0xffff0000u);
                        *(f32x4*)(C + ro + bj * HALF + n * 16) = h + acc[ai][bj][m][n]; } }
    }
};
template <int SPLIT, int KFULL> struct SplitKOrder {
    int G, c;
    __host__ __device__ bool next(int i, Unit& u) const { const int L = i * G + c; if (L >= 16 * SPLIT) return false; const int ks = L % SPLIT, tile = L / SPLIT; u.pm = 256 + (tile >> 2); u.pn = tile & 3; u.ko = ks * (KFULL / SPLIT); return true; }
    __device__ __forceinline__ void a_ready(const Unit&) const {}
    __device__ __forceinline__ void done(const Unit&) const {}
};
struct EpiAtomicAdd {
    static constexpr bool PERM = false, AFTER_DRAIN = false;
    float* C; int ldc;
    typedef NoPre Pre; __device__ __forceinline__ void pre(Pre&, const Unit&, int, int, int, int) const {}
    __device__ __forceinline__ void operator()(const f32x4 (&acc)[2][2][4][2], const Unit& u, int wr, int wc, int fr, int fq, const Pre&) const {
        const int row0 = u.pm * BM + wr * 64 + fr, col0 = u.pn * BM + wc * 32 + 4 * fq;
#pragma unroll
        for (int ai = 0; ai < 2; ++ai)
#pragma unroll
            for (int m = 0; m < 4; ++m) { float* rowp = C + (size_t)(row0 + ai * HALF + m * 16) * ldc + col0;
#pragma unroll
                for (int bj = 0; bj < 2; ++bj)
#pragma unroll
                    for (int n = 0; n < 2; ++n) { float* p = rowp + bj * HALF + n * 16;
#pragma unroll
                        for (int j = 0; j < 4; ++j) unsafeAtomicAdd(p + j, acc[ai][bj][m][n][j]); } }
    }
};

template <class Epi, class Sched, bool ALIGN_EPI = false, bool SP2 = false>
__device__ __forceinline__ void gemm_phase(PG8_LAS unsigned char* lds, const Gemm g, const Sched& S, const Epi& E) {
    const int tid = threadIdx.x, wid = __builtin_amdgcn_readfirstlane(tid >> 6), lane = tid & 63, wr = wid >> 2, wc = wid & 3, fr = lane & 15, fq = lane >> 4;
    const int K = g.K, nt = K / BK, LD = g.ld ? g.ld : g.K;
    unsigned voffA[2], voffB[2];
#pragma unroll
    for (int i = 0; i < 2; ++i) { int R, C; stage_rc(tid * 16 + i * 8192, R, C); const int Rb = Epi::PERM ? ((R & ~31) + perm32(R & 31)) : R;
        voffA[i] = (unsigned)(R * LD + C) * 2u; voffB[i] = (unsigned)(Rb * LD + C) * 2u; }
    const size_t kstep = (size_t)(BK * 2);
    const size_t hstep = (size_t)HALF * LD * 2;
    const size_t tstep = 2 * hstep;
    const unsigned ldsw = (unsigned)wid * 1024u;
    const int aoff = lds_byte(wr * 64 + fr, fq * 8), boff = lds_byte(wc * 32 + fr, fq * 8);
#define PG8_SA(b, h) (((b) * 2 + (h)) * HTB)
#define PG8_SB(b, h) ((4 + (b) * 2 + (h)) * HTB)
#define PG8_STAGE(bufoff, gbase, voff) do { _Pragma("unroll") for (int _i = 0; _i < 2; ++_i) \
        __builtin_amdgcn_global_load_lds((const unsigned*)((const char*)(gbase) + (voff)[_i]), (PG8_LAS unsigned*)(lds + (bufoff) + ldsw + _i * 8192), 16, 0, 0); } while (0)
#define PG8_LDA(dst, b, h) do { _Pragma("unroll") for (int m = 0; m < 4; ++m) _Pragma("unroll") for (int k = 0; k < 2; ++k) dst[m][k] = *(const PG8_LAS bf16x8*)(lds + PG8_SA(b, h) + aoff + m * 2048 + k * 1024); } while (0)
#define PG8_LDB(dst, b, h) do { _Pragma("unroll") for (int n = 0; n < 2; ++n) _Pragma("unroll") for (int k = 0; k < 2; ++k) dst[n][k] = *(const PG8_LAS bf16x8*)(lds + PG8_SB(b, h) + boff + n * 2048 + k * 1024); } while (0)
#define PG8_MMA(ai, bj, At, Bt) do { __builtin_amdgcn_s_setprio(1); _Pragma("unroll") for (int m = 0; m < 4; ++m) _Pragma("unroll") for (int n = 0; n < 2; ++n) _Pragma("unroll") for (int k = 0; k < 2; ++k) \
        acc[ai][bj][m][n] = __builtin_amdgcn_mfma_f32_16x16x32_bf16(Bt[n][k], At[m][k], acc[ai][bj][m][n], 0, 0, 0); __builtin_amdgcn_s_setprio(0); } while (0)
#define PG8_WAIT_V(n) asm volatile("s_waitcnt vmcnt(" #n ")" ::: "memory")
#define PG8_WAIT_L(n) asm volatile("s_waitcnt lgkmcnt(" #n ")" ::: "memory")
#define PG8_BAR __builtin_amdgcn_s_barrier()
#define PG8_SCHED __builtin_amdgcn_sched_barrier(0)
    Unit cur, nxt; int ui = 0;
    if (!S.next(0, cur)) return;
    f32x4 acc[2][2][4][2];
    typename Epi::Pre epre;
#pragma unroll
    for (int a = 0; a < 2; ++a)
#pragma unroll
        for (int b = 0; b < 2; ++b)
#pragma unroll
            for (int m = 0; m < 4; ++m)
#pragma unroll
                for (int n = 0; n < 2; ++n) acc[a][b][m][n] = (f32x4){0.f, 0.f, 0.f, 0.f};
    bf16x8 At[4][2], B0[2][2], B1[2][2];
    const char* cA = (const char*)g.A + (size_t)cur.pm * tstep + (size_t)cur.ko * 2; const char* cB = (const char*)g.Bt + (size_t)cur.pn * tstep + (size_t)cur.ko * 2;
    S.a_ready(cur);
    if constexpr (SP2) {
        PG8_STAGE(PG8_SB(0, 0), cB, voffB); PG8_STAGE(PG8_SB(0, 1), cB + hstep, voffB); PG8_STAGE(PG8_SA(0, 0), cA, voffA); PG8_STAGE(PG8_SA(0, 1), cA + hstep, voffA);
        if (wr == 1) PG8_BAR;
        PG8_WAIT_V(2); PG8_BAR;
        PG8_STAGE(PG8_SB(1, 0), cB + kstep, voffB); PG8_STAGE(PG8_SA(1, 0), cA + kstep, voffA); PG8_STAGE(PG8_SB(1, 1), cB + hstep + kstep, voffB);
        PG8_WAIT_V(6); PG8_BAR;
    } else {
        PG8_STAGE(PG8_SB(0, 0), cB, voffB); PG8_STAGE(PG8_SA(0, 0), cA, voffA); PG8_STAGE(PG8_SB(0, 1), cB + hstep, voffB); PG8_STAGE(PG8_SA(0, 1), cA + hstep, voffA);
        if (wr == 1) PG8_BAR;
        PG8_WAIT_V(4); PG8_BAR;
        PG8_STAGE(PG8_SB(1, 0), cB + kstep, voffB); PG8_STAGE(PG8_SA(1, 0), cA + kstep, voffA); PG8_STAGE(PG8_SB(1, 1), cB + hstep + kstep, voffB);
        PG8_WAIT_V(6); PG8_BAR;
    }
    for (;;) {
        const bool has_next = S.next(ui + 1, nxt);
        const char* nA = has_next ? (const char*)g.A + (size_t)nxt.pm * tstep + (size_t)nxt.ko * 2 : cA; const char* nB = has_next ? (const char*)g.Bt + (size_t)nxt.pn * tstep + (size_t)nxt.ko * 2 : cB;
        for (int t = 0; t < nt; t += 2) {
            const bool last = (t == nt - 2);
            const char* a1 = cA + (size_t)(t + 1) * kstep;
            const char* a2 = last ? nA : cA + (size_t)(t + 2) * kstep; const char* b2 = last ? nB : cB + (size_t)(t + 2) * kstep;
            const char* a3 = a2 + kstep; const char* b3 = b2 + kstep;
            if (last && has_next) S.a_ready(nxt);
            if (last) E.pre(epre, cur, wr, wc, fr, fq);
            if constexpr (SP2) {
            PG8_LDB(B0, 0, 0); PG8_LDB(B1, 0, 1); PG8_SCHED; PG8_LDA(At, 0, 0); PG8_STAGE(PG8_SA(1, 1), a1 + hstep, voffA);
            PG8_WAIT_V(8); PG8_WAIT_L(0); PG8_BAR; PG8_MMA(0, 0, At, B0); PG8_MMA(0, 1, At, B1); PG8_BAR; PG8_SCHED;
            PG8_LDA(At, 0, 1); PG8_STAGE(PG8_SB(0, 0), b2, voffB); PG8_STAGE(PG8_SB(0, 1), b2 + hstep, voffB); PG8_STAGE(PG8_SA(0, 0), a2, voffA);
            PG8_WAIT_V(8); PG8_WAIT_L(0); PG8_BAR; PG8_MMA(1, 0, At, B0); PG8_MMA(1, 1, At, B1); PG8_BAR; PG8_SCHED;
            PG8_LDB(B0, 1, 0); PG8_LDB(B1, 1, 1); PG8_SCHED; PG8_LDA(At, 1, 0); PG8_STAGE(PG8_SA(0, 1), a2 + hstep, voffA);
            PG8_WAIT_V(8); PG8_WAIT_L(0); PG8_BAR; PG8_MMA(0, 0, At, B0); PG8_MMA(0, 1, At, B1); PG8_BAR; PG8_SCHED;
            PG8_LDA(At, 1, 1); PG8_STAGE(PG8_SB(1, 0), b3, voffB); PG8_STAGE(PG8_SB(1, 1), b3 + hstep, voffB); PG8_STAGE(PG8_SA(1, 0), a3, voffA);
            PG8_WAIT_V(8); PG8_WAIT_L(0); PG8_BAR; PG8_MMA(1, 0, At, B0); PG8_MMA(1, 1, At, B1); PG8_BAR; PG8_SCHED;
            } else {
            PG8_LDB(B0, 0, 0); PG8_SCHED; PG8_LDA(At, 0, 0); PG8_STAGE(PG8_SA(1, 1), a1 + hstep, voffA);
            PG8_WAIT_L(8); PG8_BAR; PG8_WAIT_L(0); PG8_MMA(0, 0, At, B0); PG8_BAR; PG8_SCHED;
            PG8_LDB(B1, 0, 1); PG8_STAGE(PG8_SB(0, 0), b2, voffB);
            PG8_BAR; PG8_WAIT_L(0); PG8_MMA(0, 1, At, B1); PG8_BAR;
            PG8_LDA(At, 0, 1); PG8_STAGE(PG8_SA(0, 0), a2, voffA);
            PG8_BAR; PG8_WAIT_L(0); PG8_MMA(1, 0, At, B0); PG8_BAR; PG8_SCHED;
            PG8_STAGE(PG8_SB(0, 1), b2 + hstep, voffB);
            PG8_WAIT_V(6); PG8_BAR; PG8_MMA(1, 1, At, B1); PG8_BAR;
            PG8_LDB(B0, 1, 0); PG8_SCHED; PG8_LDA(At, 1, 0); PG8_STAGE(PG8_SA(0, 1), a2 + hstep, voffA);
            PG8_WAIT_L(8); PG8_BAR; PG8_WAIT_L(0); PG8_MMA(0, 0, At, B0); PG8_BAR; PG8_SCHED;
            PG8_LDB(B1, 1, 1); PG8_STAGE(PG8_SB(1, 0), b3, voffB);
            PG8_BAR; PG8_WAIT_L(0); PG8_MMA(0, 1, At, B1); PG8_BAR;
            PG8_LDA(At, 1, 1); PG8_STAGE(PG8_SA(1, 0), a3, voffA);
            PG8_BAR; PG8_WAIT_L(0); PG8_MMA(1, 0, At, B0); PG8_BAR; PG8_SCHED;
            PG8_STAGE(PG8_SB(1, 1), b3 + hstep, voffB);
            PG8_WAIT_V(6); PG8_BAR; PG8_MMA(1, 1, At, B1); PG8_BAR;
            }
        }
        if constexpr (ALIGN_EPI) { if (wr == 0) PG8_BAR; }
        if constexpr (!Epi::AFTER_DRAIN) { E(acc, cur, wr, wc, fr, fq, epre); S.done(cur); }
        if (!has_next) break;
#pragma unroll
        for (int a = 0; a < 2; ++a)
#pragma unroll
            for (int b = 0; b < 2; ++b)
#pragma unroll
                for (int m = 0; m < 4; ++m)
#pragma unroll
                    for (int n = 0; n < 2; ++n) acc[a][b][m][n] = (f32x4){0.f, 0.f, 0.f, 0.f};
        cur = nxt; cA = nA; cB = nB; ++ui;
        if constexpr (ALIGN_EPI) { if (wr == 1) PG8_BAR; }
    }
    PG8_WAIT_V(0);
    if constexpr (!ALIGN_EPI) { if (wr == 0) PG8_BAR; }
    PG8_BAR;
    if constexpr (Epi::AFTER_DRAIN) { E.fused(acc, cur, wr, wc, fr, fq, lds, wid, lane); S.done(cur); }
#undef PG8_SA
#undef PG8_SB
#undef PG8_STAGE
#undef PG8_LDA
#undef PG8_LDB
#undef PG8_MMA
#undef PG8_WAIT_V
#undef PG8_WAIT_L
#undef PG8_BAR
#undef PG8_SCHED
}
}
#define GAS __attribute__((address_space(1)))
#define LAS __attribute__((address_space(3)))
typedef unsigned short bf16;
typedef unsigned v4u __attribute__((ext_vector_type(4)));
typedef float f32x4 __attribute__((ext_vector_type(4)));
typedef short bf16x8 __attribute__((ext_vector_type(8)));
typedef GAS unsigned gu32;
typedef GAS unsigned long long gu64;
#define RLX_AGENT __ATOMIC_RELAXED, __HIP_MEMORY_SCOPE_AGENT
#define LDS_WAIT() asm volatile("s_waitcnt lgkmcnt(0)" ::: "memory")
#define VM_WAIT() asm volatile("s_waitcnt vmcnt(0)" ::: "memory")
__device__ __forceinline__ unsigned long long rt() { return __builtin_amdgcn_s_memrealtime(); }
__device__ __forceinline__ unsigned f2bf(float f) { unsigned u = __builtin_bit_cast(unsigned, f); return (u + 0x7fffu + ((u >> 16) & 1u)) >> 16; }
__device__ __forceinline__ unsigned pk2(float lo, float hi) { return f2bf(lo) | (f2bf(hi) << 16); }

#define XB_TMO      128
#define XB_XCNT(j)  (256  + 64 * (j))
#define XB_XSUB(j)  (1280 + 64 * (j))
#define XB_XGEN(j)  (2304 + 64 * (j))
#define XB_TOP      3328
#define XB_TOPGEN   3392
#define XCD_BAR_WORDS 3456
#define XB_SPIN_CAP (1u << 18)

__device__ __forceinline__ unsigned xb_ld(unsigned* p)              { return __hip_atomic_load(p, __ATOMIC_RELAXED, __HIP_MEMORY_SCOPE_AGENT); }
__device__ __forceinline__ unsigned xb_add(unsigned* p, unsigned v) { return __hip_atomic_fetch_add(p, v, __ATOMIC_RELAXED, __HIP_MEMORY_SCOPE_AGENT); }
__device__ __forceinline__ unsigned xb_xcc_id() { return (unsigned)__builtin_amdgcn_s_getreg((3 << 11) | 20) & 0xFu; }
#define XB_SPIN(cond, bar) do { unsigned _sp = 0; while (cond) { __builtin_amdgcn_s_sleep(1); \
    if ((++_sp & 255u) == 0u) { if (xb_ld(&(bar)[XB_TMO])) break; if (_sp > XB_SPIN_CAP) { atomicAdd(&(bar)[XB_TMO], 1u); break; } } } } while (0)

struct XcdBarrier {
    unsigned* bar; unsigned x;
    volatile LAS unsigned* st;
};

__device__ __forceinline__ XcdBarrier xcd_barrier_post(unsigned* bar, volatile LAS unsigned* st) {
    XcdBarrier b; b.bar = bar; b.x = xb_xcc_id(); b.st = st;
    if (threadIdx.x == 0) (void)xb_add(&bar[XB_XCNT(b.x)], 1u);
    return b;
}
__device__ __forceinline__ void xcd_barrier_complete(unsigned* bar, unsigned x, unsigned& nloc, unsigned& nx) {
    const unsigned G = gridDim.x * gridDim.y * gridDim.z;
    unsigned sum, cnt, mine, sp = 0u;
    for (;;) {
        sum = 0u; cnt = 0u; mine = 0u;
#pragma unroll
        for (unsigned j = 0; j < 16; ++j) { const unsigned c = xb_ld(&bar[XB_XCNT(j)]); sum += c; cnt += (c > 0u) ? 1u : 0u; mine = (j == x) ? c : mine; }
        if (sum == G) break;
        __builtin_amdgcn_s_sleep(1);
        if ((++sp & 255u) == 0u) { if (xb_ld(&bar[XB_TMO])) break; if (sp > XB_SPIN_CAP) { atomicAdd(&bar[XB_TMO], 1u); break; } }
    }
    nloc = mine > 0u ? mine : 1u; nx = cnt > 0u ? cnt : 1u;
}

__device__ __forceinline__ void xcd_barrier(const XcdBarrier& b) {
    asm volatile("s_waitcnt vmcnt(0)" ::: "memory");
    __syncthreads();
    if (threadIdx.x == 0) {
        unsigned* bar = b.bar;
        __builtin_amdgcn_s_waitcnt(0);
        unsigned nloc = b.st[0], nx = b.st[1];
        if (nloc == 0u) { xcd_barrier_complete(bar, b.x, nloc, nx); b.st[0] = nloc; b.st[1] = nx; }
        const unsigned old = xb_add(&bar[XB_XSUB(b.x)], 1u);
        const unsigned gen = old / nloc;
        if (old + 1u == (gen + 1u) * nloc) {
            __builtin_amdgcn_fence(__ATOMIC_RELEASE, "agent");
            asm volatile("s_waitcnt vmcnt(0)" ::: "memory");
            const unsigned og = xb_add(&bar[XB_TOP], 1u);
            const unsigned tg = og / nx;
            if (og + 1u == (tg + 1u) * nx) xb_add(&bar[XB_TOPGEN], 1u);
            else XB_SPIN(xb_ld(&bar[XB_TOPGEN]) == tg, bar);
            __builtin_amdgcn_fence(__ATOMIC_ACQUIRE, "agent");
            xb_add(&bar[XB_XGEN(b.x)], 1u);
            asm volatile("s_waitcnt vmcnt(0)" ::: "memory");
        } else {
            XB_SPIN(xb_ld(&bar[XB_XGEN(b.x)]) == gen, bar);
            __builtin_amdgcn_fence(__ATOMIC_ACQUIRE, "agent");
            asm volatile("s_waitcnt vmcnt(0)" ::: "memory");
        }
    }
    __syncthreads();
}
constexpr int NWAVES = 8, NTHR = 512;
constexpr int D = 1024, BATCH = 8, SEQ = 8192, MP = BATCH * SEQ, SBATCH = 128, STOK = 8, MS = SBATCH * STOK, M = MP + MS;
constexpr int AW = 512, HD = 64, NH = 8, NSHIFT = 1824, NIN = 3360, NINP = 3584, FF = 4096, LWIN = 2048;
constexpr int C_Q = 0, C_K = 512, C_V = 1024, C_P = 1536;
constexpr float RMS_EPS = 1e-6f, GN_EPS = 64e-5f;
constexpr size_t O_YP = 0, O_YS = 67108864, O_KWP = 68157440, O_VWP = 76546048, O_WKVP = 84934656, O_SHP = 85196800, O_KNS = 85211392, O_VNS = 85735680, O_WKVS = 86259968, O_SHS = 90454272, O_END = 90687744;
constexpr size_t MiB = 1u << 20;
constexpr size_t WS_CTL = 0, CTL_ZERO_BYTES = 1 * MiB;
constexpr size_t WS_SSQ = 256 * 1024;
constexpr size_t WS_WIN = 2 * MiB, WS_WO = 10 * MiB, WS_W1 = 12 * MiB, WS_W2 = 20 * MiB, WS_QS = 28 * MiB;
constexpr size_t WS_XN = 32 * MiB;
constexpr size_t WS_MIX = 1200 * MiB;
constexpr size_t WS_RSTD = 576 * 1024;
constexpr size_t WS_QB = 162 * MiB, WS_KB = 226 * MiB, WS_VB = 290 * MiB;
constexpr size_t WS_PB = 354 * MiB;
constexpr size_t WS_LORA = 30 * MiB;
constexpr size_t WS_RW = 614 * MiB;
constexpr size_t RW_STRIDE = 2 * MiB;
constexpr size_t WS_LIN = 1156 * MiB;
constexpr size_t WS_PT = 640 * MiB, WS_RP = 704 * MiB, WS_QM = 768 * MiB, WS_Y0 = 896 * MiB, WS_GC = 1024 * MiB, WS_G2 = 1028 * MiB, WS_BV = 1092 * MiB;
constexpr size_t WS_HBF = 1524 * MiB;
constexpr size_t WS_HB = 162 * MiB;
constexpr size_t WS_END = 1654 * MiB;
static_assert(WS_SSQ + (size_t)M * 4 <= WS_RSTD && WS_RSTD + (size_t)M * 4 <= CTL_ZERO_BYTES && WS_LIN + (size_t)MP * 288 * 2 <= WS_MIX && WS_MIX + (size_t)M * 1024 * 2 <= WS_HBF && WS_XN + (size_t)M * 1024 * 2 <= WS_QB && WS_PB + (size_t)M * 2048 * 2 <= WS_RW && (size_t)MS * 512 * 4 <= RW_STRIDE && WS_RW + 7 * RW_STRIDE <= WS_PT && WS_LIN + (size_t)MP * 288 * 2 <= WS_HBF && WS_HB + (size_t)M * FF * 2 <= WS_HBF && WS_END <= 2048 * MiB, "ws map");
constexpr int CW_TMO = 0, CW_BAR = 4096;
constexpr int RING_OFF = 0, RING_BYTES = 131072, LDSCTL_OFF = RING_BYTES, MISC_OFF = LDSCTL_OFF + 320, LDS_BYTES = 147456;

struct Args { const float* in[26]; float* out; unsigned char* ws; int ph_lo, ph_hi, pad0, pad1; };

struct Frame {
    LAS unsigned char* lds; volatile LAS unsigned* MISC; gu32* ctl;
    int tid, lane, wave, vcu, G;
};
__device__ __forceinline__ float wave_sum(float v) {
#pragma unroll
    for (int o = 1; o < 64; o <<= 1) v += __shfl_xor(v, o);
    return v;
}
typedef float f32x2_c __attribute__((ext_vector_type(2))); typedef __bf16 bf16x2_c __attribute__((ext_vector_type(2)));
__device__ __forceinline__ unsigned cvt2(float lo, float hi) { const f32x2_c v = {lo, hi}; const bf16x2_c b = __builtin_convertvector(v, bf16x2_c); return __builtin_bit_cast(unsigned, b); }
__device__ __forceinline__ float wave_max(float v) {
#pragma unroll
    for (int o = 1; o < 64; o <<= 1) v = fmaxf(v, __shfl_xor(v, o));
    return v;
}
__device__ __forceinline__ void p0_transpose_blk(const float* W, int K, int N, bf16* WT, const float* ks, LAS float* scr, int k0, int n0, int d0, int lane) {
#pragma unroll 8
    for (int i = 0; i < 32; ++i) { const int kk = 2 * i + (lane >> 5); float w = W[(size_t)(k0 + kk) * N + n0 + (lane & 31)]; if (ks) w *= ks[k0 + kk]; scr[kk * 33 + (lane & 31)] = w; }
    LDS_WAIT(); asm volatile("" ::: "memory");
    const int c = lane & 7;
#pragma unroll
    for (int j = 0; j < 4; ++j) { const int n = (lane >> 3) + 8 * j; const LAS float* s = scr + (8 * c) * 33 + n;
        v4u o; o.x = pk2(s[0 * 33], s[1 * 33]); o.y = pk2(s[2 * 33], s[3 * 33]); o.z = pk2(s[4 * 33], s[5 * 33]); o.w = pk2(s[6 * 33], s[7 * 33]);
        *(GAS v4u*)(WT + (size_t)(d0 + n) * K + k0 + 8 * c) = o; }
    LDS_WAIT(); asm volatile("" ::: "memory");
}
__device__ __forceinline__ void p0_transpose_item(const float* W, int K, int N, bf16* WT, const float* ks, LAS float* scr, int item, int lane) {
    const int nblk = N / 32, kb = item / nblk, nb = item % nblk;
    p0_transpose_blk(W, K, N, WT, ks, scr, 64 * kb, 32 * nb, 32 * nb, lane);
}

__device__ __forceinline__ void p0_prologue(Frame& F, const Args& A) {
    unsigned char* ws = A.ws;
    bf16* WIN = (bf16*)(ws + WS_WIN); bf16* WO = (bf16*)(ws + WS_WO); bf16* W1 = (bf16*)(ws + WS_W1); bf16* W2 = (bf16*)(ws + WS_W2); bf16* XN = (bf16*)(ws + WS_XN);
    LAS float* scr = (LAS float*)(F.lds + RING_OFF + F.wave * 16384);
    const int gw = F.vcu * NWAVES + F.wave, NGW = F.G * NWAVES;
    constexpr int I_IN = (D / 64) * (NINP / 32), I_O = (D / 64) * (D / 32), I_1 = (D / 64) * (FF / 32), I_2 = (FF / 64) * (D / 32);
    constexpr int NITEMS = I_IN + I_O + I_1 + I_2;
    for (int it = gw; it < NITEMS; it += NGW) {
        int r = it;
        if (r < I_IN) { const int kb = r / (NINP / 32), gi = r % (NINP / 32), pn = gi >> 3, gl = gi & 7; int src;
            if (pn < 6) src = (pn >> 1) * 512 + ((pn & 1) * 4 + (gl & 3)) * 64 + 32 * (gl >> 2); else src = 1536 + (pn - 6) * 256 + gl * 32;
            if (src < NIN) p0_transpose_blk(A.in[8], D, NIN, WIN, A.in[7], scr, 64 * kb, src, 32 * gi, F.lane);
            else { GAS v4u* z = (GAS v4u*)(WIN + (size_t)(32 * gi) * D + 64 * kb);
                for (int i = F.lane; i < 32 * 8; i += 64) z[(size_t)(i >> 3) * (D * 2 / 16) + (i & 7)] = (v4u){0u, 0u, 0u, 0u}; }
            continue; } r -= I_IN;
        if (r < I_O) { p0_transpose_item(A.in[22], D, D, WO, nullptr, scr, r, F.lane); continue; } r -= I_O;
        if (r < I_1) { p0_transpose_item(A.in[24], D, FF, W1, A.in[23], scr, r, F.lane); continue; } r -= I_1;
        p0_transpose_item(A.in[25], FF, D, W2, nullptr, scr, r, F.lane);
    }
    { bf16* WLt = (bf16*)(ws + WS_LORA); bf16* ALt = WLt + 512 * 64; bf16* GLt = ALt + 512 * 64;
      for (int i = F.vcu * NTHR + F.tid; i < 512 * 288; i += F.G * NTHR) { const int c = i / 288, m = i % 288;
          if (m < 64) WLt[c * 64 + m] = (bf16)f2bf(A.in[13][m * 512 + c]); else if (m < 128) ALt[c * 64 + (m - 64)] = (bf16)f2bf(A.in[15][(m - 64) * 512 + c]); else GLt[c * 160 + (m - 128)] = (bf16)f2bf(A.in[16][(m - 128) * 512 + c]); } }
    float* RSTD = (float*)(ws + WS_RSTD);
    for (int m0 = gw; m0 < M; m0 += 2 * NGW) {
        f32x4 v[2][4]; float s[2] = {0.f, 0.f};
#pragma unroll
        for (int q = 0; q < 2; ++q) { const int m = (m0 + q * NGW < M) ? m0 + q * NGW : m0;
            const float* xrow = (m < MP) ? A.in[0] + (size_t)m * D : A.in[1] + (size_t)(m - MP) * D; const GAS f32x4* xr = (const GAS f32x4*)xrow + F.lane;
#pragma unroll
            for (int j = 0; j < 4; ++j) v[q][j] = xr[64 * j]; }
#pragma unroll
        for (int q = 0; q < 2; ++q)
#pragma unroll
            for (int j = 0; j < 4; ++j) s[q] += (v[q][j].x * v[q][j].x + v[q][j].y * v[q][j].y) + (v[q][j].z * v[q][j].z + v[q][j].w * v[q][j].w);
#pragma unroll
        for (int q = 0; q < 2; ++q) { const int m = m0 + q * NGW; if (m < M) {
            const float rstd = 1.0f / sqrtf(wave_sum(s[q]) * (1.f / D) + RMS_EPS);
            if (F.lane == 0) RSTD[m] = rstd;
            GAS unsigned long long* o8 = (GAS unsigned long long*)(XN + (size_t)m * D) + F.lane;
#pragma unroll
            for (int j = 0; j < 4; ++j) o8[64 * j] = (unsigned long long)pk2(v[q][j].x, v[q][j].y) | ((unsigned long long)pk2(v[q][j].z, v[q][j].w) << 32); } }
    }
}

__device__ __forceinline__ float bf2f(bf16 v) { return __builtin_bit_cast(float, (unsigned)v << 16); }
__device__ __forceinline__ void p2_post(Frame& F, const Args& A) {
    const bf16* PB = (const bf16*)(A.ws + WS_PB);
    LAS float* lin = (LAS float*)(F.lds + RING_OFF);
    float* RW = (float*)(A.ws + WS_RW); const size_t RS = RW_STRIDE / 4;
    const float* mu = A.in[11]; const float* w0 = A.in[12]; const float* wl2 = A.in[13]; const float* a0 = A.in[14]; const float* al2 = A.in[15]; const float* gl2 = A.in[16];
    const float* k_k = A.in[17]; const float* k_a = A.in[18]; const float* sshift = A.in[5];
    const int c = F.tid;
    for (int rb = F.vcu * 4; rb < MS; rb += F.G * 4) {
#define XSR(i_, cc) ({ const int rs_ = rb + (i_); const bf16* p_ = PB + (size_t)(MP + rs_) * 2048; const float x_ = bf2f(p_[cc]); \
            const float pv_ = ((rs_ & 7) == 0) ? sshift[(size_t)(rs_ >> 3) * NSHIFT + (cc)] : bf2f(p_[(cc) - 2048]); x_ + (pv_ - x_) * mu[cc]; })
        for (int idx = c; idx < 4 * 288; idx += NTHR) { const int i = idx / 288, cc = idx % 288; const float x = XSR(i, 1536 + cc); float a;
            if (cc < 64) a = tanhf(x); else if (cc < 128) a = x; else a = 1.0f / (1.0f + expf(-x));
            lin[idx] = a; }
        __syncthreads();
        float wl[4], al[4], g[4];
#pragma unroll
        for (int i = 0; i < 4; ++i) { wl[i] = w0[c]; al[i] = a0[c]; g[i] = 0.f; }
#pragma unroll 32
        for (int m = 0; m < 64; ++m) { const float ww = wl2[m * 512 + c], aw = al2[m * 512 + c];
#pragma unroll
            for (int i = 0; i < 4; ++i) { wl[i] += lin[i * 288 + m] * ww; al[i] += lin[i * 288 + 64 + m] * aw; } }
#pragma unroll 32
        for (int m = 0; m < 160; ++m) { const float gw_ = gl2[m * 512 + c];
#pragma unroll
            for (int i = 0; i < 4; ++i) g[i] += lin[i * 288 + 128 + m] * gw_; }
#pragma unroll
        for (int i = 0; i < 4; ++i) {
            const float r = XSR(i, c), k = XSR(i, 512 + c), v = XSR(i, 1024 + c);
            const float z = -wl[i]; const float sp = (z > 20.f) ? z : log1pf(expf(z));
            const float wlog = -sp - 0.5f; const float dec = expf(-expf(wlog));
            const float a = 1.0f / (1.0f + expf(-al[i]));
            const float kkv = k * k_k[c]; const float ss = wave_sum(kkv * kkv); const float kk = kkv / fmaxf(sqrtf(ss), 1e-12f);
            const float kp = k * (1.0f + (a - 1.0f) * k_a[c]);
            const size_t o = (size_t)(rb + i) * 512 + c;
            RW[0 * RS + o] = r; RW[1 * RS + o] = dec; RW[2 * RS + o] = kp; RW[3 * RS + o] = v; RW[4 * RS + o] = kk; RW[5 * RS + o] = a; RW[6 * RS + o] = g[i];
        }
#undef XSR
        __syncthreads();
    }
}

typedef short v4i16_t __attribute__((ext_vector_type(4)));
constexpr float LOG2E = 1.4426950408889634f;
constexpr int AT_O = 0, AT_VST = 65536, AT_L = 132096, AT_LUTF = 133120, AT_BKT = 135616, AT_B2 = 137216, AT_SLUT = 137472;
__device__ __forceinline__ int vst_off(int row, int ch) { return row * 128 + ((ch ^ ((((row >> 1) & 1) << 1) | (((row >> 3) & 1) << 2))) << 4); }
__device__ __forceinline__ int o_off(int qrow, int ch) { return qrow * 256 + ((ch ^ ((qrow ^ (qrow >> 4)) & 15)) << 4); }
__device__ __forceinline__ void attn_unit2(const bf16* __restrict__ Qh, const bf16* __restrict__ Kh, const bf16* __restrict__ Vh, int qbA, int qbB, int dsh, const LAS float* lutf, LAS unsigned char* vb, int lane, f32x4 (&o)[2][4], float (&lsum)[2]) {
    const int m = lane & 15, g = lane >> 4;
    int kbase[2]; kbase[0] = qbA - (128 << dsh); kbase[1] = qbB - (128 << dsh);
    bf16x8 qf0[2], qf1[2];
#pragma unroll
    for (int u = 0; u < 2; ++u) { const bf16* qp = Qh + (size_t)((u ? qbB : qbA) + (m << dsh)) * 64 + 16 * g; qf0[u] = *(const bf16x8*)qp; qf1[u] = *(const bf16x8*)(qp + 8);
#pragma unroll
        for (int et = 0; et < 4; ++et) o[u][et] = (f32x4){0.f, 0.f, 0.f, 0.f};
        lsum[u] = 0.f; }
    const int vrow = lane >> 3, vch = lane & 7;
    v4u vreg[2][4]; bf16x8 kf[2][4];
    const int voff = (((vrow) << dsh) << 7) + vch * 16, koff = (((8 * (m >> 2) + (m & 3)) << dsh) << 7) + 32 * g;
#define AU_LOAD(grp_) do { _Pragma("unroll") for (int u = 0; u < 2; ++u) { \
        const long rb_ = ((long)(kbase[u] + ((32 * (grp_)) << dsh))) << 7; const char* vbp = (const char*)Vh + rb_; const char* kbp = (const char*)Kh + rb_; \
        _Pragma("unroll") for (int it = 0; it < 4; ++it) vreg[u][it] = *(const v4u*)(vbp + (((long)((8 * it) << dsh)) << 7) + voff); \
        kf[u][0] = *(const bf16x8*)(kbp + koff); kf[u][1] = *(const bf16x8*)(kbp + koff + 16); \
        kf[u][2] = *(const bf16x8*)(kbp + (((long)(4 << dsh)) << 7) + koff); kf[u][3] = *(const bf16x8*)(kbp + (((long)(4 << dsh)) << 7) + koff + 16); } } while (0)
    int voffc[4];
#pragma unroll
    for (int it = 0; it < 4; ++it) { const int rl = 8 * it + vrow; voffc[it] = (((rl < 15 ? rl : 15) << dsh) << 7) + vch * 16; }
    const int kl_ = 8 * (m >> 2) + (m & 3); const int koffa = (((kl_ < 15 ? kl_ : 15) << dsh) << 7) + 32 * g, koffb = ((((kl_ + 4) < 15 ? (kl_ + 4) : 15) << dsh) << 7) + 32 * g;
#define AU_LOAD4() do { _Pragma("unroll") for (int u = 0; u < 2; ++u) { \
        const long rb_ = ((long)(kbase[u] + (128 << dsh))) << 7; const char* vbp = (const char*)Vh + rb_; const char* kbp = (const char*)Kh + rb_; \
        _Pragma("unroll") for (int it = 0; it < 4; ++it) vreg[u][it] = *(const v4u*)(vbp + voffc[it]); \
        kf[u][0] = *(const bf16x8*)(kbp + koffa); kf[u][1] = *(const bf16x8*)(kbp + koffa + 16); \
        kf[u][2] = *(const bf16x8*)(kbp + koffb); kf[u][3] = *(const bf16x8*)(kbp + koffb + 16); } } while (0)
    AU_LOAD(0);
    unsigned wofs[4], rofs[4];
#pragma unroll
    for (int it = 0; it < 4; ++it) { wofs[it] = (unsigned)vst_off(it * 8 + vrow, vch); rofs[it] = (unsigned)(vst_off(8 * g + (m >> 2), 2 * it + ((m & 3) >> 1)) + 8 * (m & 1)); }
    int nmin[2];
#pragma unroll
    for (int u = 0; u < 2; ++u) nmin[u] = kbase[u] < 0 ? ((-kbase[u] + (1 << dsh) - 1) >> dsh) : 0;
#pragma unroll 1
    for (int grp = 0; grp < 5; ++grp) {
        f32x4 s0[2], s1[2];
#pragma unroll
        for (int u = 0; u < 2; ++u) {
#pragma unroll
            for (int it = 0; it < 4; ++it) *(LAS v4u*)(vb + u * 4096 + wofs[it]) = vreg[u][it];
            s0[u] = __builtin_amdgcn_mfma_f32_16x16x32_bf16(kf[u][0], qf0[u], (f32x4){0.f, 0.f, 0.f, 0.f}, 0, 0, 0);
            s1[u] = __builtin_amdgcn_mfma_f32_16x16x32_bf16(kf[u][2], qf0[u], (f32x4){0.f, 0.f, 0.f, 0.f}, 0, 0, 0); }
#pragma unroll
        for (int u = 0; u < 2; ++u) {
            s0[u] = __builtin_amdgcn_mfma_f32_16x16x32_bf16(kf[u][1], qf1[u], s0[u], 0, 0, 0);
            s1[u] = __builtin_amdgcn_mfma_f32_16x16x32_bf16(kf[u][3], qf1[u], s1[u], 0, 0, 0); }
        if (grp < 3) AU_LOAD(grp + 1); else if (grp == 3) AU_LOAD4();
        const int nl = 32 * grp + 8 * g;
        const LAS float* lp = lutf + (nl - m + 32);
        bf16x8 pbf[2];
#pragma unroll
        for (int u = 0; u < 2; ++u) {
            float p0[4], p1[4];
#pragma unroll
            for (int i = 0; i < 4; ++i) { p0[i] = __builtin_amdgcn_exp2f(s0[u][i] + lp[i]); p1[i] = __builtin_amdgcn_exp2f(s1[u][i] + lp[4 + i]); }
            if (nmin[u] > 32 * grp) {
#pragma unroll
                for (int i = 0; i < 4; ++i) { if (nl + i < nmin[u]) p0[i] = 0.f; if (nl + 4 + i < nmin[u]) p1[i] = 0.f; }
            }
            lsum[u] += ((p0[0] + p0[1]) + (p0[2] + p0[3])) + ((p1[0] + p1[1]) + (p1[2] + p1[3]));
            v4u pw; pw.x = cvt2(p0[0], p0[1]); pw.y = cvt2(p0[2], p0[3]); pw.z = cvt2(p1[0], p1[1]); pw.w = cvt2(p1[2], p1[3]);
            pbf[u] = __builtin_bit_cast(bf16x8, pw);
        }
        asm volatile("" ::: "memory");
#pragma unroll
        for (int u = 0; u < 2; ++u) {
#pragma unroll
            for (int et = 0; et < 4; ++et) {
                const v4i16_t t0 = __builtin_amdgcn_ds_read_tr16_b64_v4i16((LAS v4i16_t*)(vb + u * 4096 + rofs[et]));
                const v4i16_t t1 = __builtin_amdgcn_ds_read_tr16_b64_v4i16((LAS v4i16_t*)(vb + u * 4096 + rofs[et] + 512));
                const bf16x8 va = (bf16x8){t0[0], t0[1], t0[2], t0[3], t1[0], t1[1], t1[2], t1[3]};
                o[u][et] = __builtin_amdgcn_mfma_f32_16x16x32_bf16(va, pbf[u], o[u][et], 0, 0, 0);
            }
        }
        asm volatile("" ::: "memory");
    }
#undef AU_LOAD
#undef AU_LOAD4
#pragma unroll
    for (int u = 0; u < 2; ++u) { lsum[u] += __shfl_xor(lsum[u], 16); lsum[u] += __shfl_xor(lsum[u], 32); }
}
__device__ __forceinline__ void attn_tile32(const bf16* __restrict__ Qh, const bf16* __restrict__ Kh, const bf16* __restrict__ Vh, int qb, int dsh, const LAS float* lutf, LAS unsigned char* vb, int lane, f32x4 (&o)[2][4], float (&lsum)[2]) {
    const int m = lane & 15, g = lane >> 4;
    const int kbase = qb - (128 << dsh);
    bf16x8 qf0[2], qf1[2];
#pragma unroll
    for (int u = 0; u < 2; ++u) { const bf16* qp = Qh + (size_t)(qb + ((m + 16 * u) << dsh)) * 64 + 16 * g; qf0[u] = *(const bf16x8*)qp; qf1[u] = *(const bf16x8*)(qp + 8);
#pragma unroll
        for (int et = 0; et < 4; ++et) o[u][et] = (f32x4){0.f, 0.f, 0.f, 0.f};
        lsum[u] = 0.f; }
    const int vrow = lane >> 3, vch = lane & 7;
    v4u vrA[4], vrB[4]; bf16x8 kfA[4], kfB[4];
    const int voff = (((vrow) << dsh) << 7) + vch * 16, koff = (((8 * (m >> 2) + (m & 3)) << dsh) << 7) + 32 * g;
#define T_LOAD(VR, KF, grp_) do { \
        const long rb_ = ((long)(kbase + ((32 * (grp_)) << dsh))) << 7; const char* vbp = (const char*)Vh + rb_; const char* kbp = (const char*)Kh + rb_; \
        _Pragma("unroll") for (int it = 0; it < 4; ++it) VR[it] = *(const v4u*)(vbp + (((long)((8 * it) << dsh)) << 7) + voff); \
        KF[0] = *(const bf16x8*)(kbp + koff); KF[1] = *(const bf16x8*)(kbp + koff + 16); \
        KF[2] = *(const bf16x8*)(kbp + (((long)(4 << dsh)) << 7) + koff); KF[3] = *(const bf16x8*)(kbp + (((long)(4 << dsh)) << 7) + koff + 16); } while (0)
    T_LOAD(vrA, kfA, 0); T_LOAD(vrB, kfB, 1);
    unsigned wofs[4], rofs[4];
#pragma unroll
    for (int it = 0; it < 4; ++it) { wofs[it] = (unsigned)vst_off(it * 8 + vrow, vch); rofs[it] = (unsigned)(vst_off(8 * g + (m >> 2), 2 * it + ((m & 3) >> 1)) + 8 * (m & 1)); }
    const int nmin = kbase < 0 ? ((-kbase + (1 << dsh) - 1) >> dsh) : 0;
#define T_STEP(VR, KF, grp) do { \
        LAS unsigned char* vbg = vb + ((grp) & 1) * 4096; \
        _Pragma("unroll") for (int it = 0; it < 4; ++it) *(LAS v4u*)(vbg + wofs[it]) = VR[it]; \
        f32x4 s0[2], s1[2]; \
        _Pragma("unroll") for (int u = 0; u < 2; ++u) { \
            s0[u] = __builtin_amdgcn_mfma_f32_16x16x32_bf16(KF[0], qf0[u], (f32x4){0.f, 0.f, 0.f, 0.f}, 0, 0, 0); \
            s1[u] = __builtin_amdgcn_mfma_f32_16x16x32_bf16(KF[2], qf0[u], (f32x4){0.f, 0.f, 0.f, 0.f}, 0, 0, 0); } \
        _Pragma("unroll") for (int u = 0; u < 2; ++u) { \
            s0[u] = __builtin_amdgcn_mfma_f32_16x16x32_bf16(KF[1], qf1[u], s0[u], 0, 0, 0); \
            s1[u] = __builtin_amdgcn_mfma_f32_16x16x32_bf16(KF[3], qf1[u], s1[u], 0, 0, 0); } \
        if ((grp) + 2 < 5) T_LOAD(VR, KF, (grp) + 2); \
        const int nl = 32 * (grp) + 8 * g; \
        bf16x8 pbf[2]; \
        _Pragma("unroll") for (int u = 0; u < 2; ++u) { \
            const LAS float* lp = lutf + (nl - m - 16 * u + 32); \
            float p0[4], p1[4]; \
            _Pragma("unroll") for (int i = 0; i < 4; ++i) { p0[i] = __builtin_amdgcn_exp2f(s0[u][i] + lp[i]); p1[i] = __builtin_amdgcn_exp2f(s1[u][i] + lp[4 + i]); } \
            if (nmin > 32 * (grp)) { \
                _Pragma("unroll") for (int i = 0; i < 4; ++i) { if (nl + i < nmin) p0[i] = 0.f; if (nl + 4 + i < nmin) p1[i] = 0.f; } } \
            lsum[u] += ((p0[0] + p0[1]) + (p0[2] + p0[3])) + ((p1[0] + p1[1]) + (p1[2] + p1[3])); \
            v4u pw; pw.x = cvt2(p0[0], p0[1]); pw.y = cvt2(p0[2], p0[3]); pw.z = cvt2(p1[0], p1[1]); pw.w = cvt2(p1[2], p1[3]); \
            pbf[u] = __builtin_bit_cast(bf16x8, pw); } \
        asm volatile("" ::: "memory"); \
        _Pragma("unroll") for (int et = 0; et < 4; ++et) { \
            const v4i16_t t0 = __builtin_amdgcn_ds_read_tr16_b64_v4i16((LAS v4i16_t*)(vbg + rofs[et])); \
            const v4i16_t t1 = __builtin_amdgcn_ds_read_tr16_b64_v4i16((LAS v4i16_t*)(vbg + rofs[et] + 512)); \
            const bf16x8 va = (bf16x8){t0[0], t0[1], t0[2], t0[3], t1[0], t1[1], t1[2], t1[3]}; \
            o[0][et] = __builtin_amdgcn_mfma_f32_16x16x32_bf16(va, pbf[0], o[0][et], 0, 0, 0); \
            o[1][et] = __builtin_amdgcn_mfma_f32_16x16x32_bf16(va, pbf[1], o[1][et], 0, 0, 0); } \
        asm volatile("" ::: "memory"); } while (0)
    T_STEP(vrA, kfA, 0); T_STEP(vrB, kfB, 1); T_STEP(vrA, kfA, 2); T_STEP(vrB, kfB, 3); T_STEP(vrA, kfA, 4);
#undef T_STEP
#undef T_LOAD
#pragma unroll
    for (int u = 0; u < 2; ++u) { lsum[u] += __shfl_xor(lsum[u], 16); lsum[u] += __shfl_xor(lsum[u], 32); }
}
struct SampleCtx { const float* QS; const float* ck; const float* cv; const float* kn; const float* vn; int sb, h; };
__device__ __forceinline__ const float* s_row(const float* cache, const float* nw, int sb, int h, int cpos) {
    return (cpos >= LWIN) ? nw + ((size_t)(sb * STOK + (cpos - LWIN < STOK ? cpos - LWIN : STOK - 1)) * NH + h) * 64 : cache + ((size_t)(sb * LWIN + cpos) * NH + h) * 64;
}
__device__ __forceinline__ void attn_unit_s(const SampleCtx& C, int qb, int dsh, int nmax, const LAS float* lutf, LAS unsigned char* vb, int lane, f32x4 (&o)[4], float& lsum) {
    const int m = lane & 15, g = lane >> 4;
    const int kbase = qb - (128 << dsh);
    const int qi = qb + (m << dsh) - LWIN;
    bf16x8 qf0 = (bf16x8){0, 0, 0, 0, 0, 0, 0, 0}, qf1 = qf0;
    if ((unsigned)qi < (unsigned)STOK) { const float* qp = C.QS + (size_t)(C.sb * STOK + qi) * 512 + C.h * 64 + 16 * g; const float sc = 0.125f * LOG2E;
        const f32x4 a = *(const f32x4*)qp * sc, b = *(const f32x4*)(qp + 4) * sc, c = *(const f32x4*)(qp + 8) * sc, d = *(const f32x4*)(qp + 12) * sc;
        v4u w0, w1; w0.x = cvt2(a[0], a[1]); w0.y = cvt2(a[2], a[3]); w0.z = cvt2(b[0], b[1]); w0.w = cvt2(b[2], b[3]); w1.x = cvt2(c[0], c[1]); w1.y = cvt2(c[2], c[3]); w1.z = cvt2(d[0], d[1]); w1.w = cvt2(d[2], d[3]);
        qf0 = __builtin_bit_cast(bf16x8, w0); qf1 = __builtin_bit_cast(bf16x8, w1); }
#pragma unroll
    for (int et = 0; et < 4; ++et) o[et] = (f32x4){0.f, 0.f, 0.f, 0.f};
    lsum = 0.f;
    const int vrow = lane >> 3, vch = lane & 7;
    f32x4 vrA[4][2], krA[2][4], vrB[4][2], krB[2][4];
#define AS_LOAD(VR, KR, grp_) do { \
        _Pragma("unroll") for (int it = 0; it < 4; ++it) { const int nv_ = 32 * (grp_) + it * 8 + vrow; const float* vp = s_row(C.cv, C.vn, C.sb, C.h, kbase + ((nv_ < nmax ? nv_ : nmax) << dsh)) + vch * 8; VR[it][0] = *(const f32x4*)vp; VR[it][1] = *(const f32x4*)(vp + 4); } \
        const int n0_ = 32 * (grp_) + 8 * (m >> 2) + (m & 3); \
        const float* ka = s_row(C.ck, C.kn, C.sb, C.h, kbase + ((n0_ < nmax ? n0_ : nmax) << dsh)) + 16 * g; const float* kb = s_row(C.ck, C.kn, C.sb, C.h, kbase + (((n0_ + 4) < nmax ? (n0_ + 4) : nmax) << dsh)) + 16 * g; \
        _Pragma("unroll") for (int j = 0; j < 4; ++j) { KR[0][j] = *(const f32x4*)(ka + 4 * j); KR[1][j] = *(const f32x4*)(kb + 4 * j); } } while (0)
    AS_LOAD(vrA, krA, 0); AS_LOAD(vrB, krB, 1);
#define AS_STEP(VR, KR, grp) do { \
        LAS unsigned char* vbg = vb + ((grp) & 1) * 4096; \
        _Pragma("unroll") for (int it = 0; it < 4; ++it) { v4u w; w.x = cvt2(VR[it][0][0], VR[it][0][1]); w.y = cvt2(VR[it][0][2], VR[it][0][3]); w.z = cvt2(VR[it][1][0], VR[it][1][1]); w.w = cvt2(VR[it][1][2], VR[it][1][3]); \
            *(LAS v4u*)(vbg + vst_off(it * 8 + vrow, vch)) = w; } \
        bf16x8 kf[4]; \
        _Pragma("unroll") for (int tl = 0; tl < 2; ++tl) { v4u w0, w1; w0.x = cvt2(KR[tl][0][0], KR[tl][0][1]); w0.y = cvt2(KR[tl][0][2], KR[tl][0][3]); w0.z = cvt2(KR[tl][1][0], KR[tl][1][1]); w0.w = cvt2(KR[tl][1][2], KR[tl][1][3]); \
            w1.x = cvt2(KR[tl][2][0], KR[tl][2][1]); w1.y = cvt2(KR[tl][2][2], KR[tl][2][3]); w1.z = cvt2(KR[tl][3][0], KR[tl][3][1]); w1.w = cvt2(KR[tl][3][2], KR[tl][3][3]); \
            kf[2 * tl] = __builtin_bit_cast(bf16x8, w0); kf[2 * tl + 1] = __builtin_bit_cast(bf16x8, w1); } \
        if ((grp) + 2 < 5) AS_LOAD(VR, KR, (grp) + 2); \
        f32x4 s0 = __builtin_amdgcn_mfma_f32_16x16x32_bf16(kf[0], qf0, (f32x4){0.f, 0.f, 0.f, 0.f}, 0, 0, 0); \
        s0 = __builtin_amdgcn_mfma_f32_16x16x32_bf16(kf[1], qf1, s0, 0, 0, 0); \
        f32x4 s1 = __builtin_amdgcn_mfma_f32_16x16x32_bf16(kf[2], qf0, (f32x4){0.f, 0.f, 0.f, 0.f}, 0, 0, 0); \
        s1 = __builtin_amdgcn_mfma_f32_16x16x32_bf16(kf[3], qf1, s1, 0, 0, 0); \
        const int nl = 32 * (grp) + 8 * g; \
        const LAS float* lp = lutf + (nl - m + 16); \
        float p0[4], p1[4]; \
        _Pragma("unroll") for (int i = 0; i < 4; ++i) { p0[i] = __builtin_amdgcn_exp2f(s0[i] + lp[i]); p1[i] = __builtin_amdgcn_exp2f(s1[i] + lp[4 + i]); } \
        lsum += ((p0[0] + p0[1]) + (p0[2] + p0[3])) + ((p1[0] + p1[1]) + (p1[2] + p1[3])); \
        v4u pw; pw.x = cvt2(p0[0], p0[1]); pw.y = cvt2(p0[2], p0[3]); pw.z = cvt2(p1[0], p1[1]); pw.w = cvt2(p1[2], p1[3]); \
        const bf16x8 pbf = __builtin_bit_cast(bf16x8, pw); \
        asm volatile("" ::: "memory"); \
        _Pragma("unroll") for (int et = 0; et < 4; ++et) { \
            const int r0 = 8 * g + (m >> 2), ch = 2 * et + ((m & 3) >> 1); \
            const v4i16_t t0 = __builtin_amdgcn_ds_read_tr16_b64_v4i16((LAS v4i16_t*)(vbg + vst_off(r0, ch) + 8 * (m & 1))); \
            const v4i16_t t1 = __builtin_amdgcn_ds_read_tr16_b64_v4i16((LAS v4i16_t*)(vbg + vst_off(r0 + 4, ch) + 8 * (m & 1))); \
            const bf16x8 va = (bf16x8){t0[0], t0[1], t0[2], t0[3], t1[0], t1[1], t1[2], t1[3]}; \
            o[et] = __builtin_amdgcn_mfma_f32_16x16x32_bf16(va, pbf, o[et], 0, 0, 0); } \
        asm volatile("" ::: "memory"); } while (0)
    AS_STEP(vrA, krA, 0); AS_STEP(vrB, krB, 1); AS_STEP(vrA, krA, 2); AS_STEP(vrB, krB, 3); AS_STEP(vrA, krA, 4);
#undef AS_STEP
#undef AS_LOAD
    lsum += __shfl_xor(lsum, 16); lsum += __shfl_xor(lsum, 32);
}
constexpr int CW_Q = 8192;
__device__ __forceinline__ int q_pop(Frame& F, int k) {
    if (F.tid == 0) F.MISC[16] = __hip_atomic_fetch_add(F.ctl + CW_Q + 64 * k, 1u, __ATOMIC_RELAXED, __HIP_MEMORY_SCOPE_AGENT);
    __syncthreads(); const int it = (int)F.MISC[16]; __syncthreads(); return it;
}
__device__ __forceinline__ void p3_attn(Frame& F, const Args& A) {
    const bf16* QB = (const bf16*)(A.ws + WS_QB); const bf16* KB = (const bf16*)(A.ws + WS_KB); const bf16* VB = (const bf16*)(A.ws + WS_VB); bf16* MIX = (bf16*)(A.ws + WS_MIX);
    const float* btab = A.in[6]; const int lane = F.lane;
    LAS unsigned char* Ob = F.lds + AT_O; LAS float* Lb = (LAS float*)(F.lds + AT_L); LAS float* lutf = (LAS float*)(F.lds + AT_LUTF); LAS int* bkt = (LAS int*)(F.lds + AT_BKT); LAS float* b2p = (LAS float*)(F.lds + AT_B2);
    LAS unsigned char* vb = F.lds + AT_VST + F.wave * 8192;
    for (int i = F.tid; i < 387; i += NTHR) { const int br = i / 129, j = i % 129; const int dist = j << (2 * br);
        int bk; if (dist < 16) bk = dist; else { bk = 16 + (int)(log((double)dist / 16.0) / log(128.0) * 16.0); if (bk > 31) bk = 31; }
        bkt[i] = bk; }
    if (F.wave == 0) { const float gqm = wave_max(fabsf(A.in[9][lane])), gkm = wave_max(fabsf(A.in[10][lane]));
        const float bm = wave_max(fmaxf(fmaxf(btab[lane * 4], btab[lane * 4 + 1]), fmaxf(btab[lane * 4 + 2], btab[lane * 4 + 3])));
        if (lane == 0) b2p[0] = (8.0f * gqm * gkm + bm) * LOG2E; }
    __syncthreads();
    const float B2 = b2p[0];
    const int m = lane & 15, g = lane >> 4;
    const int xq0 = (F.vcu * 8 / F.G) & 7; int lut_h = -1, slut_h = -1;
    SampleCtx C; C.QS = (const float*)(A.ws + WS_QS); C.ck = A.in[2]; C.cv = A.in[3]; C.kn = A.out + O_KNS; C.vn = A.out + O_VNS;
    LAS float* Oacc = (LAS float*)(F.lds + AT_O);
    LAS float* Lacc = Oacc + 4 * 8 * 64;
    LAS float* slut = (LAS float*)(F.lds + AT_SLUT);
    const int pl = 0;
    int pk = 0, cnt = 0; bool p_left = true, s_left = true;
#pragma unroll 1
    while (p_left || s_left) {
      if (p_left && !(s_left && cnt >= 2)) {
        const int xq = (xq0 + pk) & 7;
        const int qi = q_pop(F, xq); if (qi >= 256) { if (++pk == 8) p_left = false; continue; }
        ++cnt;
        const int bh = (qi >> 5) * 8 + xq, qblk = qi & 31, h = bh & 7, b = bh >> 3, q0 = qblk * 256;
        const bf16* Qh = QB + (size_t)bh * SEQ * 64; const bf16* Kh = KB + (size_t)bh * SEQ * 64; const bf16* Vh = VB + (size_t)bh * SEQ * 64;
        if (h != lut_h) {
            for (int i = F.tid; i < 3 * 208; i += NTHR) { const int br = i / 208, dl = (i % 208) - 32; lutf[i] = (dl >= 0 && dl <= 128) ? btab[bkt[br * 129 + (128 - dl)] * NH + h] * LOG2E - B2 : -INFINITY; }
            lut_h = h; __syncthreads(); }
#pragma unroll 1
        for (int br = 0; br < 3; ++br) {
            int qrel[2];
#pragma unroll
            for (int uu = 0; uu < 2; ++uu) { if (br == 0) qrel[uu] = 32 * F.wave + 16 * uu; else if (br == 1) qrel[uu] = 128 * (F.wave >> 2) + (F.wave & 3) + 64 * uu; else qrel[uu] = F.wave + 8 * uu; }
            f32x4 o[2][4]; float lsum[2];
            int ln = lane; asm volatile("" : "+v"(ln));
            if (br < 2) attn_tile32(Qh, Kh, Vh, q0 + qrel[0], 2 * br, lutf + br * 208, vb, ln, o, lsum);
            else attn_unit2(Qh, Kh, Vh, q0 + qrel[0], q0 + qrel[1], 2 * br, lutf + br * 208, vb, ln, o, lsum);
#pragma unroll
            for (int uu = 0; uu < 2; ++uu) {
                const int qrow = qrel[uu] + (m << (2 * br));
                if (br == 0) {
#pragma unroll
                    for (int et = 0; et < 4; ++et) *(LAS f32x4*)(Ob + o_off(qrow, 4 * et + g)) = o[uu][et];
                    if (g == 0) Lb[qrow] = lsum[uu];
                } else if (br == 1) {
#pragma unroll
                    for (int et = 0; et < 4; ++et) { LAS f32x4* p = (LAS f32x4*)(Ob + o_off(qrow, 4 * et + g)); *p = *p + o[uu][et]; }
                    if (g == 0) Lb[qrow] += lsum[uu];
                } else {
                    const float inv = 1.0f / (Lb[qrow] + lsum[uu]);
                    bf16* dst = MIX + (size_t)(b * SEQ + q0 + qrow) * D + h * 64 + 4 * g;
#pragma unroll
                    for (int et = 0; et < 4; ++et) { const f32x4 v = (*(LAS f32x4*)(Ob + o_off(qrow, 4 * et + g)) + o[uu][et]) * inv;
                        *(unsigned long long*)(dst + 16 * et) = (unsigned long long)cvt2(v[0], v[1]) | ((unsigned long long)cvt2(v[2], v[3]) << 32); }
                }
            }
            __syncthreads();
        }
      } else {
        cnt = 0;
        const int qi = q_pop(F, 8); if (qi >= SBATCH * NH) { s_left = false; continue; }
        const int pair = qi; C.sb = pair >> 3; C.h = pair & 7;
        for (int i = F.tid; i < 8 * 64; i += NTHR) Oacc[i] = 0.f;
        if (F.tid < 8) Lacc[F.tid] = 0.f;
        if (C.h != slut_h) { for (int i = F.tid; i < 3 * 192; i += NTHR) { const int br = i / 192, dl = (i % 192) - 16; slut[i] = (dl >= 0 && dl <= 128) ? btab[bkt[br * 129 + (128 - dl)] * NH + C.h] * LOG2E - B2 : -INFINITY; } slut_h = C.h; }
        __syncthreads();
#pragma unroll 1
        for (int u = F.wave; u < 13; u += 8) {
            int br, cls; if (u == 0) { br = 0; cls = 0; } else if (u < 5) { br = 1; cls = u - 1; } else { br = 2; cls = u - 5; }
            f32x4 o[4]; float lsum;
            int ln = lane; asm volatile("" : "+v"(ln));
            attn_unit_s(C, LWIN + cls, 2 * br, 128 + ((STOK - 1 - cls) >> (2 * br)), slut + br * 192, vb, ln, o, lsum);
            const int qi2 = cls + (m << (2 * br));
            if (qi2 < STOK) {
                LAS float* op = Oacc + (pl * 8 + qi2) * 64 + 4 * g;
#pragma unroll
                for (int et = 0; et < 4; ++et) {
#pragma unroll
                    for (int r = 0; r < 4; ++r) (void)__hip_atomic_fetch_add(op + 16 * et + r, o[et][r], __ATOMIC_RELAXED, __HIP_MEMORY_SCOPE_WORKGROUP); }
                if (g == 0) (void)__hip_atomic_fetch_add(Lacc + pl * 8 + qi2, lsum, __ATOMIC_RELAXED, __HIP_MEMORY_SCOPE_WORKGROUP);
            }
        }
        __syncthreads();
        if (F.wave == 0) { const int i = lane >> 3, e8 = (lane & 7) * 8; const float inv = 1.0f / Lacc[pl * 8 + i];
            const LAS float* op = Oacc + (pl * 8 + i) * 64 + e8;
            v4u w; w.x = cvt2(op[0] * inv, op[1] * inv); w.y = cvt2(op[2] * inv, op[3] * inv); w.z = cvt2(op[4] * inv, op[5] * inv); w.w = cvt2(op[6] * inv, op[7] * inv);
            *(v4u*)(MIX + (size_t)(MP + C.sb * STOK + i) * D + C.h * 64 + e8) = w; }
        __syncthreads();
      }
    }
}

__device__ __forceinline__ void p4_scan(Frame& F, const Args& A, int gw, int NGW) {
    const float* RW = (const float*)(A.ws + WS_RW); const size_t RS = RW_STRIDE / 4; bf16* MIX = (bf16*)(A.ws + WS_MIX);
    const float* r_k = A.in[19]; const float* lnx_g = A.in[20]; const float* lnx_b = A.in[21]; const float* wkv0 = A.in[4];
    LAS float* sh = (LAS float*)(F.lds + RING_OFF + F.wave * 2048);
    const int lane = F.lane;
    for (int it0 = gw; it0 < SBATCH * NH; it0 += NGW) {
        const int it = it0 + BATCH * NH;
        const bool prompt = false; const int sq = it0 >> 3, h = it0 & 7;
        const int T = STOK; const size_t row0 = (size_t)MP + (size_t)sq * STOK;
        float S[64];
        if (prompt) {
#pragma unroll
            for (int j = 0; j < 64; ++j) S[j] = 0.f;
        } else { const f32x4* s0 = (const f32x4*)(wkv0 + ((size_t)(sq * NH + h) * 64 + lane) * 64);
#pragma unroll
            for (int j = 0; j < 16; ++j) { const f32x4 v = s0[j]; S[4 * j] = v.x; S[4 * j + 1] = v.y; S[4 * j + 2] = v.z; S[4 * j + 3] = v.w; } }
        const int c = h * 64 + lane; const float rkc = r_k[c], lg = lnx_g[c], lb = lnx_b[c];
        float nr, ndec, nkp, nv, nkk, na, ng;
        { const size_t o = (row0 - MP) * 512 + c; nr = RW[o]; ndec = RW[RS + o]; nkp = RW[2 * RS + o]; nv = RW[3 * RS + o]; nkk = RW[4 * RS + o]; na = RW[5 * RS + o]; ng = RW[6 * RS + o]; }
        for (int t = 0; t < T; ++t) {
            const float r = nr, dec = ndec, kp = nkp, v = nv, kk = nkk, a = na, g = ng;
            { const size_t o = (row0 - MP + (t + 1 < T ? t + 1 : t)) * 512 + c; nr = RW[o]; ndec = RW[RS + o]; nkp = RW[2 * RS + o]; nv = RW[3 * RS + o]; nkk = RW[4 * RS + o]; na = RW[5 * RS + o]; ng = RW[6 * RS + o]; }
            sh[lane] = r; sh[64 + lane] = dec; sh[128 + lane] = kp; sh[192 + lane] = kk; sh[256 + lane] = kk * a;
            LDS_WAIT(); asm volatile("" ::: "memory");
            float sk = 0.f;
#pragma unroll
            for (int j = 0; j < 64; ++j) sk += S[j] * sh[192 + j];
            float y = 0.f;
#pragma unroll
            for (int j = 0; j < 64; ++j) { S[j] = S[j] * sh[64 + j] - sk * sh[256 + j] + v * sh[128 + j]; y += S[j] * sh[j]; }
            const float bon = wave_sum(r * kp * rkc);
            const float mean = wave_sum(y) * (1.f / 64.f); const float dv = y - mean; const float var = wave_sum(dv * dv) * (1.f / 64.f);
            const float yo = dv * (1.0f / sqrtf(var + GN_EPS)) * lg + lb;
            MIX[(row0 + t) * D + 512 + c] = (bf16)f2bf((yo + bon * v) * g);
            LDS_WAIT(); asm volatile("" ::: "memory");
        }
        float* so = A.out + (prompt ? O_WKVP : O_WKVS) + ((size_t)(sq * NH + h) * 64 + lane) * 64;
#pragma unroll
        for (int j = 0; j < 16; ++j) ((f32x4*)so)[j] = (f32x4){S[4 * j], S[4 * j + 1], S[4 * j + 2], S[4 * j + 3]};
    }
}

constexpr int RS = 72;
constexpr int SLOT = 9216;
typedef unsigned u32x2_t __attribute__((ext_vector_type(2)));
__device__ __forceinline__ f32x4 mfma16(bf16x8 a, bf16x8 b, f32x4 c) { return __builtin_amdgcn_mfma_f32_16x16x32_bf16(a, b, c, 0, 0, 0); }
__device__ __forceinline__ f32x4 mm64(const LAS bf16* A, const LAS bf16* B, int ta, int tb, int lane, f32x4 acc) {
    const int r = lane & 15, g = lane >> 4;
    const LAS bf16* ap = A + (16 * ta + r) * RS + 8 * g; const LAS bf16* bp = B + (16 * tb + r) * RS + 8 * g;
    const bf16x8 a0 = *(const LAS bf16x8*)ap, a1 = *(const LAS bf16x8*)(ap + 32), b0 = *(const LAS bf16x8*)bp, b1 = *(const LAS bf16x8*)(bp + 32);
    acc = mfma16(a0, b0, acc); return mfma16(a1, b1, acc);
}
template <bool SWA, bool SWB>
__device__ __forceinline__ f32x4 mm64s(const LAS bf16* A, const LAS bf16* B, int ta, int tb, int lane, f32x4 acc) {
    const int r = lane & 15, g = lane >> 4;
    const int ra = 16 * ta + r, rb = 16 * tb + r, xa = SWA ? ((ra >> 3) & 7) : 0, xb = SWB ? ((rb >> 3) & 7) : 0;
    const LAS bf16* ap = A + ra * RS; const LAS bf16* bp = B + rb * RS;
    const bf16x8 a0 = *(const LAS bf16x8*)(ap + 8 * (g ^ xa)), a1 = *(const LAS bf16x8*)(ap + 8 * ((g + 4) ^ xa)), b0 = *(const LAS bf16x8*)(bp + 8 * (g ^ xb)), b1 = *(const LAS bf16x8*)(bp + 8 * ((g + 4) ^ xb));
    acc = mfma16(a0, b0, acc); return mfma16(a1, b1, acc);
}

struct Frag2 { bf16x8 f[2][2]; };
template <bool SW> __device__ __forceinline__ void ldfrag(const LAS bf16* M, int blk, int lane, Frag2& F_) {
    const int r = lane & 15, g = lane >> 4;
#pragma unroll
    for (int x = 0; x < 2; ++x) { const int row = 32 * blk + 16 * x + r, xs = SW ? ((row >> 3) & 7) : 0; const LAS bf16* p = M + row * RS;
        F_.f[x][0] = *(const LAS bf16x8*)(p + 8 * (g ^ xs)); F_.f[x][1] = *(const LAS bf16x8*)(p + 8 * ((g + 4) ^ xs)); }
}
__device__ __forceinline__ void mmblk(const Frag2& a, const Frag2& b, f32x4 (&acc)[2][2]) {
#pragma unroll
    for (int x = 0; x < 2; ++x)
#pragma unroll
        for (int y = 0; y < 2; ++y) { acc[x][y] = mfma16(a.f[x][0], b.f[y][0], acc[x][y]); acc[x][y] = mfma16(a.f[x][1], b.f[y][1], acc[x][y]); }
}
#define ZERO22(acc) do { _Pragma("unroll") for (int x = 0; x < 2; ++x) _Pragma("unroll") for (int y = 0; y < 2; ++y) acc[x][y] = (f32x4){0.f, 0.f, 0.f, 0.f}; } while (0)
__device__ __forceinline__ int dm_off(int j, int t) { return j * RS + (t ^ (8 * ((j >> 3) & 7))); }
__device__ __forceinline__ u32x2_t pack4(f32x4 v) { u32x2_t w; w.x = cvt2(v[0], v[1]); w.y = cvt2(v[2], v[3]); return w; }
__device__ __forceinline__ void st_t(LAS bf16* Dst, int c, int r0, f32x4 v) { *(LAS u32x2_t*)(Dst + c * RS + r0) = pack4(v); }
#define BARRIER() asm volatile("s_waitcnt lgkmcnt(0)\n\ts_barrier" ::: "memory")


__device__ __forceinline__ void r1_lin(Frame& F, const bf16* PB, const float* mu, bf16* LIN) {
    const int nvec = MP * 36;
#pragma unroll 1
    for (int base = F.vcu * NTHR + F.tid; base < nvec; base += 4 * F.G * NTHR) {
        v4u xv[4], pv[4];
#pragma unroll
        for (int k = 0; k < 4; ++k) { const int vi = base + k * F.G * NTHR; xv[k] = (v4u){0u, 0u, 0u, 0u}; pv[k] = xv[k];
            if (vi < nvec) { const int row = vi / 36, v8 = vi % 36; const bf16* pr = PB + (size_t)row * 2048 + 1536 + 8 * v8;
                xv[k] = *(const v4u*)pr; if ((row & (SEQ - 1)) != 0) pv[k] = *(const v4u*)(pr - 2048); } }
#pragma unroll
        for (int k = 0; k < 4; ++k) { const int vi = base + k * F.G * NTHR;
            if (vi < nvec) { const int row = vi / 36, v8 = vi % 36; const float* mp = mu + 1536 + 8 * v8;
                const f32x4 m0 = *(const f32x4*)mp, m1 = *(const f32x4*)(mp + 4); float a[8];
#pragma unroll
                for (int i = 0; i < 8; ++i) { const unsigned sh = (i & 1) * 16;
                    const float x = __builtin_bit_cast(float, ((xv[k][i >> 1] >> sh) & 0xffffu) << 16), p = __builtin_bit_cast(float, ((pv[k][i >> 1] >> sh) & 0xffffu) << 16);
                    const float xs = x + (p - x) * (i < 4 ? m0[i & 3] : m1[i & 3]);
                    if (v8 < 8) a[i] = 1.0f - 2.0f * __builtin_amdgcn_rcpf(1.0f + __expf(2.0f * xs));
                    else if (v8 < 16) a[i] = xs;
                    else a[i] = __builtin_amdgcn_rcpf(1.0f + __expf(-xs)); }
                v4u w_; w_.x = cvt2(a[0], a[1]); w_.y = cvt2(a[2], a[3]); w_.z = cvt2(a[4], a[5]); w_.w = cvt2(a[6], a[7]);
                *(v4u*)(LIN + (size_t)row * 288 + 8 * v8) = w_; } }
    }
}
struct R1Ptrs {
    const bf16* LIN;
    const bf16* PB; const bf16* WLt; const bf16* ALt; const bf16* GLt;
    const float *mu, *w0, *a0, *k_k, *k_a, *r_k;
    bf16* PT; bf16* RP; bf16* QM; bf16* Y0; float* GC; bf16* G2; bf16* BV;
};
struct R1W { bf16x8 wa0, wa1, aa0, aa1; };
__device__ __forceinline__ void r1_load_w(Frame& F, const R1Ptrs& P, int h, R1W& W) {
    const int ta = F.wave >> 1, r = F.lane & 15, g = F.lane >> 4;
    const bf16* wa = P.WLt + (size_t)(h * 64 + 16 * ta + r) * 64 + 8 * g; const bf16* aa = P.ALt + (size_t)(h * 64 + 16 * ta + r) * 64 + 8 * g; const bf16* ga = P.GLt + (size_t)(h * 64 + 16 * ta + r) * 160 + 8 * g;
    W.wa0 = *(const bf16x8*)wa; W.wa1 = *(const bf16x8*)(wa + 32); W.aa0 = *(const bf16x8*)aa; W.aa1 = *(const bf16x8*)(aa + 32); (void)ga;
}
__device__ __forceinline__ void r1_load_par(Frame& F, const R1Ptrs& P, int h) {
    LAS float* par = (LAS float*)(F.lds + 14 * SLOT); const int i = F.tid;
    if (i < 512) { const int a = i >> 6, j = i & 63; float v;
        if (a < 3) v = P.mu[a * 512 + h * 64 + j]; else if (a == 3) v = P.w0[h * 64 + j]; else if (a == 4) v = P.a0[h * 64 + j]; else if (a == 5) v = P.k_k[h * 64 + j]; else if (a == 6) v = P.k_a[h * 64 + j]; else v = P.r_k[h * 64 + j];
        par[i] = v; }
    __syncthreads();
}
struct R1Pre { v4u xr, xk, xv, qr, qk, qv; bf16x8 lw0[2], lw1[2], la0[2], la1[2]; };
__device__ __forceinline__ void r1_prefetch(const R1Ptrs& P, int tid, int w, int bh, int c, R1Pre& N) {
    const int lane = tid & 63, h = bh & 7, b = bh >> 3; const size_t row0 = (size_t)b * SEQ + (size_t)c * 64;
    { const int t = tid >> 3, jb = (tid & 7) * 8, hj = h * 64 + jb; const bf16* pr = P.PB + (row0 + t) * 2048 + hj; const bool first = (c == 0 && t == 0);
      N.xr = *(const v4u*)pr; N.xk = *(const v4u*)(pr + 512); N.xv = *(const v4u*)(pr + 1024);
      N.qr = (v4u){0u, 0u, 0u, 0u}; N.qk = N.qr; N.qv = N.qr;
      if (!first) { N.qr = *(const v4u*)(pr - 2048); N.qk = *(const v4u*)(pr - 2048 + 512); N.qv = *(const v4u*)(pr - 2048 + 1024); } }
#pragma unroll
    for (int tt = 0; tt < 2; ++tt) { const int r = lane & 15, g = lane >> 4, tcol = 16 * (2 * (w & 1) + tt) + r; const bf16* bw = P.LIN + (row0 + tcol) * 288 + 8 * g;
      N.lw0[tt] = *(const bf16x8*)bw; N.lw1[tt] = *(const bf16x8*)(bw + 32); N.la0[tt] = *(const bf16x8*)(bw + 64); N.la1[tt] = *(const bf16x8*)(bw + 96); }
}
__device__ __forceinline__ void r1_item(Frame& F, const R1Ptrs& P, const R1W& W, R1Pre& N, int bh, int c, bool has_next) {
    int tid_ = F.tid; asm volatile("" : "+v"(tid_));
    const int tid = tid_, lane = tid & 63, w = F.wave, h = bh & 7, b = bh >> 3;
    const int ch = bh * 128 + c; const size_t row0 = (size_t)b * SEQ + (size_t)c * 64;
    LAS unsigned char* L = F.lds;
#define SL(k) ((LAS bf16*)(L + (k) * SLOT))
    LAS float* wlf = (LAS float*)(L + 0 * SLOT); LAS float* alf = (LAS float*)(L + 2 * SLOT); LAS float* cum = (LAS float*)(L + 12 * SLOT);
    LAS float* segtot = (LAS float*)(L + 11 * SLOT);
    {
        const int ta = w >> 1, r = lane & 15, g = lane >> 4;
#pragma unroll
        for (int tt = 0; tt < 2; ++tt) {
            const int tb = 2 * (w & 1) + tt, tcol = 16 * tb + r, j0 = 16 * ta + 4 * g;
            f32x4 dw = (f32x4){0.f, 0.f, 0.f, 0.f}, da = dw;
            dw = mfma16(W.wa0, N.lw0[tt], dw); dw = mfma16(W.wa1, N.lw1[tt], dw); da = mfma16(W.aa0, N.la0[tt], da); da = mfma16(W.aa1, N.la1[tt], da);
            *(LAS f32x4*)(wlf + tcol * 68 + j0) = dw; *(LAS f32x4*)(alf + tcol * 68 + j0) = da;
        }
    }
    BARRIER();
    const int t = tid >> 3, jb = (tid & 7) * 8, hj = h * 64 + jb; (void)hj;
    const LAS float* par = (const LAS float*)(L + 14 * SLOT);
    float r_[8], kp_[8], v_[8], kk_[8], lr_[8], lw_[8];
    {
        const v4u xr = N.xr, xk = N.xk, xv = N.xv, qr = N.qr, qk = N.qk, qv = N.qv;
        const f32x4 wl0 = *(const LAS f32x4*)(wlf + t * 68 + jb), wl1 = *(const LAS f32x4*)(wlf + t * 68 + jb + 4), al0 = *(const LAS f32x4*)(alf + t * 68 + jb), al1 = *(const LAS f32x4*)(alf + t * 68 + jb + 4);
        float ssq = 0.f, bon = 0.f; float kraw[8];
#pragma unroll
        for (int i = 0; i < 8; ++i) {
            const unsigned sh = (i & 1) * 16;
            const float x_r = __builtin_bit_cast(float, ((xr[i >> 1] >> sh) & 0xffffu) << 16), x_k = __builtin_bit_cast(float, ((xk[i >> 1] >> sh) & 0xffffu) << 16), x_v = __builtin_bit_cast(float, ((xv[i >> 1] >> sh) & 0xffffu) << 16);
            const float p_r = __builtin_bit_cast(float, ((qr[i >> 1] >> sh) & 0xffffu) << 16), p_k = __builtin_bit_cast(float, ((qk[i >> 1] >> sh) & 0xffffu) << 16), p_v = __builtin_bit_cast(float, ((qv[i >> 1] >> sh) & 0xffffu) << 16);
            r_[i] = x_r + (p_r - x_r) * par[jb + i]; kraw[i] = x_k + (p_k - x_k) * par[64 + jb + i]; v_[i] = x_v + (p_v - x_v) * par[128 + jb + i];
            const float wl = par[192 + jb + i] + (i < 4 ? wl0[i & 3] : wl1[i & 3]), al = par[256 + jb + i] + (i < 4 ? al0[i & 3] : al1[i & 3]);
            lw_[i] = -0.60653065971f * __builtin_amdgcn_rcpf(1.0f + __expf(-wl));
            lr_[i] = __builtin_amdgcn_rcpf(1.0f + __expf(-al));
            const float kkv = kraw[i] * par[320 + jb + i]; kk_[i] = kkv; ssq += kkv * kkv;
            kp_[i] = kraw[i] * (1.0f + (lr_[i] - 1.0f) * par[384 + jb + i]);
            bon += r_[i] * kp_[i] * par[448 + jb + i];
        }
        ssq += __shfl_xor(ssq, 1); ssq += __shfl_xor(ssq, 2); ssq += __shfl_xor(ssq, 4);
        bon += __shfl_xor(bon, 1); bon += __shfl_xor(bon, 2); bon += __shfl_xor(bon, 4);
        const float rn = 1.0f / fmaxf(sqrtf(ssq), 1e-12f);
#pragma unroll
        for (int i = 0; i < 8; ++i) kk_[i] *= rn;
        v4u bvw; bvw.x = cvt2(bon * v_[0], bon * v_[1]); bvw.y = cvt2(bon * v_[2], bon * v_[3]); bvw.z = cvt2(bon * v_[4], bon * v_[5]); bvw.w = cvt2(bon * v_[6], bon * v_[7]);
        { bf16* bg = P.BV + (((row0 + t) * 8 + h) * 16 + (jb >> 2)) * 8; *(u32x2_t*)bg = (u32x2_t){bvw.x, bvw.y}; *(u32x2_t*)(bg + 8) = (u32x2_t){bvw.z, bvw.w}; }
        *(LAS f32x4*)(cum + t * 68 + jb) = (f32x4){lw_[0], lw_[1], lw_[2], lw_[3]}; *(LAS f32x4*)(cum + t * 68 + jb + 4) = (f32x4){lw_[4], lw_[5], lw_[6], lw_[7]};
    }
    BARRIER();
    { const int seg = tid >> 6, j = tid & 63; float acc = 0.f;
#pragma unroll
      for (int i = 0; i < 8; ++i) { acc += cum[(8 * seg + i) * 68 + j]; cum[(8 * seg + i) * 68 + j] = acc; }
      segtot[seg * 64 + j] = acc; }
    BARRIER();
    { const int seg = tid >> 6, j = tid & 63; float off = 0.f;
      for (int s = 0; s < seg; ++s) off += segtot[s * 64 + j];
#pragma unroll
      for (int i = 0; i < 8; ++i) cum[(8 * seg + i) * 68 + j] += off; }
    BARRIER();
    LAS bf16* Atm = SL(0); LAS bf16* Btm = SL(1); LAS bf16* Ktm = SL(2); LAS bf16* Rtm = SL(3); LAS bf16* Adm = SL(4); LAS bf16* Bhd = SL(5); LAS bf16* Khd = SL(6); LAS bf16* Vdm = SL(7);
    {
        const f32x4 c0 = *(const LAS f32x4*)(cum + t * 68 + jb), c1 = *(const LAS f32x4*)(cum + t * 68 + jb + 4), e0 = *(const LAS f32x4*)(cum + 63 * 68 + jb), e1 = *(const LAS f32x4*)(cum + 63 * 68 + jb + 4);
        float at[8], bt[8], kt[8], rt[8], bh_[8], kh_[8];
#pragma unroll
        for (int i = 0; i < 8; ++i) {
            const float cc = (i < 4) ? c0[i & 3] : c1[i & 3], ce = (i < 4) ? e0[i & 3] : e1[i & 3];
            const float em = __expf(-cc), ep = __expf(cc), epm1 = __expf(cc - lw_[i]), ec = __expf(ce - cc);
            const float kl = kk_[i] * lr_[i];
            at[i] = -kk_[i] * epm1; bt[i] = kl * em; kt[i] = kp_[i] * em; rt[i] = r_[i] * ep; bh_[i] = kl * ec; kh_[i] = kp_[i] * ec;
            if (t == 63) P.GC[(size_t)ch * 64 + jb + i] = __expf(ce);
        }
#define ST8(M, a) do { v4u _w; _w.x = cvt2(a[0], a[1]); _w.y = cvt2(a[2], a[3]); _w.z = cvt2(a[4], a[5]); _w.w = cvt2(a[6], a[7]); *(LAS v4u*)(M + t * RS + jb) = _w; } while (0)
        ST8(Atm, at); ST8(Btm, bt); ST8(Ktm, kt); ST8(Rtm, rt);
#undef ST8
#pragma unroll
        for (int i = 0; i < 8; ++i) { const int o_ = dm_off(jb + i, t); Adm[o_] = (bf16)f2bf(at[i]); Bhd[o_] = (bf16)f2bf(bh_[i]); Khd[o_] = (bf16)f2bf(kh_[i]); Vdm[o_] = (bf16)f2bf(v_[i]); }
    }
    BARRIER();
    LAS float* TBf = (LAS float*)(L + 8 * SLOT); LAS bf16* TBb = SL(10); LAS bf16* TK = SL(11); LAS bf16* MBRt = SL(12);
    const int ta = w >> 1, cl = lane & 15, g = lane >> 4; (void)ta;
    const int bi = (w >> 1) & 1, bj = w & 1;
    if (w < 4) {
        Frag2 fa, fb, fk; ldfrag<false>(Atm, bi, lane, fa); ldfrag<false>(Btm, bj, lane, fb); ldfrag<false>(Ktm, bj, lane, fk);
        f32x4 d1[2][2], d2[2][2]; ZERO22(d1); ZERO22(d2); mmblk(fa, fb, d1); mmblk(fa, fk, d2);
#pragma unroll
        for (int x = 0; x < 2; ++x)
#pragma unroll
            for (int y = 0; y < 2; ++y) { const int col = 32 * bj + 16 * y + cl, r0 = 32 * bi + 16 * x + 4 * g;
#pragma unroll
                for (int i = 0; i < 4; ++i) if (!(col < r0 + i)) { d1[x][y][i] = 0.f; d2[x][y][i] = 0.f; }
                *(LAS f32x4*)(TBf + col * 68 + r0) = d1[x][y]; st_t(TBb, col, r0, d1[x][y]); st_t(TK, col, r0, d2[x][y]); }
    } else {
        Frag2 fb, fr; ldfrag<false>(Btm, bi, lane, fb); ldfrag<false>(Rtm, bj, lane, fr);
        f32x4 d3[2][2]; ZERO22(d3); mmblk(fb, fr, d3);
#pragma unroll
        for (int x = 0; x < 2; ++x)
#pragma unroll
            for (int y = 0; y < 2; ++y) { const int col = 32 * bj + 16 * y + cl, r0 = 32 * bi + 16 * x + 4 * g;
#pragma unroll
                for (int i = 0; i < 4; ++i) if (!(r0 + i <= col)) d3[x][y][i] = 0.f;
                st_t(MBRt, col, r0, d3[x][y]); }
    }
    BARRIER();
    LAS bf16* Minv = SL(0); LAS bf16* MinvT = SL(1); LAS bf16* Wsc = SL(13);
    for (int i = tid; i < 2 * SLOT / 4; i += NTHR) ((LAS unsigned*)Minv)[i] = 0u;
    BARRIER();
    if (w != 0) {
        const int r = lane & 15, g = lane >> 4;
#pragma unroll 1
        for (int k = w - 1; k < 16; k += 7) {
            const int ja = k >> 2, tb = k & 3, tcol = 16 * tb + r, j0 = 16 * ja + 4 * g;
            const bf16* ga = P.GLt + (size_t)(h * 64 + 16 * ja + r) * 160 + 8 * g; const bf16* bg = P.LIN + (row0 + tcol) * 288 + 128 + 8 * g;
            bf16x8 fa[5], fb[5];
#pragma unroll
            for (int ks = 0; ks < 5; ++ks) { fa[ks] = *(const bf16x8*)(ga + 32 * ks); fb[ks] = *(const bf16x8*)(bg + 32 * ks); }
            f32x4 dg = (f32x4){0.f, 0.f, 0.f, 0.f};
#pragma unroll
            for (int ks = 0; ks < 5; ++ks) dg = mfma16(fa[ks], fb[ks], dg);
            *(u32x2_t*)(P.BV + (((row0 + tcol) * 8 + h) * 16 + (j0 >> 2)) * 8 + 4) = pack4(dg);
        }
    }
    if (w == 0) {
        {
            const int blk = lane >> 4, cc = lane & 15; float x[16];
#pragma unroll
            for (int rr = 15; rr >= 0; --rr) {
                float s = (rr == cc) ? 1.f : 0.f;
                const LAS float* trow = TBf + (16 * blk + rr) * 68 + 16 * blk;
#pragma unroll
                for (int k = rr + 1; k < 16; ++k) s += trow[k] * x[k];
                x[rr] = s; asm volatile("" ::: "memory");
            }
#pragma unroll
            for (int rr = 0; rr < 16; ++rr) { const bf16 xb = (bf16)f2bf(x[rr]); Minv[(16 * blk + rr) * RS + 16 * blk + cc] = xb; MinvT[(16 * blk + cc) * RS + 16 * blk + rr] = xb; }
        }
        asm volatile("s_waitcnt lgkmcnt(0)" ::: "memory");
#pragma unroll 1
        for (int lev = 1; lev < 4; ++lev)
#pragma unroll 1
            for (int bi = 0; bi + lev < 4; ++bi) {
                const int bj = bi + lev;
                f32x4 wv = mm64(TBb, MinvT, bi, bj, lane, (f32x4){0.f, 0.f, 0.f, 0.f});
                *(LAS u32x2_t*)(Wsc + cl * RS + 4 * g) = pack4(wv);
                asm volatile("s_waitcnt lgkmcnt(0)" ::: "memory");
                bf16x8 a0 = *(const LAS bf16x8*)(Minv + (16 * bi + cl) * RS + 16 * bi + 8 * (g & 1));
                bf16x8 b0 = *(const LAS bf16x8*)(Wsc + cl * RS + 8 * (g & 1));
                if (g >= 2) { a0 = (bf16x8){0, 0, 0, 0, 0, 0, 0, 0}; b0 = a0; }
                const f32x4 xv = mfma16(a0, b0, (f32x4){0.f, 0.f, 0.f, 0.f});
                *(LAS u32x2_t*)(MinvT + (16 * bj + cl) * RS + 16 * bi + 4 * g) = pack4(xv);
#pragma unroll
                for (int i = 0; i < 4; ++i) Minv[(16 * bi + 4 * g + i) * RS + 16 * bj + cl] = (bf16)f2bf(xv[i]);
                asm volatile("s_waitcnt lgkmcnt(0)" ::: "memory");
            }
    }
    BARRIER();
    if (has_next) r1_prefetch(P, tid, w, bh, c + 1, N);
    LAS bf16* GT = SL(13); LAS bf16* ZT = SL(8);
    {
        Frag2 fa, fb; ldfrag<false>(Minv, bi, lane, fa);
        if (w < 4) ldfrag<false>(MBRt, bj, lane, fb); else ldfrag<true>(Bhd, bj, lane, fb);
        f32x4 d[2][2]; ZERO22(d); mmblk(fa, fb, d);
        LAS bf16* dst = (w < 4) ? GT : ZT;
#pragma unroll
        for (int x = 0; x < 2; ++x)
#pragma unroll
            for (int y = 0; y < 2; ++y) st_t(dst, 32 * bj + 16 * y + cl, 32 * bi + 16 * x + 4 * g, d[x][y]);
    }
    BARRIER();
    LAS bf16* HT = SL(9); LAS bf16* XT = SL(10);
    {
        Frag2 ftk; ldfrag<false>(TK, bi, lane, ftk);
        f32x4 d[2][2];
        if (w < 4) {
            Frag2 fk, fr, fg; ldfrag<false>(Ktm, bi, lane, fk); ldfrag<false>(Rtm, bj, lane, fr); ldfrag<false>(GT, bj, lane, fg);
            ZERO22(d); mmblk(fk, fr, d);
#pragma unroll
            for (int x = 0; x < 2; ++x)
#pragma unroll
                for (int y = 0; y < 2; ++y) { const int col = 32 * bj + 16 * y + cl, r0 = 32 * bi + 16 * x + 4 * g;
#pragma unroll
                    for (int i = 0; i < 4; ++i) if (!(r0 + i <= col)) d[x][y][i] = 0.f; }
            mmblk(ftk, fg, d);
#pragma unroll
            for (int x = 0; x < 2; ++x)
#pragma unroll
                for (int y = 0; y < 2; ++y) st_t(HT, 32 * bj + 16 * y + cl, 32 * bi + 16 * x + 4 * g, d[x][y]);
        } else {
            Frag2 fz; ldfrag<false>(ZT, bj, lane, fz);
#pragma unroll
            for (int x = 0; x < 2; ++x)
#pragma unroll
                for (int y = 0; y < 2; ++y) { const int col = 32 * bj + 16 * y + cl, r0 = 32 * bi + 16 * x + 4 * g;
                    const u32x2_t kh = *(const LAS u32x2_t*)(Khd + dm_off(col, r0));
                    d[x][y][0] = __builtin_bit_cast(float, kh.x << 16); d[x][y][1] = __builtin_bit_cast(float, kh.x & 0xffff0000u); d[x][y][2] = __builtin_bit_cast(float, kh.y << 16); d[x][y][3] = __builtin_bit_cast(float, kh.y & 0xffff0000u); }
            mmblk(ftk, fz, d);
#pragma unroll
            for (int x = 0; x < 2; ++x)
#pragma unroll
                for (int y = 0; y < 2; ++y) st_t(XT, 32 * bj + 16 * y + cl, 32 * bi + 16 * x + 4 * g, d[x][y]);
        }
    }
    BARRIER();
    asm volatile("; prefetch retired" :: "v"(N.xr), "v"(N.xk), "v"(N.xv), "v"(N.qr), "v"(N.qk), "v"(N.qv));
    asm volatile("; prefetch retired" :: "v"(N.lw0[0]), "v"(N.lw1[0]), "v"(N.la0[0]), "v"(N.la1[0]), "v"(N.lw0[1]), "v"(N.lw1[1]), "v"(N.la0[1]), "v"(N.la1[1]));
    {
        const int prod = w >> 1, rb = w & 1;
        Frag2 fa;
        if (prod == 0 || prod == 2) ldfrag<true>(Adm, rb, lane, fa); else if (prod == 1) ldfrag<false>(XT, rb, lane, fa); else ldfrag<true>(Vdm, rb, lane, fa);
#pragma unroll
        for (int cb = 0; cb < 2; ++cb) {
            Frag2 fb;
            if (prod == 0) ldfrag<false>(ZT, cb, lane, fb); else if (prod == 1) ldfrag<true>(Vdm, cb, lane, fb); else if (prod == 2) ldfrag<false>(GT, cb, lane, fb); else ldfrag<false>(HT, cb, lane, fb);
            f32x4 d[2][2]; ZERO22(d);
            if (prod == 2) {
#pragma unroll
                for (int x = 0; x < 2; ++x)
#pragma unroll
                    for (int y = 0; y < 2; ++y) { const u32x2_t rr = *(const LAS u32x2_t*)(Rtm + (32 * cb + 16 * y + cl) * RS + 32 * rb + 16 * x + 4 * g);
                        d[x][y][0] = __builtin_bit_cast(float, rr.x << 16); d[x][y][1] = __builtin_bit_cast(float, rr.x & 0xffff0000u); d[x][y][2] = __builtin_bit_cast(float, rr.y << 16); d[x][y][3] = __builtin_bit_cast(float, rr.y & 0xffff0000u); }
            }
            mmblk(fa, fb, d);
#pragma unroll
            for (int x = 0; x < 2; ++x)
#pragma unroll
                for (int y = 0; y < 2; ++y) { const int col = 32 * cb + 16 * y + cl, r0 = 32 * rb + 16 * x + 4 * g;
                    if (prod == 0) *(u32x2_t*)(P.PT + (size_t)ch * 4096 + col * 64 + r0) = pack4(d[x][y]);
                    else if (prod == 1) *(u32x2_t*)(P.QM + (size_t)ch * 4096 + col * 64 + r0) = pack4(d[x][y]);
                    else if (prod == 2) *(u32x2_t*)(P.RP + (size_t)ch * 4096 + col * 64 + r0) = pack4(d[x][y]);
                    else *(u32x2_t*)(P.Y0 + (size_t)ch * 4096 + col * 64 + r0) = pack4(d[x][y]); }
        }
    }
    BARRIER();
#undef SL
}

struct R2Ptrs { const bf16* PT; const bf16* RP; const bf16* QM; const bf16* Y0; const float* GC; const bf16* G2; const bf16* BV; const float* lnx_g; const float* lnx_b; bf16* MIX; float* wkv_out; };
__device__ __forceinline__ void r2_seq(Frame& F, const R2Ptrs& P, int bh) {
    const int lane = F.lane, w = F.wave, cl = lane & 15, g = lane >> 4, h = bh & 7, b = bh >> 3, x = w & 3;
    const bool isS = w < 4;
    LAS bf16* Sbf = (LAS bf16*)(F.lds);
    const size_t chb = (size_t)bh * 128;
    if (isS) {
        f32x4 S[4]; bf16x8 ptA[2], ptB[2], ptC[2], ptD[2]; u32x2_t qA[4], qB[4], qC[4], qD[4]; f32x4 gcA, gcB, gcC, gcD;
#define S_LOAD(pt, q, gc, cc_) do { const size_t cn_ = chb + ((cc_) < 128 ? (cc_) : 127); const bf16* pp = P.PT + cn_ * 4096 + (16 * x + cl) * 64 + 8 * g; pt[0] = *(const bf16x8*)pp; pt[1] = *(const bf16x8*)(pp + 32); \
            gc = *(const f32x4*)(P.GC + cn_ * 64 + 16 * x + 4 * g); \
            _Pragma("unroll") for (int it = 0; it < 4; ++it) q[it] = *(const u32x2_t*)(P.QM + cn_ * 4096 + (16 * it + cl) * 64 + 16 * x + 4 * g); } while (0)
#define S_STEP(pt, q, gc, c_) do { const LAS bf16* sr = Sbf + ((c_) & 1) * (64 * RS) + cl * RS + 8 * g; LAS bf16* sw = Sbf + (((c_) + 1) & 1) * (64 * RS) + cl * RS + 16 * x + 4 * g; \
            _Pragma("unroll") for (int it = 0; it < 4; ++it) { const bf16x8 sb0 = *(const LAS bf16x8*)(sr + 16 * it * RS), sb1 = *(const LAS bf16x8*)(sr + 16 * it * RS + 32); \
                f32x4 d = mfma16(pt[0], sb0, (f32x4){0.f, 0.f, 0.f, 0.f}); d = mfma16(pt[1], sb1, d);          \
                f32x4 qf; qf[0] = __builtin_bit_cast(float, q[it].x << 16); qf[1] = __builtin_bit_cast(float, q[it].x & 0xffff0000u); qf[2] = __builtin_bit_cast(float, q[it].y << 16); qf[3] = __builtin_bit_cast(float, q[it].y & 0xffff0000u); \
                S[it] = d + S[it] * gc + qf; *(LAS u32x2_t*)(sw + 16 * it * RS) = pack4(S[it]); } } while (0)
#pragma unroll
        for (int it = 0; it < 4; ++it) { S[it] = (f32x4){0.f, 0.f, 0.f, 0.f}; *(LAS u32x2_t*)(Sbf + (16 * it + cl) * RS + 16 * x + 4 * g) = (u32x2_t){0u, 0u}; }
        S_LOAD(ptA, qA, gcA, 0); S_LOAD(ptB, qB, gcB, 1); S_LOAD(ptC, qC, gcC, 2); S_LOAD(ptD, qD, gcD, 3);
        BARRIER();
#pragma unroll 1
        for (int c = 0; c < 128; c += 4) {
            S_STEP(ptA, qA, gcA, c); S_LOAD(ptA, qA, gcA, c + 4); BARRIER();
            S_STEP(ptB, qB, gcB, c + 1); S_LOAD(ptB, qB, gcB, c + 5); BARRIER();
            S_STEP(ptC, qC, gcC, c + 2); S_LOAD(ptC, qC, gcC, c + 6); BARRIER();
            S_STEP(ptD, qD, gcD, c + 3); S_LOAD(ptD, qD, gcD, c + 7); BARRIER();
        }
#undef S_LOAD
#undef S_STEP
#pragma unroll
        for (int it = 0; it < 4; ++it) *(f32x4*)(P.wkv_out + ((size_t)bh * 64 + 16 * it + cl) * 64 + 16 * x + 4 * g) = S[it];
    } else {
        f32x4 lg[4], lb[4];
#pragma unroll
        for (int it = 0; it < 4; ++it) { lg[it] = *(const f32x4*)(P.lnx_g + h * 64 + 16 * it + 4 * g); lb[it] = *(const f32x4*)(P.lnx_b + h * 64 + 16 * it + 4 * g); }
        bf16x8 rpA[2], rpB[2], rpC[2], rpD[2]; u32x2_t y0A[4], y0B[4], y0C[4], y0D[4]; v4u bgA[4], bgB[4], bgC[4], bgD[4];
        const size_t rowb0 = (size_t)b * SEQ;
#define Y_LOAD(rp, y0, bgw, cc_) do { const int ci_ = ((cc_) < 128 ? (cc_) : 127); const size_t cn_ = chb + ci_; const size_t rown = rowb0 + (size_t)ci_ * 64 + 16 * x + cl; \
            const bf16* rr = P.RP + cn_ * 4096 + (16 * x + cl) * 64 + 8 * g; rp[0] = *(const bf16x8*)rr; rp[1] = *(const bf16x8*)(rr + 32); \
            _Pragma("unroll") for (int it = 0; it < 4; ++it) { y0[it] = *(const u32x2_t*)(P.Y0 + cn_ * 4096 + (16 * x + cl) * 64 + 16 * it + 4 * g); \
                bgw[it] = *(const v4u*)(P.BV + ((rown * 8 + h) * 16 + 4 * it + g) * 8); } } while (0)
#define Y_STEP(rp, y0, bgw, c_) do { const LAS bf16* sr = Sbf + ((c_) & 1) * (64 * RS) + cl * RS + 8 * g; \
            f32x4 Y[4]; float s1 = 0.f, s2 = 0.f; \
            _Pragma("unroll") for (int it = 0; it < 4; ++it) { const bf16x8 sb0 = *(const LAS bf16x8*)(sr + 16 * it * RS), sb1 = *(const LAS bf16x8*)(sr + 16 * it * RS + 32); \
                f32x4 yi; yi[0] = __builtin_bit_cast(float, y0[it].x << 16); yi[1] = __builtin_bit_cast(float, y0[it].x & 0xffff0000u); yi[2] = __builtin_bit_cast(float, y0[it].y << 16); yi[3] = __builtin_bit_cast(float, y0[it].y & 0xffff0000u); \
                f32x4 y = mfma16(sb0, rp[0], yi); y = mfma16(sb1, rp[1], y); Y[it] = y;                 \
                s1 += (y[0] + y[1]) + (y[2] + y[3]); s2 += (y[0] * y[0] + y[1] * y[1]) + (y[2] * y[2] + y[3] * y[3]); } \
            s1 += __shfl_xor(s1, 16); s1 += __shfl_xor(s1, 32); s2 += __shfl_xor(s2, 16); s2 += __shfl_xor(s2, 32); \
            const float mean = s1 * (1.f / 64.f), var = fmaxf(s2 * (1.f / 64.f) - mean * mean, 0.f), rstd = 1.0f / sqrtf(var + GN_EPS); \
            const size_t row = rowb0 + (size_t)(c_) * 64 + 16 * x + cl; \
            _Pragma("unroll") for (int it = 0; it < 4; ++it) { f32x4 bv, g2; \
                bv[0] = __builtin_bit_cast(float, bgw[it].x << 16); bv[1] = __builtin_bit_cast(float, bgw[it].x & 0xffff0000u); bv[2] = __builtin_bit_cast(float, bgw[it].y << 16); bv[3] = __builtin_bit_cast(float, bgw[it].y & 0xffff0000u); \
                g2[0] = __builtin_bit_cast(float, bgw[it].z << 16); g2[1] = __builtin_bit_cast(float, bgw[it].z & 0xffff0000u); g2[2] = __builtin_bit_cast(float, bgw[it].w << 16); g2[3] = __builtin_bit_cast(float, bgw[it].w & 0xffff0000u); \
                const f32x4 o = ((Y[it] - mean) * rstd * lg[it] + lb[it] + bv) * g2; \
                *(u32x2_t*)(P.MIX + row * D + 512 + h * 64 + 16 * it + 4 * g) = pack4(o); } } while (0)
        Y_LOAD(rpA, y0A, bgA, 0); Y_LOAD(rpB, y0B, bgB, 1); Y_LOAD(rpC, y0C, bgC, 2); Y_LOAD(rpD, y0D, bgD, 3);
        BARRIER();
#pragma unroll 1
        for (int c = 0; c < 128; c += 4) {
            Y_STEP(rpA, y0A, bgA, c); Y_LOAD(rpA, y0A, bgA, c + 4); BARRIER();
            Y_STEP(rpB, y0B, bgB, c + 1); Y_LOAD(rpB, y0B, bgB, c + 5); BARRIER();
            Y_STEP(rpC, y0C, bgC, c + 2); Y_LOAD(rpC, y0C, bgC, c + 6); BARRIER();
            Y_STEP(rpD, y0D, bgD, c + 3); Y_LOAD(rpD, y0D, bgD, c + 7); BARRIER();
        }
#undef Y_LOAD
#undef Y_STEP
    }
}

#ifndef DUP0
#define DUP0 1
#endif
#ifndef DUP2
#define DUP2 1
#endif
#ifndef DUP3
#define DUP3 1
#endif
#ifndef DUP4
#define DUP4 1
#endif
__global__ void __launch_bounds__(NTHR, 2) fwd(Args args) {
    extern __shared__ __attribute__((aligned(16))) unsigned char lds[];
    Frame F;
    F.lds = (LAS unsigned char*)lds; F.MISC = (volatile LAS unsigned*)(F.lds + MISC_OFF);
    F.tid = threadIdx.x; F.lane = F.tid & 63; F.wave = __builtin_amdgcn_readfirstlane(F.tid >> 6);
    F.G = gridDim.x; { const int bx = blockIdx.x; F.vcu = (F.G % 8 == 0) ? (bx % 8) * (F.G / 8) + bx / 8 : bx; }
    unsigned char* ws = args.ws; F.ctl = (gu32*)(ws + WS_CTL);
    for (int u = F.tid; u < (LDS_BYTES - LDSCTL_OFF) / 4; u += NTHR) ((LAS unsigned*)(F.lds + LDSCTL_OFF))[u] = 0u;
    __syncthreads();
    const int lo = args.ph_lo, hi = args.ph_hi; const bool multi = (hi - lo) > 1;
    XcdBarrier bar; bar.bar = (unsigned*)(F.ctl + CW_BAR); bar.x = 0; bar.st = nullptr;
    if (multi) bar = xcd_barrier_post((unsigned*)(F.ctl + CW_BAR), F.MISC + 8);
#define IN(k) (lo <= (k) && (k) < hi)
#define SEAM(k) do { if (IN(k) && IN((k) + 1)) xcd_barrier(bar); } while (0)
    bf16* WIN = (bf16*)(ws + WS_WIN); bf16* WO = (bf16*)(ws + WS_WO); bf16* W1 = (bf16*)(ws + WS_W1); bf16* W2 = (bf16*)(ws + WS_W2);
    bf16* XN = (bf16*)(ws + WS_XN); bf16* HB = (bf16*)(ws + WS_HB); bf16* HBF = (bf16*)(ws + WS_HBF); float* SSQ = (float*)(ws + WS_SSQ);
#ifndef SKIP_0
    if (IN(0)) { for (int rep = 0; rep < DUP0; ++rep) { p0_prologue(F, args); __syncthreads(); } SEAM(0); }
#endif
#ifndef SKIP_1
    if (IN(1)) { pg8::Gemm g{XN, WIN, M, NINP, D}; pg8::StaticOrder S; S.init(M, NINP, F.G, (int)blockIdx.x);
        pg8::EpiProj E{(bf16*)(ws + WS_QB), (WS_KB - WS_QB) / 2, (bf16*)(ws + WS_PB), (float*)(ws + WS_QS), args.out, args.in[9], args.in[10], (const float*)(ws + WS_RSTD)};
        pg8::gemm_phase<pg8::EpiProj, pg8::StaticOrder, true, true>(F.lds + RING_OFF, g, S, E); SEAM(1); }
#endif
#ifndef SKIP_2
    if (IN(2)) {
#pragma unroll
      for (int rep = 0; rep < DUP2; ++rep) {
        r1_lin(F, (const bf16*)(ws + WS_PB), args.in[11], (bf16*)(ws + WS_LIN));
        p2_post(F, args);
        if (multi) xcd_barrier(bar);
        { R1Ptrs P; P.LIN = (const bf16*)(ws + WS_LIN); P.PB = (const bf16*)(ws + WS_PB); P.WLt = (const bf16*)(ws + WS_LORA); P.ALt = P.WLt + 512 * 64; P.GLt = P.ALt + 512 * 64;
          P.mu = args.in[11]; P.w0 = args.in[12]; P.a0 = args.in[14]; P.k_k = args.in[17]; P.k_a = args.in[18]; P.r_k = args.in[19];
          P.PT = (bf16*)(ws + WS_PT); P.RP = (bf16*)(ws + WS_RP); P.QM = (bf16*)(ws + WS_QM); P.Y0 = (bf16*)(ws + WS_Y0); P.GC = (float*)(ws + WS_GC); P.G2 = nullptr; P.BV = (bf16*)(ws + WS_G2);
          { const int nper = (BATCH * NH * 128) / F.G; const int it0 = F.vcu * nper; R1W W; r1_load_w(F, P, (it0 >> 7) & 7, W); r1_load_par(F, P, (it0 >> 7) & 7); R1Pre N; r1_prefetch(P, F.tid, F.wave, it0 >> 7, it0 & 127, N);
#pragma unroll 1
          for (int it = it0; it < it0 + nper; ++it) r1_item(F, P, W, N, it >> 7, it & 127, it + 1 < it0 + nper); } }
        __syncthreads(); }
        SEAM(2); }
#endif
#ifndef SKIP_3
    if (IN(3)) {
      for (int rep = 0; rep < DUP3; ++rep) {
        if ((F.vcu & 3) == 0 && (F.vcu >> 2) < BATCH * NH) {
            R2Ptrs P; P.PT = (const bf16*)(ws + WS_PT); P.RP = (const bf16*)(ws + WS_RP); P.QM = (const bf16*)(ws + WS_QM); P.Y0 = (const bf16*)(ws + WS_Y0); P.GC = (const float*)(ws + WS_GC);
            P.G2 = nullptr; P.BV = (const bf16*)(ws + WS_G2); P.lnx_g = args.in[20]; P.lnx_b = args.in[21]; P.MIX = (bf16*)(ws + WS_MIX); P.wkv_out = args.out + O_WKVP;
            r2_seq(F, P, F.vcu >> 2);
        } else { const int q = F.vcu >> 2, r = F.vcu & 3; const int idx = (q < BATCH * NH) ? 3 * q + (r - 1) : F.vcu - BATCH * NH; p4_scan(F, args, idx * NWAVES + F.wave, (F.G - BATCH * NH) * NWAVES); }
        __syncthreads();
        p3_attn(F, args); __syncthreads(); }
      SEAM(3); }
#endif
#ifndef SKIP_5
    if (IN(5)) { pg8::Gemm g{(const bf16*)(ws + WS_MIX), WO, M, D, D}; pg8::StaticOrder S; S.init(M, D, F.G, (int)blockIdx.x);
        pg8::EpiHRes E{XN, args.out + O_YP, HBF, SSQ, MP};
        pg8::gemm_phase<pg8::EpiHRes, pg8::StaticOrder, true, true>(F.lds + RING_OFF, g, S, E); SEAM(5); }
#endif
#ifndef SKIP_6
    if (IN(6)) { pg8::Gemm g{HBF, W1, M, FF, D}; pg8::StaticOrder S; S.init(M, FF, F.G, (int)blockIdx.x);
        pg8::EpiRelu2 E{HB, FF, SSQ};
        pg8::gemm_phase<pg8::EpiRelu2, pg8::StaticOrder, true, true>(F.lds + RING_OFF, g, S, E); SEAM(6); }
#endif
#ifndef SKIP_7
    if (IN(7)) { { pg8::Gemm g{HB, W2, MP, D, FF, 0}; pg8::StaticOrder S; S.init(MP, D, F.G, (int)blockIdx.x);
        pg8::EpiAddH E{args.out + O_YP, HBF, D};
        pg8::gemm_phase<pg8::EpiAddH, pg8::StaticOrder, true, true>(F.lds + RING_OFF, g, S, E); }
        { pg8::Gemm g{HB, W2, M, D, FF / 8, FF}; pg8::SplitKOrder<8, FF> S{F.G, (int)blockIdx.x};
        pg8::EpiAtomicAdd E{args.out + O_YP, D};
        pg8::gemm_phase<pg8::EpiAtomicAdd, pg8::SplitKOrder<8, FF>, true, true>(F.lds + RING_OFF, g, S, E); } }
#endif
#undef IN
#undef SEAM
}

#ifndef N_PHASES_PER_LAUNCH
#define N_PHASES_PER_LAUNCH 8
#endif
extern "C" void kernel_launch(void* const* d_in, const int* in_sizes, int n_in, void* d_out, int out_size, void* d_ws, size_t ws_size, hipStream_t stream) {
    static int grid = 0;
    if (grid == 0) {
        if (n_in != 26 || out_size != (int)O_END || ws_size < WS_END) { fprintf(stderr, "kernel_launch: unexpected shapes n_in %d out %d ws %zu\n", n_in, out_size, ws_size); grid = -1; return; }
        int dev = 0, cus = 0, per_cu = 0;
        if (hipGetDevice(&dev) != hipSuccess || hipDeviceGetAttribute(&cus, hipDeviceAttributeMultiprocessorCount, dev) != hipSuccess) { grid = -1; return; }
        if (hipFuncSetAttribute((const void*)fwd, hipFuncAttributeMaxDynamicSharedMemorySize, LDS_BYTES) != hipSuccess) { fprintf(stderr, "kernel_launch: hipFuncSetAttribute failed\n"); grid = -1; return; }
        if (hipOccupancyMaxActiveBlocksPerMultiprocessor(&per_cu, (const void*)fwd, NTHR, LDS_BYTES) != hipSuccess || per_cu < 1) { fprintf(stderr, "kernel_launch: occupancy query says %d\n", per_cu); }
        (void)hipGetLastError();
        grid = cus;
    }
    if (grid < 0) return;
    if (hipMemsetAsync((char*)d_ws + WS_CTL, 0, CTL_ZERO_BYTES, stream) != hipSuccess) return;
    Args a{};
    for (int i = 0; i < 26; ++i) a.in[i] = (const float*)d_in[i];
    a.out = (float*)d_out; a.ws = (unsigned char*)d_ws;
    constexpr int NPH = 8;
    for (int p = 0; p < NPH; p += N_PHASES_PER_LAUNCH) {
        a.ph_lo = p; a.ph_hi = (p + N_PHASES_PER_LAUNCH < NPH) ? p + N_PHASES_PER_LAUNCH : NPH;
        hipLaunchKernelGGL(fwd, dim3(grid), dim3(NTHR), LDS_BYTES, stream, a);
    }
}
```
